# Optimizing an MI355X kernel written in HIP

```python
import math
import jax, jax.numpy as jnp
from jax import lax
import numpy as np


D_MODEL = 1024
BATCH = 2
SEQ = 16384
DEPTH = 4
DEC_BATCH = 16
DEC_SEQ = 2048
PAST_LEN = 128

MLA_HEADS = D_MODEL // 128
QK_NOPE_DIM = 64
QK_ROPE_DIM = 32
V_HEAD_DIM = 64
Q_LORA_RANK = D_MODEL // 4
KV_LORA_RANK = D_MODEL // 8
ROPE_THETA = 10000.0
Q_BLOCK = 128
MLA_OUT = MLA_HEADS * V_HEAD_DIM
POOL_GROUPS = 4
POOL_GROUP_DIM = D_MODEL // 16
POOL_WINDOWS = (2, 4, 8, 16)
POOL_WIDTH = POOL_GROUPS * POOL_GROUP_DIM
MLSTM_HEADS = 4
MLSTM_HEAD_DIM = D_MODEL // 16
MLSTM_WIDTH = MLSTM_HEADS * MLSTM_HEAD_DIM
MLSTM_CHUNK = 128
N_GATES = 4 * MLSTM_HEADS
NEG_BIG = -1e30
MIX_WIDTH = MLA_OUT + POOL_WIDTH + MLSTM_WIDTH
IN_WIDTHS = (Q_LORA_RANK, KV_LORA_RANK, QK_ROPE_DIM, POOL_WIDTH,
             MLSTM_WIDTH, MLSTM_WIDTH, MLSTM_WIDTH, MLSTM_WIDTH, N_GATES)
IN_WIDTH = sum(IN_WIDTHS)
IN_SPLITS = tuple(int(v) for v in np.cumsum(IN_WIDTHS)[:-1])
D_FF = -(-8 * D_MODEL // (3 * 256)) * 256
DEEPNORM_ALPHA = (2 * DEPTH) ** 0.25
DEEPNORM_BETA = (8 * DEPTH) ** -0.25
LN_EPS = 1e-5

kernel_name = 'hymba_mla_pool_mlstm_deepnorm_encoder'


def layer_norm(x, g, b):
    xf = x.astype(jnp.float32)
    mu = xf.mean(-1, keepdims=True)
    var = jnp.square(xf - mu).mean(-1, keepdims=True)
    return ((xf - mu) * lax.rsqrt(var + LN_EPS) * g + b).astype(x.dtype)


def rms_norm(x, g):
    xf = x.astype(jnp.float32)
    return (xf * lax.rsqrt(jnp.square(xf).mean(-1, keepdims=True) + LN_EPS) * g).astype(x.dtype)


def rope_tables(seq_len):
    inv = 1.0 / (ROPE_THETA ** (jnp.arange(0, QK_ROPE_DIM, 2, dtype=jnp.float32) / QK_ROPE_DIM))
    ang = jnp.arange(seq_len, dtype=jnp.float32)[:, None] * inv[None, :]
    return jnp.cos(ang), jnp.sin(ang)


def apply_rope(x, cos, sin):
    xf = x.astype(jnp.float32)
    half = QK_ROPE_DIM // 2
    x1, x2 = xf[..., :half], xf[..., half:]
    return jnp.concatenate([x1 * cos - x2 * sin, x2 * cos + x1 * sin], axis=-1).astype(x.dtype)


def mla_mix(c_q, c_kv, k_rope, q_norm_g, w_uq, kv_norm_g, w_ukv):
    B, S, _ = c_q.shape
    q = jnp.einsum('bsr,rn->bsn', rms_norm(c_q, q_norm_g), w_uq).reshape(
        B, S, MLA_HEADS, QK_NOPE_DIM + QK_ROPE_DIM)
    kv = jnp.einsum('bsr,rn->bsn', rms_norm(c_kv, kv_norm_g), w_ukv).reshape(
        B, S, MLA_HEADS, QK_NOPE_DIM + V_HEAD_DIM)
    k_nope, v = kv[..., :QK_NOPE_DIM], kv[..., QK_NOPE_DIM:]
    cos, sin = rope_tables(S)
    q_rope = apply_rope(q[..., QK_NOPE_DIM:], cos[:, None, :], sin[:, None, :])
    k_rope = apply_rope(k_rope, cos, sin)
    q = jnp.concatenate([q[..., :QK_NOPE_DIM], q_rope], axis=-1)
    k = jnp.concatenate(
        [k_nope, jnp.broadcast_to(k_rope[:, :, None, :], (B, S, MLA_HEADS, QK_ROPE_DIM))], axis=-1)
    scale = (QK_NOPE_DIM + QK_ROPE_DIM) ** -0.5
    q_blocks = q.reshape(B, S // Q_BLOCK, Q_BLOCK, MLA_HEADS, -1).transpose(1, 0, 2, 3, 4)

    def attend(q_blk):
        s = jnp.einsum('bqhd,bkhd->bhqk', q_blk, k, preferred_element_type=jnp.float32) * scale
        p = jax.nn.softmax(s, axis=-1).astype(v.dtype)
        return jnp.einsum('bhqk,bkhd->bqhd', p, v)

    o = lax.map(attend, q_blocks)
    return o.transpose(1, 0, 2, 3, 4).reshape(B, S, MLA_OUT)


def pool_mix(xp, w_pool, pool_scale):
    B, S, _ = xp.shape
    xf = xp.astype(jnp.float32)
    cs = jnp.concatenate([jnp.zeros((B, 1, POOL_WIDTH), jnp.float32), jnp.cumsum(xf, axis=1)], axis=1)
    t = jnp.arange(S)
    outs = []
    for g, w in enumerate(POOL_WINDOWS):
        lo = jnp.clip(t - w // 2, 0, S)
        hi = jnp.clip(t + w // 2, 0, S)
        sl = slice(g * POOL_GROUP_DIM, (g + 1) * POOL_GROUP_DIM)
        csg = cs[:, :, sl]
        win_sum = jnp.take(csg, hi, axis=1) - jnp.take(csg, lo, axis=1)
        cnt = (hi - lo).astype(jnp.float32)[None, :, None]
        outs.append(win_sum / cnt - xf[:, :, sl])
    y = jnp.stack(outs, axis=2).astype(xp.dtype)
    y = jnp.einsum('bsgc,gcd->bsgd', y, w_pool).reshape(B, S, POOL_WIDTH)
    return y * pool_scale


def mlstm_chunk_scan(q, k, v, i_pre, f_pre):
    B, H, S, D = q.shape
    L = MLSTM_CHUNK
    NC = S // L

    def to_chunks(a):
        return jnp.moveaxis(a.reshape(B, H, NC, L, *a.shape[3:]), 2, 0)

    logf = jax.nn.log_sigmoid(f_pre)
    lower = jnp.tril(jnp.ones((L, L), dtype=bool))

    def step(carry, inp):
        C, n, m = carry
        qc, kc, vc, ic, fc = inp
        b = jnp.cumsum(fc, axis=-1)
        d_mat = jnp.where(lower, b[..., :, None] - b[..., None, :] + ic[..., None, :], NEG_BIG)
        m_inter = b + m[..., None]
        m_j = jnp.maximum(m_inter, d_mat.max(-1))
        w_intra = jnp.exp(d_mat - m_j[..., None])
        w_inter = jnp.exp(m_inter - m_j)
        scores = jnp.einsum('bhjd,bhsd->bhjs', qc, kc) * w_intra
        num = (w_inter[..., None] * jnp.einsum('bhjk,bhkv->bhjv', qc, C)
               + jnp.einsum('bhjs,bhsv->bhjv', scores, vc))
        den = w_inter * jnp.einsum('bhjk,bhk->bhj', qc, n) + scores.sum(-1)
        h = num / jnp.maximum(jnp.abs(den), jnp.exp(-m_j))[..., None]
        b_last = b[..., -1]
        g = b_last[..., None] - b + ic
        m_new = jnp.maximum(b_last + m, g.max(-1))
        decay = jnp.exp(b_last + m - m_new)
        w_s = jnp.exp(g - m_new[..., None])
        C_new = decay[..., None, None] * C + jnp.einsum('bhs,bhsk,bhsv->bhkv', w_s, kc, vc)
        n_new = decay[..., None] * n + jnp.einsum('bhs,bhsk->bhk', w_s, kc)
        return (C_new, n_new, m_new), h

    init = (jnp.zeros((B, H, D, D), jnp.float32), jnp.zeros((B, H, D), jnp.float32),
            jnp.zeros((B, H), jnp.float32))
    _, h = lax.scan(step, init, (to_chunks(q), to_chunks(k), to_chunks(v),
                                 to_chunks(i_pre), to_chunks(logf)))
    return jnp.moveaxis(h, 0, 2).reshape(B, H, S, D)


def mlstm_mix(q, k, v, o_pre, gates, gate_bias, norm_g):
    B, S, _ = q.shape

    def heads(a):
        return a.astype(jnp.float32).reshape(B, S, MLSTM_HEADS, MLSTM_HEAD_DIM).transpose(0, 2, 1, 3)

    qh, kh, vh = heads(q), heads(k) * MLSTM_HEAD_DIM ** -0.5, heads(v)
    g = (gates.astype(jnp.float32) + gate_bias.astype(jnp.float32)).reshape(
        B, S, 4, MLSTM_HEADS).transpose(2, 0, 3, 1)
    h_fwd = mlstm_chunk_scan(qh, kh, vh, g[0], g[1])
    flip = lambda a: jnp.flip(a, axis=2)
    h_bwd = flip(mlstm_chunk_scan(flip(qh), flip(kh), flip(vh), flip(g[2]), flip(g[3])))
    h = h_fwd + h_bwd
    mu = h.mean(-1, keepdims=True)
    var = jnp.square(h - mu).mean(-1, keepdims=True)
    h = ((h - mu) * lax.rsqrt(var + LN_EPS)).transpose(0, 2, 1, 3).reshape(B, S, MLSTM_WIDTH) * norm_g
    return (jax.nn.sigmoid(o_pre.astype(jnp.float32)) * h).astype(q.dtype)


def encoder_layer(x, w_in, q_norm_g, w_uq, kv_norm_g, w_ukv, w_pool, pool_scale,
                  mlstm_gate_bias, mlstm_norm_g, w_out, ln1_g, ln1_b,
                  w_gate, w_up, w_down, ln2_g, ln2_b):
    proj = jnp.einsum('bsd,dn->bsn', x, w_in)
    c_q, c_kv, k_rope, x_pool, q_m, k_m, v_m, o_m, gates = jnp.split(proj, IN_SPLITS, axis=-1)
    y_mla = mla_mix(c_q, c_kv, k_rope, q_norm_g, w_uq, kv_norm_g, w_ukv)
    y_pool = pool_mix(x_pool, w_pool, pool_scale).astype(x.dtype)
    y_mlstm = mlstm_mix(q_m, k_m, v_m, o_m, gates, mlstm_gate_bias, mlstm_norm_g)
    mix = jnp.einsum('bsm,md->bsd', jnp.concatenate([y_mla, y_pool, y_mlstm], axis=-1), w_out)
    x = layer_norm(DEEPNORM_ALPHA * x + mix, ln1_g, ln1_b)
    hid = jax.nn.silu(jnp.einsum('bsd,df->bsf', x, w_gate)) * jnp.einsum('bsd,df->bsf', x, w_up)
    ffn = jnp.einsum('bsf,fd->bsd', hid, w_down)
    return layer_norm(DEEPNORM_ALPHA * x + ffn, ln2_g, ln2_b)


def setup_inputs(seed: int = 0) -> dict:
    key = jax.random.key(seed)
    ks = jax.random.split(key, 24)

    def nrm(k, shape, scale):
        return jax.random.normal(k, shape, jnp.float32) * scale

    x_prompt = nrm(ks[0], (BATCH, SEQ, D_MODEL), 1.0)
    x_sample = nrm(ks[1], (DEC_BATCH, DEC_SEQ, D_MODEL), 1.0)
    ln_in_g = 1.0 + nrm(ks[2], (D_MODEL,), 0.02)
    ln_in_b = nrm(ks[3], (D_MODEL,), 0.02)
    w_in = nrm(ks[4], (DEPTH, D_MODEL, IN_WIDTH), D_MODEL ** -0.5)
    q_norm_g = 1.0 + nrm(ks[5], (DEPTH, Q_LORA_RANK), 0.02)
    w_uq = nrm(ks[6], (DEPTH, Q_LORA_RANK, MLA_HEADS * (QK_NOPE_DIM + QK_ROPE_DIM)), Q_LORA_RANK ** -0.5)
    kv_norm_g = 1.0 + nrm(ks[7], (DEPTH, KV_LORA_RANK), 0.02)
    w_ukv = nrm(ks[8], (DEPTH, KV_LORA_RANK, MLA_HEADS * (QK_NOPE_DIM + V_HEAD_DIM)), KV_LORA_RANK ** -0.5)
    w_pool = nrm(ks[9], (DEPTH, POOL_GROUPS, POOL_GROUP_DIM, POOL_GROUP_DIM), POOL_GROUP_DIM ** -0.5)
    pool_scale = 1.0 + nrm(ks[10], (DEPTH, POOL_WIDTH), 0.02)
    i_bias = nrm(ks[11], (DEPTH, 2, MLSTM_HEADS), 0.1)
    f_bias = jnp.linspace(3.0, 6.0, MLSTM_HEADS, dtype=jnp.float32)[None, None, :] + nrm(
        ks[12], (DEPTH, 2, MLSTM_HEADS), 0.1)
    mlstm_gate_bias = jnp.stack([i_bias[:, 0], f_bias[:, 0], i_bias[:, 1], f_bias[:, 1]],
                                axis=1).reshape(DEPTH, N_GATES)
    mlstm_norm_g = 1.0 + nrm(ks[13], (DEPTH, MLSTM_WIDTH), 0.02)
    w_out = nrm(ks[14], (DEPTH, MIX_WIDTH, D_MODEL), MIX_WIDTH ** -0.5 * DEEPNORM_BETA)
    ln1_g = 1.0 + nrm(ks[15], (DEPTH, D_MODEL), 0.02)
    ln1_b = nrm(ks[16], (DEPTH, D_MODEL), 0.02)
    w_gate = nrm(ks[17], (DEPTH, D_MODEL, D_FF), D_MODEL ** -0.5)
    w_up = nrm(ks[18], (DEPTH, D_MODEL, D_FF), D_MODEL ** -0.5)
    w_down = nrm(ks[19], (DEPTH, D_FF, D_MODEL), D_FF ** -0.5 * DEEPNORM_BETA)
    ln2_g = 1.0 + nrm(ks[20], (DEPTH, D_MODEL), 0.02)
    ln2_b = nrm(ks[21], (DEPTH, D_MODEL), 0.02)
    return {'x_prompt': x_prompt, 'x_sample': x_sample, 'ln_in_g': ln_in_g, 'ln_in_b': ln_in_b,
            'w_in': w_in, 'q_norm_g': q_norm_g, 'w_uq': w_uq, 'kv_norm_g': kv_norm_g, 'w_ukv': w_ukv,
            'w_pool': w_pool, 'pool_scale': pool_scale, 'mlstm_gate_bias': mlstm_gate_bias,
            'mlstm_norm_g': mlstm_norm_g, 'w_out': w_out, 'ln1_g': ln1_g, 'ln1_b': ln1_b,
            'w_gate': w_gate, 'w_up': w_up, 'w_down': w_down, 'ln2_g': ln2_g, 'ln2_b': ln2_b}


def reference(x_prompt, x_sample, ln_in_g, ln_in_b, w_in, q_norm_g, w_uq, kv_norm_g, w_ukv,
              w_pool, pool_scale, mlstm_gate_bias, mlstm_norm_g, w_out, ln1_g, ln1_b,
              w_gate, w_up, w_down, ln2_g, ln2_b):
    def trunk(x):
        x = layer_norm(x, ln_in_g, ln_in_b)
        for l in range(DEPTH):
            x = encoder_layer(x, w_in[l], q_norm_g[l], w_uq[l], kv_norm_g[l], w_ukv[l],
                              w_pool[l], pool_scale[l], mlstm_gate_bias[l], mlstm_norm_g[l],
                              w_out[l], ln1_g[l], ln1_b[l], w_gate[l], w_up[l], w_down[l],
                              ln2_g[l], ln2_b[l])
        return x

    y_prompt = trunk(x_prompt)
    y_sample = trunk(x_sample)
    return (y_prompt, y_sample)
```

```cpp
#include <hip/hip_runtime.h>
#include <hip/hip_cooperative_groups.h>
#include <stdint.h>
#include <stdio.h>
namespace cg = cooperative_groups;

#ifndef REP_P1
#define REP_P1 1
#endif
#ifndef REP_P3
#define REP_P3 1
#endif
#ifndef REP_LN
#define REP_LN 1
#endif
#ifndef ONE_LAUNCH
#define ONE_LAUNCH 1
#endif

typedef unsigned short bf16_t;
typedef short bf16x8 __attribute__((ext_vector_type(8)));
typedef float f32x16 __attribute__((ext_vector_type(16)));
typedef float f32x4 __attribute__((ext_vector_type(4)));
typedef float f32x2 __attribute__((ext_vector_type(2)));
typedef unsigned u32x4 __attribute__((ext_vector_type(4)));
typedef unsigned u32x2 __attribute__((ext_vector_type(2)));
typedef __bf16 bf16x2_t __attribute__((ext_vector_type(2)));

constexpr int DM = 1024, DEPTH = 4, MT = 32768;
constexpr int NPROJ = 1792, INW = 1712, DFF = 2816, NGU = 5632;
constexpr int C_CQ = 0, C_CKV = 256, C_KR = 384, C_POOL = 416, C_QM = 672, C_KM = 928, C_VM = 1184, C_OM = 1440, C_G = 1696;
constexpr float LN_EPS = 1e-5f;
constexpr float DN_ALPHA = 1.6817928305074290f;
constexpr float QSCALE = 0.10206207261596577f * 1.4426950408889634f;
constexpr int NTHR = 512;

constexpr size_t MiB = 1u << 20;
constexpr size_t W_IN = 0, W_UQ = W_IN + (size_t)NPROJ * 1024 * 2, W_UKV = W_UQ + 768 * 256 * 2, W_OUT = W_UKV + 1024 * 128 * 2,
                 W_GU = W_OUT + 1024 * 1024 * 2, W_DN = W_GU + (size_t)NGU * 1024 * 2, W_LAYER = W_DN + (size_t)1024 * DFF * 2;
static_assert(W_LAYER * 4 <= 96 * MiB, "weights");
constexpr size_t OFF_W = 0, OFF_ROPE = 96 * MiB, OFF_XB = 98 * MiB, OFF_Y = 162 * MiB, OFF_R = 226 * MiB;
constexpr size_t OFF_PROJ = OFF_R, OFF_Q = OFF_R + 112 * MiB, OFF_KN = OFF_Q + 48 * MiB, OFF_VT = OFF_KN + 32 * MiB, OFF_KR = OFF_VT + 32 * MiB,
                 OFF_GATES = OFF_KR + 2 * MiB, OFF_STU = OFF_GATES + 2 * MiB, OFF_STN = OFF_STU + 32 * MiB, OFF_STS = OFF_STN + 1 * MiB, OFF_END = OFF_STS + 1 * MiB;
constexpr size_t OFF_HID = OFF_R;
constexpr size_t OFF_CNT = OFF_END;
constexpr size_t OFF_XBAR = OFF_END + 4096;
constexpr size_t OFF_STAT = OFF_XBAR + 16384;
constexpr size_t OFF_ID = OFF_STAT + (size_t)MT * 8;
static_assert(OFF_ID + 8192 <= 512 * MiB, "ws");
static_assert(OFF_HID + (size_t)MT * DFF * 2 <= OFF_END, "hid");

constexpr int LDS_BYTES = 151552;

struct Params {
  const float* in[21];
  float* out;
  unsigned char* ws;
  int ph_lo, ph_hi;
};

__device__ __forceinline__ unsigned pk2(float lo, float hi) { f32x2 v = {lo, hi}; bf16x2_t b = __builtin_convertvector(v, bf16x2_t); return __builtin_bit_cast(unsigned, b); }
__device__ __forceinline__ bf16_t f2bf(float x) { return (bf16_t)(pk2(x, 0.f) & 0xffffu); }
__device__ __forceinline__ float bf2f(bf16_t b) { return __uint_as_float(((unsigned)b) << 16); }
__device__ __forceinline__ float bflo(unsigned w) { return __uint_as_float(w << 16); }
__device__ __forceinline__ float bfhi(unsigned w) { return __uint_as_float(w & 0xffff0000u); }
__device__ __forceinline__ int crow(int r, int hi) { return (r & 3) + 8 * (r >> 2) + 4 * hi; }
__device__ __forceinline__ float wave_sum(float v) {
  v += __shfl_xor(v, 32); v += __shfl_xor(v, 16); v += __shfl_xor(v, 8); v += __shfl_xor(v, 4); v += __shfl_xor(v, 2); v += __shfl_xor(v, 1); return v;
}
__device__ __forceinline__ int otid() { int t = threadIdx.x; asm volatile("" : "+v"(t)); return t; }
#define MFMA32(a, b, c) __builtin_amdgcn_mfma_f32_32x32x16_bf16((a), (b), (c), 0, 0, 0)
#define PK4(P, BASE, OUT) do { unsigned a0_ = pk2(P[BASE + 0], P[BASE + 1]), a1_ = pk2(P[BASE + 2], P[BASE + 3]);   \
    unsigned b0_ = pk2(P[BASE + 4], P[BASE + 5]), b1_ = pk2(P[BASE + 6], P[BASE + 7]);                              \
    auto r0_ = __builtin_amdgcn_permlane32_swap(a0_, b0_, false, false); auto r1_ = __builtin_amdgcn_permlane32_swap(a1_, b1_, false, false); \
    u32x4 w_ = {r0_[0], r1_[0], r0_[1], r1_[1]}; OUT = __builtin_bit_cast(bf16x8, w_); } while (0)

__device__ void prep_tile(const float* srcA, int colA, int limA, const float* srcB, int colB, int limB, int ld, int k0,
                          const float* kscale, float mul, bf16_t* dst, int ldd, int n0, float* tile) {
  const int tid = otid();
#pragma unroll
  for (int i = 0; i < 8; ++i) {
    const int kk = (tid >> 6) + 8 * i, nn = tid & 63;
    float v = 0.f;
    if (nn < 32) { const int c = colA + nn; if (c < limA) v = srcA[(size_t)(k0 + kk) * ld + c]; }
    else { const int c = colB + nn - 32; if (c < limB) v = srcB[(size_t)(k0 + kk) * ld + c]; }
    if (kscale) v *= kscale[k0 + kk];
    tile[kk * 65 + nn] = v * mul;
  }
  __syncthreads();
#pragma unroll
  for (int i = 0; i < 8; ++i) {
    const int nn = (tid >> 6) + 8 * i, kk = tid & 63;
    dst[(size_t)(n0 + nn) * ldd + k0 + kk] = f2bf(tile[kk * 65 + nn]);
  }
  __syncthreads();
}

__device__ void phase_prep(const Params& p, char* smem) {
  float* tile = (float*)smem;
  const int tid = otid();
  constexpr int N_IN = 28 * 16, N_UQ = 12 * 4, N_UKV = 16 * 2, N_OUT = 16 * 12, N_PF = 4 * 16, N_GU = 88 * 16, N_DN = 16 * 44;
  constexpr int PER_LAYER = N_IN + N_UQ + N_UKV + N_OUT + N_PF + N_GU + N_DN;
  constexpr int N_ROPE = 16384 * 16 / NTHR;
  const int total = PER_LAYER * DEPTH + N_ROPE;
  for (int it = blockIdx.x; it < total; it += gridDim.x) {
    if (it >= PER_LAYER * DEPTH) {
      const int e = (it - PER_LAYER * DEPTH) * NTHR + tid, pos = e >> 4, i = e & 15;
      const float inv = exp2f(-(float)i * (13.287712379549449f / 16.0f));
      const float ang = (float)pos * inv;
      double rev = (double)ang * 0.15915494309189535; rev -= floor(rev);
      const float fr = (float)rev;
      f32x2 cs = {__builtin_amdgcn_cosf(fr), __builtin_amdgcn_sinf(fr)};
      ((f32x2*)(p.ws + OFF_ROPE))[e] = cs;
      continue;
    }
    const int l = it / PER_LAYER; int j = it % PER_LAYER;
    unsigned char* wl = p.ws + OFF_W + (size_t)l * W_LAYER;
    if (j < N_IN) { const int nt = j / 16, kt = j % 16; const float* s = p.in[4] + (size_t)l * 1024 * INW;
      prep_tile(s, nt * 64, INW, s, nt * 64 + 32, INW, INW, kt * 64, nullptr, 1.f, (bf16_t*)(wl + W_IN), 1024, nt * 64, tile); continue; }
    j -= N_IN;
    if (j < N_UQ) { const int nt = j / 4, kt = j % 4; const float* s = p.in[6] + (size_t)l * 256 * 768;
      prep_tile(s, nt * 64, 768, s, nt * 64 + 32, 768, 768, kt * 64, p.in[5] + l * 256, QSCALE, (bf16_t*)(wl + W_UQ), 256, nt * 64, tile); continue; }
    j -= N_UQ;
    if (j < N_UKV) { const int nt = j / 2, kt = j % 2; const float* s = p.in[8] + (size_t)l * 128 * 1024;
      prep_tile(s, nt * 64, 1024, s, nt * 64 + 32, 1024, 1024, kt * 64, p.in[7] + l * 128, 1.f, (bf16_t*)(wl + W_UKV), 128, nt * 64, tile); continue; }
    j -= N_UKV;
    if (j < N_OUT) { const int nt = j / 12; int kt = j % 12; if (kt >= 8) kt += 4; const float* s = p.in[13] + (size_t)l * 1024 * 1024;
      prep_tile(s, nt * 64, 1024, s, nt * 64 + 32, 1024, 1024, kt * 64, nullptr, 1.f, (bf16_t*)(wl + W_OUT), 1024, nt * 64, tile); continue; }
    j -= N_OUT;
    if (j < N_PF) {
      const int g = j / 16, n0 = (j % 16) * 64, nn = tid & 63;
      const float* wo = p.in[13] + (size_t)l * 1024 * 1024 + (size_t)(512 + g * 64) * 1024 + n0 + nn;
      const float* wp = p.in[9] + (size_t)l * 4 * 64 * 64 + (size_t)g * 64 * 64;
      const float* ps = p.in[10] + l * 256 + g * 64;
      bf16_t* dst = (bf16_t*)(wl + W_OUT);
      for (int i = 0; i < 8; ++i) {
        const int c = (tid >> 6) + 8 * i; float s = 0.f;
        for (int d = 0; d < 64; ++d) s += wp[c * 64 + d] * ps[d] * wo[(size_t)d * 1024];
        dst[(size_t)(n0 + nn) * 1024 + 512 + g * 64 + c] = f2bf(s);
      }
      continue; }
    j -= N_PF;
    if (j < N_GU) { const int nt = j / 16, kt = j % 16, T = nt >> 2, sb = nt & 3;
      const float* s = ((sb < 2) ? p.in[16] : p.in[17]) + (size_t)l * 1024 * DFF; const int c0 = 128 * T + 64 * (sb & 1);
      prep_tile(s, c0, DFF, s, c0 + 32, DFF, DFF, kt * 64, nullptr, 1.f, (bf16_t*)(wl + W_GU), 1024, nt * 64, tile); continue; }
    j -= N_GU;
    { const int nt = j / 44, kt = j % 44; const float* s = p.in[18] + (size_t)l * DFF * 1024;
      prep_tile(s, nt * 64, 1024, s, nt * 64 + 32, 1024, 1024, kt * 64, nullptr, 1.f, (bf16_t*)(wl + W_DN), DFF, nt * 64, tile); }
  }
}

__device__ void phase_ln(const float* src, float* dst32, bf16_t* dstb, const float* g, const float* bta, int nrows, f32x2* stats, bool ident) {
  const int tid = otid(); const int lane = tid & 63, wid = tid >> 6;
  f32x4 gv[4], bv[4];
#pragma unroll
  for (int j = 0; j < 4; ++j) { gv[j] = *(const f32x4*)(g + j * 256 + lane * 4); bv[j] = *(const f32x4*)(bta + j * 256 + lane * 4); }
  const int rstride = gridDim.x * 8;
  for (int row0 = blockIdx.x * 8 + wid; row0 < nrows; row0 += 2 * rstride) {
    f32x4 v[2][4];
    const bool two = (row0 + rstride) < nrows;
#pragma unroll
    for (int j = 0; j < 4; ++j) v[0][j] = *(const f32x4*)(src + (size_t)row0 * 1024 + j * 256 + lane * 4);
    if (two) {
#pragma unroll
      for (int j = 0; j < 4; ++j) v[1][j] = *(const f32x4*)(src + (size_t)(row0 + rstride) * 1024 + j * 256 + lane * 4);
    }
#pragma unroll
    for (int u = 0; u < 2; ++u) {
      if (u == 1 && !two) break;
      const int row = row0 + u * rstride;
      float s = 0.f;
#pragma unroll
      for (int j = 0; j < 4; ++j) s += (v[u][j][0] + v[u][j][1]) + (v[u][j][2] + v[u][j][3]);
      const float mean = wave_sum(s) * (1.f / 1024.f);
      float q = 0.f;
#pragma unroll
      for (int j = 0; j < 4; ++j) { f32x4 d = v[u][j] - mean; q += (d[0] * d[0] + d[1] * d[1]) + (d[2] * d[2] + d[3] * d[3]); }
      const float rstd = rsqrtf(wave_sum(q) * (1.f / 1024.f) + LN_EPS);
      if (lane == 0) { f32x2 sv = {ident ? 0.f : mean, ident ? 1.f : rstd}; stats[row] = sv; }
#pragma unroll
      for (int j = 0; j < 4; ++j) {
        f32x4 o = (v[u][j] - mean) * rstd * gv[j] + bv[j];
        if (dst32) *(f32x4*)(dst32 + (size_t)row * 1024 + j * 256 + lane * 4) = o;
        u32x2 w = {pk2(o[0], o[1]), pk2(o[2], o[3])};
        *(u32x2*)(dstb + (size_t)row * 1024 + j * 256 + lane * 4) = w;
      }
    }
  }
}

constexpr int G_BUF = 256 * 64;
constexpr int G_SMEM_BYTES = 4 * G_BUF * 2;
#define LAS3 __attribute__((address_space(3)))

template <class Epi>
__device__ __forceinline__ void gemm_tile(const bf16_t* __restrict__ A, int lda, const bf16_t* __restrict__ Bt, int K, int m0, int n0, char* smem, const Epi& epi) {
  const int tid = otid(), lane = tid & 63, wid = tid >> 6, wm = wid >> 2, wn = wid & 3, r32 = lane & 31, hi = lane >> 5;
  LAS3 unsigned char* lds = (LAS3 unsigned char*)smem;
  const int rowl = wid * 8 + (lane >> 3), gch = (lane & 7) ^ ((rowl >> 1) & 7);
  const bf16_t* pa = A + (size_t)(m0 + rowl) * lda + gch * 8;
  const bf16_t* pb = Bt + (size_t)(n0 + rowl) * K + gch * 8;
  const size_t sa = (size_t)64 * lda, sb = (size_t)64 * K;
  const unsigned wbase = (unsigned)__builtin_amdgcn_readfirstlane(wid * 1024);
#define G_DMA(buf, k0) do { _Pragma("unroll") for (int j_ = 0; j_ < 4; ++j_) { \
    __builtin_amdgcn_global_load_lds((const unsigned*)(pa + j_ * sa + (k0)), (LAS3 unsigned*)(lds + (buf) * 32768 + j_ * 8192 + wbase), 16, 0, 0); \
    __builtin_amdgcn_global_load_lds((const unsigned*)(pb + j_ * sb + (k0)), (LAS3 unsigned*)(lds + 65536 + (buf) * 32768 + j_ * 8192 + wbase), 16, 0, 0); } } while (0)
  f32x16 acc[2][4];
#pragma unroll
  for (int a = 0; a < 2; ++a)
#pragma unroll
    for (int b = 0; b < 4; ++b) acc[a][b] = f32x16{};
  G_DMA(0, 0);
  asm volatile("s_waitcnt vmcnt(0)" ::: "memory");
  __syncthreads();
  const int nk = K >> 6;
  const int swz = (r32 >> 1) & 7;
  int koff[4];
#pragma unroll
  for (int kk = 0; kk < 4; ++kk) koff[kk] = ((kk * 2 + hi) ^ swz) * 16;
  const int aoff = (wm * 128 + r32) * 128, boff = 65536 + (wn * 64 + r32) * 128;
  for (int t = 0; t < nk; ++t) {
    const int buf = t & 1;
    if (t + 1 < nk) G_DMA(buf ^ 1, (t + 1) * 64);
    const LAS3 unsigned char* as = lds + buf * 32768 + aoff; const LAS3 unsigned char* bs = lds + buf * 32768 + boff;
    bf16x8 af[2][4], bfr[2][2];
#define G_LDF(S, KK) do { _Pragma("unroll") for (int mt = 0; mt < 4; ++mt) af[S][mt] = *(const LAS3 bf16x8*)(as + mt * 4096 + koff[KK]); \
      _Pragma("unroll") for (int nt = 0; nt < 2; ++nt) bfr[S][nt] = *(const LAS3 bf16x8*)(bs + nt * 4096 + koff[KK]); } while (0)
    G_LDF(0, 0);
#pragma unroll
    for (int kk = 0; kk < 4; ++kk) {
      if (kk < 3) G_LDF((kk + 1) & 1, kk + 1);
      __builtin_amdgcn_sched_barrier(0);
#pragma unroll
      for (int nt = 0; nt < 2; ++nt)
#pragma unroll
        for (int mt = 0; mt < 4; ++mt) acc[nt][mt] = MFMA32(bfr[kk & 1][nt], af[kk & 1][mt], acc[nt][mt]);
      __builtin_amdgcn_sched_barrier(0);
    }
#undef G_LDF
    asm volatile("s_waitcnt vmcnt(0)" ::: "memory");
    __syncthreads();
  }
#undef G_DMA
  epi(acc, m0, n0, wm, wn, r32, hi);
}

struct EpiInProj {
  bf16_t* proj; float* gates; char* smem;
  __device__ __forceinline__ void operator()(const f32x16 (&acc)[2][4], int m0, int n0, int wm, int wn, int r32, int hi) const {
    const int lane = r32 + 32 * hi, wid = wm * 4 + wn;
    bf16_t* wl = (bf16_t*)smem + wid * (32 * 72);
    const int c = lane & 7, rq = lane >> 3;
#pragma unroll
    for (int mt = 0; mt < 4; ++mt) {
      const int m = m0 + wm * 128 + mt * 32 + r32;
#pragma unroll
      for (int nt = 0; nt < 2; ++nt)
#pragma unroll
        for (int g = 0; g < 4; ++g) {
          const int nb = n0 + wn * 64 + nt * 32 + g * 8 + hi * 4;
          const f32x16& a = acc[nt][mt];
          u32x2 w = {pk2(a[4 * g], a[4 * g + 1]), pk2(a[4 * g + 2], a[4 * g + 3])};
          *(u32x2*)(wl + r32 * 72 + nt * 32 + g * 8 + hi * 4) = w;
          if (nb >= C_G && nb < INW) { f32x4 v = {a[4 * g], a[4 * g + 1], a[4 * g + 2], a[4 * g + 3]}; *(f32x4*)(gates + (size_t)m * 16 + (nb - C_G)) = v; }
        }
      asm volatile("s_waitcnt lgkmcnt(0)" ::: "memory");
#pragma unroll
      for (int i = 0; i < 4; ++i) {
        const int rr = rq + 8 * i;
        const u32x4 v = *(const u32x4*)(wl + rr * 72 + c * 8);
        *(u32x4*)(proj + (size_t)(m0 + wm * 128 + mt * 32 + rr) * NPROJ + n0 + wn * 64 + c * 8) = v;
      }
      asm volatile("s_waitcnt lgkmcnt(0)" ::: "memory");
    }
    __syncthreads();
  }
};

struct EpiQUp {
  bf16_t* Q; const float* rs; const f32x2* rope; int smask;
  __device__ __forceinline__ void operator()(const f32x16 (&acc)[2][4], int m0, int n0, int wm, int wn, int r32, int hi) const {
#pragma unroll
    for (int mt = 0; mt < 4; ++mt) {
      const int ml = wm * 128 + mt * 32 + r32, m = m0 + ml; const float r = rs[ml]; const int pos = m & smask;
#pragma unroll
      for (int nt = 0; nt < 2; ++nt) {
        const int nb0 = n0 + wn * 64 + nt * 32; const int t32 = nb0 >> 5; const bool isrope = (t32 % 3) == 2;
        float v[16];
#pragma unroll
        for (int k = 0; k < 16; ++k) v[k] = acc[nt][mt][k] * r;
        if (isrope) {
#pragma unroll
          for (int g = 0; g < 2; ++g)
#pragma unroll
            for (int i = 0; i < 4; ++i) {
              const int dd = 8 * g + 4 * hi + i; const f32x2 cs = rope[pos * 16 + dd];
              const float x1 = v[4 * g + i], x2 = v[4 * g + i + 8];
              v[4 * g + i] = x1 * cs[0] - x2 * cs[1]; v[4 * g + i + 8] = x2 * cs[0] + x1 * cs[1];
            }
        }
#pragma unroll
        for (int g = 0; g < 4; ++g) { u32x2 w = {pk2(v[4 * g], v[4 * g + 1]), pk2(v[4 * g + 2], v[4 * g + 3])}; *(u32x2*)(Q + (size_t)m * 768 + nb0 + g * 8 + hi * 4) = w; }
      }
    }
  }
};

struct EpiKVUp {
  bf16_t* Kn; bf16_t* Vt; const float* rs; int S, slog, smask;
  __device__ __forceinline__ void operator()(const f32x16 (&acc)[2][4], int m0, int n0, int wm, int wn, int r32, int hi) const {
#pragma unroll
    for (int mt = 0; mt < 4; ++mt) {
      const int ml = wm * 128 + mt * 32 + r32, m = m0 + ml; const float r = rs[ml]; const int pos = m & smask, b = m >> slog;
#pragma unroll
      for (int nt = 0; nt < 2; ++nt) {
        const int nb0 = n0 + wn * 64 + nt * 32; const int head = nb0 >> 7, d0 = nb0 & 127;
        if (d0 < 64) {
#pragma unroll
          for (int g = 0; g < 4; ++g) { const f32x16& a = acc[nt][mt];
            u32x2 w = {pk2(a[4 * g] * r, a[4 * g + 1] * r), pk2(a[4 * g + 2] * r, a[4 * g + 3] * r)};
            *(u32x2*)(Kn + (size_t)m * 512 + head * 64 + d0 + g * 8 + hi * 4) = w; }
        } else {
#pragma unroll
          for (int k = 0; k < 16; ++k) { const int dv = d0 - 64 + 8 * (k >> 2) + 4 * hi + (k & 3);
            Vt[((size_t)(b * 8 + head) * 64 + dv) * S + pos] = f2bf(acc[nt][mt][k] * r); }
        }
      }
    }
  }
};

struct EpiResid {
  float* x; char* smem;
  __device__ __forceinline__ void operator()(const f32x16 (&acc)[2][4], int m0, int n0, int wm, int wn, int r32, int hi) const {
    const int lane = r32 + 32 * hi, wid = wm * 4 + wn;
    float* wl = (float*)smem + wid * (32 * 68);
    const int c = lane & 15, rq = lane >> 4;
    float* xb = x + (size_t)(m0 + wm * 128 + rq) * 1024 + n0 + wn * 64 + c * 4;
    f32x4 xc[8], xn[8];
#pragma unroll
    for (int i = 0; i < 8; ++i) xc[i] = *(const f32x4*)(xb + (size_t)(4 * i) * 1024);
#pragma unroll
    for (int mt = 0; mt < 4; ++mt) {
      if (mt < 3) {
#pragma unroll
        for (int i = 0; i < 8; ++i) xn[i] = *(const f32x4*)(xb + (size_t)((mt + 1) * 32 + 4 * i) * 1024);
      }
#pragma unroll
      for (int nt = 0; nt < 2; ++nt)
#pragma unroll
        for (int g = 0; g < 4; ++g) { const f32x16& a = acc[nt][mt];
          f32x4 v = {a[4 * g], a[4 * g + 1], a[4 * g + 2], a[4 * g + 3]};
          *(f32x4*)(wl + r32 * 68 + nt * 32 + g * 8 + hi * 4) = v; }
      asm volatile("s_waitcnt lgkmcnt(0)" ::: "memory");
      f32x4 ov[8];
#pragma unroll
      for (int i = 0; i < 8; ++i) { const f32x4 a = *(const f32x4*)(wl + (rq + 4 * i) * 68 + c * 4); ov[i] = xc[i] * DN_ALPHA + a; }
#pragma unroll
      for (int i = 0; i < 8; ++i) *(f32x4*)(xb + (size_t)(mt * 32 + 4 * i) * 1024) = ov[i];
      asm volatile("s_waitcnt lgkmcnt(0)" ::: "memory");
#pragma unroll
      for (int i = 0; i < 8; ++i) xc[i] = xn[i];
    }
    __syncthreads();
  }
};

struct EpiGU {
  bf16_t* hid; char* smem;
  __device__ __forceinline__ void operator()(const f32x16 (&acc)[2][4], int m0, int n0, int wm, int wn, int r32, int hi) const {
    const int hb = (n0 + wn * 64) >> 1;
    const int lane = r32 + 32 * hi, wid = wm * 4 + wn;
    bf16_t* wl = (bf16_t*)smem + wid * (32 * 40);
    const int c = lane & 3, rq = lane >> 2;
#pragma unroll
    for (int mt = 0; mt < 4; ++mt) {
#pragma unroll
      for (int g = 0; g < 4; ++g) {
        float o[4];
#pragma unroll
        for (int i = 0; i < 4; ++i) { const float gt = acc[0][mt][4 * g + i], up = acc[1][mt][4 * g + i]; o[i] = gt * up * __builtin_amdgcn_rcpf(1.f + __builtin_amdgcn_exp2f(-1.4426950408889634f * gt)); }
        u32x2 w = {pk2(o[0], o[1]), pk2(o[2], o[3])};
        *(u32x2*)(wl + r32 * 40 + g * 8 + hi * 4) = w;
      }
      asm volatile("s_waitcnt lgkmcnt(0)" ::: "memory");
#pragma unroll
      for (int i = 0; i < 2; ++i) {
        const int rr = rq + 16 * i;
        const u32x4 v = *(const u32x4*)(wl + rr * 40 + c * 8);
        *(u32x4*)(hid + (size_t)(m0 + wm * 128 + mt * 32 + rr) * DFF + hb + c * 8) = v;
      }
      asm volatile("s_waitcnt lgkmcnt(0)" ::: "memory");
    }
    __syncthreads();
  }
};

namespace pg8 {
#define PG8_LAS __attribute__((address_space(3)))
typedef unsigned short bf16_t;
typedef short bf16x8 __attribute__((ext_vector_type(8)));
typedef float f32x4 __attribute__((ext_vector_type(4)));
typedef unsigned u32x4 __attribute__((ext_vector_type(4)));
constexpr int BM = 256, BK = 64, HALF = 128, HTB = HALF * BK * 2  , STAGE_BYTES = 8 * HTB, NXCD = 8, WGM = 8;

__host__ __device__ __forceinline__ int lds_byte(int r, int c) { const int st = (r >> 4) * 2 + (c >> 5), rr = r & 15, cc = c & 31, ob = rr * 64 + cc * 2; return st * 1024 + (ob ^ (((ob >> 9) & 1) << 5)); }
__host__ __device__ __forceinline__ void stage_rc(int b, int& R, int& C) { const int st = b / 1024, sb = b % 1024, swz = sb ^ (((sb >> 9) & 1) << 5); R = (st >> 1) * 16 + swz / 64; C = (st & 1) * 32 + (swz % 64) / 2; }
__host__ __device__ __forceinline__ int perm32(int rho) { const int n = rho >> 4, i = rho & 15; return 8 * (i >> 2) + 4 * n + (i & 3); }

struct Unit { int pm, pn; };
struct Gemm { const bf16_t* A; const bf16_t* Bt; int M, N, K, lda; };

struct StaticOrder {
    int nM, nN, nwg, G, c;
    __host__ __device__ void init(int M, int N, int G_, int c_) { nM = M / BM; nN = N / BM; nwg = nM * nN; G = G_; c = c_; }
    __host__ __device__ bool next(int i, Unit& u) const {
        const long L = (long)i * G + c; if (L >= nwg) return false;
        int wgid = (int)L; { const int q = nwg / NXCD, r = nwg % NXCD, xcd = wgid % NXCD, off = wgid / NXCD; wgid = (xcd < r ? xcd * (q + 1) : r * (q + 1) + (xcd - r) * q) + off; }
        const int nig = WGM * nN, gid = wgid / nig, fm = gid * WGM, gsz = (nM - fm) < WGM ? (nM - fm) : WGM;
        u.pm = fm + ((wgid % nig) % gsz); u.pn = (wgid % nig) / gsz; return true;
    }
    __device__ __forceinline__ void a_ready(const Unit&) const {}
    __device__ __forceinline__ void done(const Unit&) const {}
};


struct EpiInProj2 {
  static constexpr bool PERM = true, AFTER_DRAIN = false;
  bf16_t* proj; float* gates;
  __device__ __forceinline__ void operator()(const f32x4 (&acc)[2][2][4][2], const Unit& u, int wr, int wc, int fr, int fq) const {
#pragma unroll
    for (int ai = 0; ai < 2; ++ai)
#pragma unroll
      for (int m = 0; m < 4; ++m) { const size_t row = (size_t)u.pm * BM + ai * HALF + wr * 64 + m * 16 + fr;
#pragma unroll
        for (int bj = 0; bj < 2; ++bj) { const int col0 = u.pn * BM + bj * HALF + wc * 32 + 8 * fq; const f32x4 v0 = acc[ai][bj][m][0], v1 = acc[ai][bj][m][1];
          u32x4 w; w.x = pk2(v0[0], v0[1]); w.y = pk2(v0[2], v0[3]); w.z = pk2(v1[0], v1[1]); w.w = pk2(v1[2], v1[3]);
          *(u32x4*)(proj + row * NPROJ + col0) = w;
          if (col0 >= C_G && col0 < INW) { *(f32x4*)(gates + row * 16 + (col0 - C_G)) = v0; *(f32x4*)(gates + row * 16 + (col0 - C_G) + 4) = v1; } } }
  }
};
struct EpiResid2 {
  static constexpr bool PERM = false, AFTER_DRAIN = false;
  float* x; const f32x2* stats; const float* g; const float* b;
  __device__ __forceinline__ void operator()(const f32x4 (&acc)[2][2][4][2], const Unit& u, int wr, int wc, int fr, int fq) const {
    const int row0 = u.pm * BM + wr * 64 + fr, col0 = u.pn * BM + wc * 32 + 4 * fq;
    float* rb = x + (size_t)row0 * 1024 + col0;
#pragma unroll
    for (int ai = 0; ai < 2; ++ai)
#pragma unroll
      for (int m = 0; m < 4; ++m) {
        f32x4 xc[2][2]; const f32x2 sv = stats[row0 + ai * HALF + m * 16];
#pragma unroll
        for (int bj = 0; bj < 2; ++bj)
#pragma unroll
          for (int n = 0; n < 2; ++n) xc[bj][n] = *(const f32x4*)(rb + (size_t)(ai * HALF + m * 16) * 1024 + bj * HALF + n * 16);
#pragma unroll
        for (int bj = 0; bj < 2; ++bj)
#pragma unroll
          for (int n = 0; n < 2; ++n) { const f32x4 gv = *(const f32x4*)(g + col0 + bj * HALF + n * 16), bv = *(const f32x4*)(b + col0 + bj * HALF + n * 16);
            const f32x4 xn = (xc[bj][n] - sv[0]) * sv[1] * gv + bv;
            *(f32x4*)(rb + (size_t)(ai * HALF + m * 16) * 1024 + bj * HALF + n * 16) = xn * DN_ALPHA + acc[ai][bj][m][n]; }
        asm volatile("" ::: "memory");
      }
  }
};
struct EpiGU2 {
  static constexpr bool PERM = true, AFTER_DRAIN = false;
  bf16_t* hid;
  __device__ __forceinline__ void operator()(const f32x4 (&acc)[2][2][4][2], const Unit& u, int wr, int wc, int fr, int fq) const {
#pragma unroll
    for (int ai = 0; ai < 2; ++ai)
#pragma unroll
      for (int m = 0; m < 4; ++m) { const size_t row = (size_t)u.pm * BM + ai * HALF + wr * 64 + m * 16 + fr; float o[8];
#pragma unroll
        for (int n = 0; n < 2; ++n)
#pragma unroll
          for (int i = 0; i < 4; ++i) { const float gt = acc[ai][0][m][n][i], up = acc[ai][1][m][n][i]; o[4 * n + i] = gt * up * __builtin_amdgcn_rcpf(1.f + __builtin_amdgcn_exp2f(-1.4426950408889634f * gt)); }
        u32x4 w; w.x = pk2(o[0], o[1]); w.y = pk2(o[2], o[3]); w.z = pk2(o[4], o[5]); w.w = pk2(o[6], o[7]);
        *(u32x4*)(hid + row * DFF + u.pn * HALF + wc * 32 + 8 * fq) = w; }
  }
};
template <class Epi, class Sched, bool ALIGN_EPI = false, bool SP2 = false>
__device__ __forceinline__ void gemm_phase(PG8_LAS unsigned char* lds, const Gemm g, const Sched& S, const Epi& E) {
    const int tid = otid(), wid = __builtin_amdgcn_readfirstlane(tid >> 6), lane = tid & 63, wr = wid >> 2, wc = wid & 3, fr = lane & 15, fq = lane >> 4;
    const int K = g.K, nt = K / BK;
    unsigned voffA[2], voffB[2];
#pragma unroll
    for (int i = 0; i < 2; ++i) { int R, C; stage_rc(tid * 16 + i * 8192, R, C); const int Rb = Epi::PERM ? ((R & ~31) + perm32(R & 31)) : R;
        voffA[i] = (unsigned)(R * g.lda + C) * 2u; voffB[i] = (unsigned)(Rb * K + C) * 2u; }
    const size_t kstep = (size_t)(BK * 2);
    const size_t hstepB = (size_t)HALF * K * 2, hstepA = (size_t)HALF * g.lda * 2;
    const size_t tstepA = 2 * hstepA, tstepB = 2 * hstepB;
    const unsigned ldsw = (unsigned)wid * 1024u;
    const int aoff = lds_byte(wr * 64 + fr, fq * 8), boff = lds_byte(wc * 32 + fr, fq * 8);
#define PG8_SA(b, h) (((b) * 2 + (h)) * HTB)
#define PG8_SB(b, h) ((4 + (b) * 2 + (h)) * HTB)
#define PG8_STAGE(bufoff, gbase, voff) do { _Pragma("unroll") for (int _i = 0; _i < 2; ++_i) \
        __builtin_amdgcn_global_load_lds((const unsigned*)((const char*)(gbase) + (voff)[_i]), (PG8_LAS unsigned*)(lds + (bufoff) + ldsw + _i * 8192), 16, 0, 0); } while (0)
#define PG8_LDA(dst, b, h) do { _Pragma("unroll") for (int m = 0; m < 4; ++m) _Pragma("unroll") for (int k = 0; k < 2; ++k) dst[m][k] = *(const PG8_LAS bf16x8*)(lds + PG8_SA(b, h) + aoff + m * 2048 + k * 1024); } while (0)
#define PG8_LDB(dst, b, h) do { _Pragma("unroll") for (int n = 0; n < 2; ++n) _Pragma("unroll") for (int k = 0; k < 2; ++k) dst[n][k] = *(const PG8_LAS bf16x8*)(lds + PG8_SB(b, h) + boff + n * 2048 + k * 1024); } while (0)
#define PG8_MMA(ai, bj, At, Bt) do { __builtin_amdgcn_s_setprio(1); _Pragma("unroll") for (int m = 0; m < 4; ++m) _Pragma("unroll") for (int n = 0; n < 2; ++n) _Pragma("unroll") for (int k = 0; k < 2; ++k) \
        acc[ai][bj][m][n] = __builtin_amdgcn_mfma_f32_16x16x32_bf16(Bt[n][k], At[m][k], acc[ai][bj][m][n], 0, 0, 0); __builtin_amdgcn_s_setprio(0); } while (0)
#define PG8_WAIT_V(n) asm volatile("s_waitcnt vmcnt(" #n ")" ::: "memory")
#define PG8_WAIT_L(n) asm volatile("s_waitcnt lgkmcnt(" #n ")" ::: "memory")
#define PG8_BAR __builtin_amdgcn_s_barrier()
#define PG8_SCHED __builtin_amdgcn_sched_barrier(0)
    Unit cur, nxt; int ui = 0;
    if (!S.next(0, cur)) return;
    f32x4 acc[2][2][4][2];
#pragma unroll
    for (int a = 0; a < 2; ++a)
#pragma unroll
        for (int b = 0; b < 2; ++b)
#pragma unroll
            for (int m = 0; m < 4; ++m)
#pragma unroll
                for (int n = 0; n < 2; ++n) acc[a][b][m][n] = (f32x4){0.f, 0.f, 0.f, 0.f};
    bf16x8 At[4][2], B0[2][2], B1[2][2];
    const char* cA = (const char*)g.A + (size_t)cur.pm * tstepA; const char* cB = (const char*)g.Bt + (size_t)cur.pn * tstepB;
    S.a_ready(cur);
    if constexpr (SP2) {
        PG8_STAGE(PG8_SB(0, 0), cB, voffB); PG8_STAGE(PG8_SB(0, 1), cB + hstepB, voffB); PG8_STAGE(PG8_SA(0, 0), cA, voffA); PG8_STAGE(PG8_SA(0, 1), cA + hstepA, voffA);
        if (wr == 1) PG8_BAR;
        PG8_WAIT_V(2); PG8_BAR;
        PG8_STAGE(PG8_SB(1, 0), cB + kstep, voffB); PG8_STAGE(PG8_SA(1, 0), cA + kstep, voffA); PG8_STAGE(PG8_SB(1, 1), cB + hstepB + kstep, voffB);
        PG8_WAIT_V(6); PG8_BAR;
    } else {
        PG8_STAGE(PG8_SB(0, 0), cB, voffB); PG8_STAGE(PG8_SA(0, 0), cA, voffA); PG8_STAGE(PG8_SB(0, 1), cB + hstepB, voffB); PG8_STAGE(PG8_SA(0, 1), cA + hstepA, voffA);
        if (wr == 1) PG8_BAR;
        PG8_WAIT_V(4); PG8_BAR;
        PG8_STAGE(PG8_SB(1, 0), cB + kstep, voffB); PG8_STAGE(PG8_SA(1, 0), cA + kstep, voffA); PG8_STAGE(PG8_SB(1, 1), cB + hstepB + kstep, voffB);
        PG8_WAIT_V(6); PG8_BAR;
    }
    for (;;) {
        const bool has_next = S.next(ui + 1, nxt);
        const char* nA = has_next ? (const char*)g.A + (size_t)nxt.pm * tstepA : cA; const char* nB = has_next ? (const char*)g.Bt + (size_t)nxt.pn * tstepB : cB;
        for (int t = 0; t < nt; t += 2) {
            const bool last = (t == nt - 2);
            const char* a1 = cA + (size_t)(t + 1) * kstep;
            const char* a2 = last ? nA : cA + (size_t)(t + 2) * kstep; const char* b2 = last ? nB : cB + (size_t)(t + 2) * kstep;
            const char* a3 = a2 + kstep; const char* b3 = b2 + kstep;
            if (last && has_next) S.a_ready(nxt);
            if constexpr (SP2) {
            PG8_LDB(B0, 0, 0); PG8_LDB(B1, 0, 1); PG8_SCHED; PG8_LDA(At, 0, 0); PG8_STAGE(PG8_SA(1, 1), a1 + hstepA, voffA);
            PG8_WAIT_V(8); PG8_WAIT_L(0); PG8_BAR; PG8_MMA(0, 0, At, B0); PG8_MMA(0, 1, At, B1); PG8_BAR; PG8_SCHED;
            PG8_LDA(At, 0, 1); PG8_STAGE(PG8_SB(0, 0), b2, voffB); PG8_STAGE(PG8_SB(0, 1), b2 + hstepB, voffB); PG8_STAGE(PG8_SA(0, 0), a2, voffA);
            PG8_WAIT_V(8); PG8_WAIT_L(0); PG8_BAR; PG8_MMA(1, 0, At, B0); PG8_MMA(1, 1, At, B1); PG8_BAR; PG8_SCHED;
            PG8_LDB(B0, 1, 0); PG8_LDB(B1, 1, 1); PG8_SCHED; PG8_LDA(At, 1, 0); PG8_STAGE(PG8_SA(0, 1), a2 + hstepA, voffA);
            PG8_WAIT_V(8); PG8_WAIT_L(0); PG8_BAR; PG8_MMA(0, 0, At, B0); PG8_MMA(0, 1, At, B1); PG8_BAR; PG8_SCHED;
            PG8_LDA(At, 1, 1); PG8_STAGE(PG8_SB(1, 0), b3, voffB); PG8_STAGE(PG8_SB(1, 1), b3 + hstepB, voffB); PG8_STAGE(PG8_SA(1, 0), a3, voffA);
            PG8_WAIT_V(8); PG8_WAIT_L(0); PG8_BAR; PG8_MMA(1, 0, At, B0); PG8_MMA(1, 1, At, B1); PG8_BAR; PG8_SCHED;
            } else {
            PG8_LDB(B0, 0, 0); PG8_SCHED; PG8_LDA(At, 0, 0); PG8_STAGE(PG8_SA(1, 1), a1 + hstepA, voffA);
            PG8_WAIT_L(8); PG8_BAR; PG8_WAIT_L(0); PG8_MMA(0, 0, At, B0); PG8_BAR; PG8_SCHED;
            PG8_LDB(B1, 0, 1); PG8_STAGE(PG8_SB(0, 0), b2, voffB);
            PG8_BAR; PG8_WAIT_L(0); PG8_MMA(0, 1, At, B1); PG8_BAR;
            PG8_LDA(At, 0, 1); PG8_STAGE(PG8_SA(0, 0), a2, voffA);
            PG8_BAR; PG8_WAIT_L(0); PG8_MMA(1, 0, At, B0); PG8_BAR; PG8_SCHED;
            PG8_STAGE(PG8_SB(0, 1), b2 + hstepB, voffB);
            PG8_WAIT_V(6); PG8_BAR; PG8_MMA(1, 1, At, B1); PG8_BAR;
            PG8_LDB(B0, 1, 0); PG8_SCHED; PG8_LDA(At, 1, 0); PG8_STAGE(PG8_SA(0, 1), a2 + hstepA, voffA);
            PG8_WAIT_L(8); PG8_BAR; PG8_WAIT_L(0); PG8_MMA(0, 0, At, B0); PG8_BAR; PG8_SCHED;
            PG8_LDB(B1, 1, 1); PG8_STAGE(PG8_SB(1, 0), b3, voffB);
            PG8_BAR; PG8_WAIT_L(0); PG8_MMA(0, 1, At, B1); PG8_BAR;
            PG8_LDA(At, 1, 1); PG8_STAGE(PG8_SA(1, 0), a3, voffA);
            PG8_BAR; PG8_WAIT_L(0); PG8_MMA(1, 0, At, B0); PG8_BAR; PG8_SCHED;
            PG8_STAGE(PG8_SB(1, 1), b3 + hstepB, voffB);
            PG8_WAIT_V(6); PG8_BAR; PG8_MMA(1, 1, At, B1); PG8_BAR;
            }
        }
        if constexpr (ALIGN_EPI) { if (wr == 0) PG8_BAR; }
        if constexpr (!Epi::AFTER_DRAIN) { E(acc, cur, wr, wc, fr, fq); S.done(cur); }
        if (!has_next) break;
#pragma unroll
        for (int a = 0; a < 2; ++a)
#pragma unroll
            for (int b = 0; b < 2; ++b)
#pragma unroll
                for (int m = 0; m < 4; ++m)
#pragma unroll
                    for (int n = 0; n < 2; ++n) acc[a][b][m][n] = (f32x4){0.f, 0.f, 0.f, 0.f};
        cur = nxt; cA = nA; cB = nB; ++ui;
        if constexpr (ALIGN_EPI) { if (wr == 1) PG8_BAR; }
    }
    PG8_WAIT_V(0);
    if constexpr (!ALIGN_EPI) { if (wr == 0) PG8_BAR; }
    PG8_BAR;
    if constexpr (Epi::AFTER_DRAIN) { E.fused(acc, cur, wr, wc, fr, fq, lds, wid, lane); S.done(cur); }
#undef PG8_SA
#undef PG8_SB
#undef PG8_STAGE
#undef PG8_LDA
#undef PG8_LDB
#undef PG8_MMA
#undef PG8_WAIT_V
#undef PG8_WAIT_L
#undef PG8_BAR
#undef PG8_SCHED
}
}


__device__ __forceinline__ void row_rms(const bf16_t* A, int lda, int K, int m0, float* rs) {
  const int tid = otid(), row = tid >> 1, half = tid & 1;
  const bf16_t* p = A + (size_t)(m0 + row) * lda + half * (K >> 1);
  float s = 0.f;
  for (int i = 0; i < (K >> 4); ++i) { const u32x4 w = *(const u32x4*)(p + i * 8);
#pragma unroll
    for (int k = 0; k < 4; ++k) { const float a = bflo(w[k]), b = bfhi(w[k]); s += a * a + b * b; } }
  s += __shfl_xor(s, 1);
  if (half == 0) rs[row] = rsqrtf(s / (float)K + LN_EPS);
  __syncthreads();
}

constexpr int A_KS = 104, A_VS = 72;
constexpr int A_KBUF = 64 * A_KS, A_VBUF = 64 * A_VS;
constexpr float A_THR = 8.f;
__device__ void attn_unit(const bf16_t* __restrict__ Q, const bf16_t* __restrict__ Kn, const bf16_t* __restrict__ Vt, const bf16_t* __restrict__ KR,
                          bf16_t* __restrict__ Y, int S, int b, int h, int qb, char* smem) {
  const int tid = otid(), lane = tid & 63, wid = tid >> 6, r32 = lane & 31, hi = lane >> 5;
  bf16_t* Ks = (bf16_t*)smem; bf16_t* Vs = Ks + 2 * A_KBUF; float* wsf = (float*)(Vs + 2 * A_VBUF) + wid * 64;
  const size_t rowbase = (size_t)b * S;
  const int q0 = qb * 256 + wid * 32;
  bf16x8 qr[6];
  { const bf16_t* qp = Q + (rowbase + q0 + r32) * 768 + h * 96 + hi * 8;
#pragma unroll
    for (int d0 = 0; d0 < 6; ++d0) qr[d0] = *(const bf16x8*)(qp + d0 * 16); }
  const bf16_t* kn_src = Kn + (rowbase + (tid >> 3)) * 512 + h * 64 + (tid & 7) * 8;
  const bf16_t* kr_src = KR + (rowbase + (tid >> 2)) * 32 + (tid & 3) * 8;
  const bf16_t* v_src = Vt + ((size_t)(b * 8 + h) * 64 + (tid >> 3)) * S + (tid & 7) * 8;
  const int kn_dst = (tid >> 3) * A_KS + (tid & 7) * 8, kr_dst = (tid >> 2) * A_KS + 64 + (tid & 3) * 8, v_dst = (tid >> 3) * A_VS + (tid & 7) * 8;
  const bool has_kr = tid < 256;
  u32x4 sk, sr, sv;
#define A_LOAD(k0) do { sk = *(const u32x4*)(kn_src + (size_t)(k0) * 512); if (has_kr) sr = *(const u32x4*)(kr_src + (size_t)(k0) * 32); sv = *(const u32x4*)(v_src + (k0)); } while (0)
#define A_STORE(bf) do { *(u32x4*)(Ks + (bf) * A_KBUF + kn_dst) = sk; if (has_kr) *(u32x4*)(Ks + (bf) * A_KBUF + kr_dst) = sr; *(u32x4*)(Vs + (bf) * A_VBUF + v_dst) = sv; } while (0)
  float m_ref = 0.f; f32x16 o[2], lacc, negm; o[0] = f32x16{}; o[1] = f32x16{}; lacc = f32x16{}; negm = f32x16{};
  const bf16x8 ones = {(short)0x3F80, (short)0x3F80, (short)0x3F80, (short)0x3F80, (short)0x3F80, (short)0x3F80, (short)0x3F80, (short)0x3F80};
  const int NT = S >> 6;
  A_LOAD(0); A_STORE(0); __syncthreads();
  for (int j = 0; j < NT; ++j) {
    const int buf = j & 1;
    if (j + 1 < NT) A_LOAD((j + 1) * 64);
#ifndef A_SKEW
#define A_SKEW 1
#endif
    if (A_SKEW > 0 && wid >= 4) __builtin_amdgcn_s_sleep(A_SKEW);
    f32x16 p0, p1;
    bf16x8 vf[8];
    { const bf16_t* kb = Ks + buf * A_KBUF + r32 * A_KS + hi * 8;
      bf16x8 kf[12];
#pragma unroll
      for (int d0 = 0; d0 < 6; ++d0) { kf[2 * d0] = *(const bf16x8*)(kb + d0 * 16); kf[2 * d0 + 1] = *(const bf16x8*)(kb + 32 * A_KS + d0 * 16); }
      __builtin_amdgcn_sched_barrier(0);
      p0 = MFMA32(kf[0], qr[0], negm); p1 = MFMA32(kf[1], qr[0], negm);
#pragma unroll
      for (int d0 = 1; d0 < 6; ++d0) { p0 = MFMA32(kf[2 * d0], qr[d0], p0); p1 = MFMA32(kf[2 * d0 + 1], qr[d0], p1); }
      __builtin_amdgcn_sched_barrier(0);
      const bf16_t* vb = Vs + buf * A_VBUF + r32 * A_VS + hi * 8;
#pragma unroll
      for (int d0 = 0; d0 < 2; ++d0)
#pragma unroll
        for (int ks = 0; ks < 4; ++ks) vf[d0 * 4 + ks] = *(const bf16x8*)(vb + d0 * 32 * A_VS + ks * 16);
      __builtin_amdgcn_sched_barrier(0);
    }
#define MX3(a, b, c) __builtin_fmaxf(__builtin_fmaxf((a), (b)), (c))
    float pmax;
    { float a = MX3(p0[0], p0[1], p0[2]), b2 = MX3(p0[3], p0[4], p0[5]);
      a = MX3(a, p0[6], p0[7]); b2 = MX3(b2, p0[8], p0[9]); a = MX3(a, p0[10], p0[11]); b2 = MX3(b2, p0[12], p0[13]); a = MX3(a, p0[14], p0[15]);
      b2 = MX3(b2, p1[0], p1[1]); a = MX3(a, p1[2], p1[3]); b2 = MX3(b2, p1[4], p1[5]); a = MX3(a, p1[6], p1[7]); b2 = MX3(b2, p1[8], p1[9]);
      a = MX3(a, p1[10], p1[11]); b2 = MX3(b2, p1[12], p1[13]); a = MX3(a, p1[14], p1[15]); pmax = __builtin_fmaxf(a, b2); }
#undef MX3
    { auto rr = __builtin_amdgcn_permlane32_swap(__float_as_uint(pmax), __float_as_uint(pmax), false, false);
      pmax = fmaxf(__uint_as_float(rr[0]), __uint_as_float(rr[1])); }
    if (j == 0 || __any(pmax > A_THR)) {
      const float delta = (j == 0) ? pmax : fmaxf(pmax, 0.f);
#pragma unroll
      for (int r = 0; r < 16; ++r) { p0[r] -= delta; p1[r] -= delta; }
      m_ref += delta;
#pragma unroll
      for (int r = 0; r < 16; ++r) negm[r] = -m_ref;
      if (j > 0) {
        if (hi == 0) wsf[r32] = __builtin_amdgcn_exp2f(-delta);
        asm volatile("s_waitcnt lgkmcnt(0)" ::: "memory");
#pragma unroll
        for (int r = 0; r < 16; ++r) { const float f = wsf[crow(r, hi)]; o[0][r] *= f; o[1][r] *= f; lacc[r] *= f; }
        asm volatile("s_waitcnt lgkmcnt(0)" ::: "memory");
      }
    }
#pragma unroll
    for (int r = 0; r < 16; ++r) p0[r] = __builtin_amdgcn_exp2f(p0[r]);
#pragma unroll
    for (int r = 0; r < 16; ++r) p1[r] = __builtin_amdgcn_exp2f(p1[r]);
    bf16x8 pa0, pa1, pa2, pa3;
    PK4(p0, 0, pa0); PK4(p0, 8, pa1); PK4(p1, 0, pa2); PK4(p1, 8, pa3);
    __builtin_amdgcn_sched_barrier(0);
    o[0] = MFMA32(pa0, vf[0], o[0]); o[1] = MFMA32(pa0, vf[4], o[1]); lacc = MFMA32(pa0, ones, lacc);
    o[0] = MFMA32(pa1, vf[1], o[0]); o[1] = MFMA32(pa1, vf[5], o[1]); lacc = MFMA32(pa1, ones, lacc);
    o[0] = MFMA32(pa2, vf[2], o[0]); o[1] = MFMA32(pa2, vf[6], o[1]); lacc = MFMA32(pa2, ones, lacc);
    o[0] = MFMA32(pa3, vf[3], o[0]); o[1] = MFMA32(pa3, vf[7], o[1]); lacc = MFMA32(pa3, ones, lacc);
    __builtin_amdgcn_sched_barrier(0);
    if (j + 1 < NT) A_STORE(buf ^ 1);
    __syncthreads();
  }
#undef A_LOAD
#undef A_STORE
  bf16_t* yp = Y + (rowbase + q0) * 1024 + h * 64 + r32;
#pragma unroll
  for (int r = 0; r < 16; ++r) {
    const int orow = crow(r, hi); const float rl = 1.f / lacc[r];
    yp[(size_t)orow * 1024] = f2bf(o[0][r] * rl); yp[(size_t)orow * 1024 + 32] = f2bf(o[1][r] * rl);
  }
  __syncthreads();
}

__device__ void phase_pool_rope(const bf16_t* __restrict__ proj, bf16_t* __restrict__ Y, bf16_t* __restrict__ KR, const f32x2* __restrict__ rope, int S) {
  const int smask = S - 1;
  const int gtid = blockIdx.x * NTHR + otid(), gstr = gridDim.x * NTHR;
  for (int idx = gtid; idx < MT * 32; idx += gstr) {
    const int m = idx >> 5, c = idx & 31, g = c >> 3, w = 2 << g, pos = m & smask;
    int lo = pos - (w >> 1); if (lo < 0) lo = 0; int hi = pos + (w >> 1); if (hi > S) hi = S;
    const bf16_t* base = proj + (size_t)(m - pos) * NPROJ + C_POOL + c * 8;
    float s[8];
#pragma unroll
    for (int k = 0; k < 8; ++k) s[k] = 0.f;
    for (int t = lo; t < hi; ++t) { const u32x4 v = *(const u32x4*)(base + (size_t)t * NPROJ);
#pragma unroll
      for (int k = 0; k < 4; ++k) { s[2 * k] += bflo(v[k]); s[2 * k + 1] += bfhi(v[k]); } }
    const float rc = 1.f / (float)(hi - lo);
    const u32x4 xv = *(const u32x4*)(base + (size_t)pos * NPROJ);
    u32x4 o;
#pragma unroll
    for (int k = 0; k < 4; ++k) o[k] = pk2(s[2 * k] * rc - bflo(xv[k]), s[2 * k + 1] * rc - bfhi(xv[k]));
    *(u32x4*)(Y + (size_t)m * 1024 + 512 + c * 8) = o;
  }
  for (int idx = gtid; idx < MT * 16; idx += gstr) {
    const int m = idx >> 4, i = idx & 15, pos = m & smask;
    const float x1 = bf2f(proj[(size_t)m * NPROJ + C_KR + i]), x2 = bf2f(proj[(size_t)m * NPROJ + C_KR + 16 + i]);
    const f32x2 cs = rope[pos * 16 + i];
    KR[(size_t)m * 32 + i] = f2bf(x1 * cs[0] - x2 * cs[1]); KR[(size_t)m * 32 + 16 + i] = f2bf(x2 * cs[0] + x1 * cs[1]);
  }
}

__device__ __forceinline__ float logsigmoidf(float f) { return fminf(f, 0.f) - log1pf(__expf(-fabsf(f))); }
constexpr int ML_T = 136;
constexpr int ML_R = 72;

__device__ void mlstm_pass1(int cgi, int hh, const bf16_t* __restrict__ proj, const float* __restrict__ gates, const float* __restrict__ gbias,
                            float* __restrict__ stU, float* __restrict__ stN, float* __restrict__ stS, char* smem) {
  const int tid = otid(), lane = tid & 63, wid = tid >> 6, r32 = lane & 31, hi = lane >> 5;
  bf16_t* Vt = (bf16_t*)smem; bf16_t* Kw = Vt + 64 * ML_T;
  float* sc = (float*)(Kw + 2 * 64 * ML_T); float* lfs = sc; float* als = sc + 256; float* wss = sc + 512; float* red = sc + 768;
  const int item = cgi * 4 + hh; const size_t m0 = (size_t)cgi * 128;
  float ipre = 0.f;
  if (tid < 256) { const int dir = tid >> 7, s = tid & 127; const float* gp = gates + (m0 + s) * 16;
    ipre = gp[(2 * dir) * 4 + hh] + gbias[(2 * dir) * 4 + hh];
    const float f = gp[(2 * dir + 1) * 4 + hh] + gbias[(2 * dir + 1) * 4 + hh];
    lfs[tid] = logsigmoidf(f); }
  __syncthreads();
  if (tid < 256) { const int dir = tid >> 7, s = tid & 127; float b = 0.f;
#pragma unroll
    for (int t4 = 0; t4 < 32; ++t4) { const f32x4 v = *(const f32x4*)(lfs + dir * 128 + 4 * t4);
#pragma unroll
      for (int k = 0; k < 4; ++k) { const int t = 4 * t4 + k; const bool in = dir ? (t >= s) : (t <= s); b += in ? v[k] : 0.f; } }
    als[tid] = ipre - b;
    if (dir == 0 && s == 127) red[0] = b;
    if (dir == 1 && s == 0) red[1] = b; }
  __syncthreads();
  if (tid < 256) { const int dir = tid >> 7, s = tid & 127; float mx = als[dir * 128];
#pragma unroll
    for (int t4 = 0; t4 < 32; ++t4) { const f32x4 v = *(const f32x4*)(als + dir * 128 + 4 * t4); mx = fmaxf(fmaxf(mx, fmaxf(v[0], v[1])), fmaxf(v[2], v[3])); }
    wss[tid] = __expf(als[tid] - mx);
    if (s == 0) { stS[(size_t)(item * 2 + dir) * 4 + 0] = red[dir]; stS[(size_t)(item * 2 + dir) * 4 + 1] = mx; } }
  __syncthreads();
#pragma unroll
  for (int it = 0; it < 2; ++it) { const int idx = tid + NTHR * it, s = idx & 127, c = idx >> 7;
    const bf16_t* rp = proj + (m0 + s) * NPROJ + hh * 64 + c * 8;
    const u32x4 kc = *(const u32x4*)(rp + C_KM), vc = *(const u32x4*)(rp + C_VM);
    const float w0 = wss[s] * 0.125f, w1 = wss[128 + s] * 0.125f;
#pragma unroll
    for (int k = 0; k < 4; ++k) {
      const float ka = bflo(kc[k]), kb = bfhi(kc[k]);
      Kw[(8 * c + 2 * k) * ML_T + s] = f2bf(ka * w0); Kw[(8 * c + 2 * k + 1) * ML_T + s] = f2bf(kb * w0);
      Kw[64 * ML_T + (8 * c + 2 * k) * ML_T + s] = f2bf(ka * w1); Kw[64 * ML_T + (8 * c + 2 * k + 1) * ML_T + s] = f2bf(kb * w1);
      Vt[(8 * c + 2 * k) * ML_T + s] = (bf16_t)(vc[k] & 0xffffu); Vt[(8 * c + 2 * k + 1) * ML_T + s] = (bf16_t)(vc[k] >> 16);
    } }
  __syncthreads();
  { const int dir = wid >> 2, kb = (wid >> 1) & 1, vb = wid & 1;
    f32x16 acc = f32x16{};
    const bf16_t* ap = Kw + dir * 64 * ML_T + (kb * 32 + r32) * ML_T + hi * 8; const bf16_t* bp = Vt + (vb * 32 + r32) * ML_T + hi * 8;
#pragma unroll
    for (int ks = 0; ks < 8; ++ks) acc = MFMA32(*(const bf16x8*)(ap + ks * 16), *(const bf16x8*)(bp + ks * 16), acc);
    float* up = stU + (size_t)(item * 2 + dir) * 4096 + vb * 32 + r32;
#pragma unroll
    for (int r = 0; r < 16; ++r) up[(kb * 32 + crow(r, hi)) * 64] = acc[r]; }
  if (tid < 128) { const int dir = tid >> 6, kd = tid & 63; const bf16_t* kp = Kw + dir * 64 * ML_T + kd * ML_T; float s = 0.f;
    for (int t = 0; t < 128; ++t) s += bf2f(kp[t]);
    stN[(size_t)(item * 2 + dir) * 64 + kd] = s; }
  __syncthreads();
}

template <int EPT, int GS>
__device__ void mlstm_pass2(int ch, int part, int NC, float* __restrict__ stU, float* __restrict__ stN, float* __restrict__ stS) {
  const int tid = otid(); const int b = ch >> 3, hh = (ch >> 1) & 3, dir = ch & 1;
  const int e0 = part * (NTHR * EPT) + tid;
  const bool own_n = (part == 0) && (tid < 64);
  float sv[EPT], nv = 0.f, m = 0.f;
#pragma unroll
  for (int i = 0; i < EPT; ++i) sv[i] = 0.f;
  for (int st0 = 0; st0 < NC; st0 += GS) {
    float uu[GS][EPT], un[GS], bs[GS], ml[GS];
#pragma unroll
    for (int q = 0; q < GS; ++q) {
      const int step = st0 + q, c = dir ? (NC - 1 - step) : step;
      const size_t base = (size_t)(((b * NC + c) * 4 + hh) * 2 + dir);
      bs[q] = stS[base * 4 + 0]; ml[q] = stS[base * 4 + 1];
#pragma unroll
      for (int i = 0; i < EPT; ++i) uu[q][i] = stU[base * 4096 + e0 + NTHR * i];
      un[q] = own_n ? stN[base * 64 + tid] : 0.f;
    }
#pragma unroll
    for (int q = 0; q < GS; ++q) {
      const int step = st0 + q, c = dir ? (NC - 1 - step) : step;
      const size_t base = (size_t)(((b * NC + c) * 4 + hh) * 2 + dir);
      const float mnew = bs[q] + fmaxf(m, ml[q]);
      const float decay = __expf(m + bs[q] - mnew), uf = __expf(ml[q] + bs[q] - mnew);
#pragma unroll
      for (int i = 0; i < EPT; ++i) { stU[base * 4096 + e0 + NTHR * i] = sv[i]; sv[i] = decay * sv[i] + uf * uu[q][i]; }
      if (own_n) { stN[base * 64 + tid] = nv; nv = decay * nv + uf * un[q]; }
      if (part == 0 && tid == 0) stS[base * 4 + 2] = m;
      m = mnew;
    }
  }
}

__device__ void mlstm_pass3(int cgi, int hh, const bf16_t* __restrict__ proj, const float* __restrict__ gates, const float* __restrict__ gbias,
                            const float* __restrict__ norm_g, const float* __restrict__ stU, const float* __restrict__ stN, const float* __restrict__ stS,
                            bf16_t* __restrict__ Y, char* smem) {
  const int tid = otid(), lane = tid & 63, wid = tid >> 6, r32 = lane & 31, hi = lane >> 5;
  bf16_t* Kr = (bf16_t*)smem; bf16_t* Qr = Kr + 128 * ML_R; bf16_t* Vt = Qr + 128 * ML_R; bf16_t* Qf = Vt + 64 * ML_T;
  bf16_t* St = Qf + 2 * 128 * ML_R;
  float* H = (float*)(St + 2 * 64 * ML_R);
  float* sc = H + 128 * 64; float* lfs = sc; float* als = sc + 256; float* bbs = sc + 512; float* Mls = sc + 768; float* ffs = sc + 1024; float* dqs = sc + 1280;
  float* nss = sc + 1536;   float* invs = sc + 1664;
  const int item = cgi * 4 + hh; const size_t m0 = (size_t)cgi * 128;
  float ipre = 0.f;
  if (tid < 256) { const int dir = tid >> 7, s = tid & 127; const float* gp = gates + (m0 + s) * 16;
    ipre = gp[(2 * dir) * 4 + hh] + gbias[(2 * dir) * 4 + hh];
    const float f = gp[(2 * dir + 1) * 4 + hh] + gbias[(2 * dir + 1) * 4 + hh];
    lfs[tid] = logsigmoidf(f); }
  __syncthreads();
  if (tid < 256) { const int dir = tid >> 7, s = tid & 127; float b = 0.f;
#pragma unroll
    for (int t4 = 0; t4 < 32; ++t4) { const f32x4 v = *(const f32x4*)(lfs + dir * 128 + 4 * t4);
#pragma unroll
      for (int k = 0; k < 4; ++k) { const int t = 4 * t4 + k; const bool in = dir ? (t >= s) : (t <= s); b += in ? v[k] : 0.f; } }
    als[tid] = ipre - b; bbs[tid] = b; }
  else if (tid < 384) { const int dir = (tid - 256) >> 6, kd = tid & 63; nss[dir * 64 + kd] = stN[(size_t)(item * 2 + dir) * 64 + kd]; }
  __syncthreads();
  if (tid < 256) { const int dir = tid >> 7, s = tid & 127; const float mst = stS[(size_t)(item * 2 + dir) * 4 + 2]; float mx = mst;
#pragma unroll
    for (int t4 = 0; t4 < 32; ++t4) { const f32x4 v = *(const f32x4*)(als + dir * 128 + 4 * t4);
#pragma unroll
      for (int k = 0; k < 4; ++k) { const int t = 4 * t4 + k; const bool in = dir ? (t >= s) : (t <= s); mx = fmaxf(mx, in ? v[k] : -3.0e38f); } }
    Mls[tid] = mx; ffs[tid] = __expf(mst - mx); }
  __syncthreads();
#pragma unroll
  for (int it = 0; it < 2; ++it) {
    { const int idx = tid + NTHR * it, s = idx >> 3, c = idx & 7;
      const bf16_t* rp = proj + (m0 + s) * NPROJ + hh * 64 + c * 8;
      const u32x4 kc = *(const u32x4*)(rp + C_KM), qc = *(const u32x4*)(rp + C_QM);
      *(u32x4*)(Kr + s * ML_R + c * 8) = kc; *(u32x4*)(Qr + s * ML_R + c * 8) = qc;
      const float f0 = ffs[s], f1 = ffs[128 + s]; u32x4 q0, q1;
#pragma unroll
      for (int k = 0; k < 4; ++k) { const float a = bflo(qc[k]), b2 = bfhi(qc[k]); q0[k] = pk2(a * f0, b2 * f0); q1[k] = pk2(a * f1, b2 * f1); }
      *(u32x4*)(Qf + s * ML_R + c * 8) = q0; *(u32x4*)(Qf + 128 * ML_R + s * ML_R + c * 8) = q1; }
    { const int idx = tid + NTHR * it, s = idx & 127, c = idx >> 7;
      const u32x4 vc = *(const u32x4*)(proj + (m0 + s) * NPROJ + C_VM + hh * 64 + c * 8);
#pragma unroll
      for (int k = 0; k < 4; ++k) { Vt[(8 * c + 2 * k) * ML_T + s] = (bf16_t)(vc[k] & 0xffffu); Vt[(8 * c + 2 * k + 1) * ML_T + s] = (bf16_t)(vc[k] >> 16); } }
  }
#pragma unroll
  for (int dir = 0; dir < 2; ++dir) { const float* sp = stU + (size_t)(item * 2 + dir) * 4096;
#pragma unroll
    for (int it = 0; it < 8; ++it) { const int idx = tid + NTHR * it, d = idx >> 6, e = idx & 63; St[dir * 64 * ML_R + e * ML_R + d] = f2bf(sp[idx]); } }
  __syncthreads();
  if (tid < 256) { const int dir = tid >> 7, j = tid & 127; const bf16_t* qp = Qr + j * ML_R; float s = 0.f;
#pragma unroll
    for (int d8 = 0; d8 < 8; ++d8) { const u32x4 qv = *(const u32x4*)(qp + d8 * 8); const f32x4 n0 = *(const f32x4*)(nss + dir * 64 + d8 * 8), n1 = *(const f32x4*)(nss + dir * 64 + d8 * 8 + 4);
      s += bflo(qv[0]) * n0[0] + bfhi(qv[0]) * n0[1] + bflo(qv[1]) * n0[2] + bfhi(qv[1]) * n0[3] + bflo(qv[2]) * n1[0] + bfhi(qv[2]) * n1[1] + bflo(qv[3]) * n1[2] + bfhi(qv[3]) * n1[3]; }
    dqs[tid] = s * ffs[tid]; }
  __syncthreads();
  f32x16 o[2]; o[0] = f32x16{}; o[1] = f32x16{};
  const int dir = wid >> 2, jb = wid & 3;
  {
    const int jrow = 32 * jb + r32; const float Mj = Mls[dir * 128 + jrow]; float den = 0.f;
    const int st_lo = dir ? jb : 0, st_hi = dir ? 3 : jb;
    for (int st = st_lo; st <= st_hi; ++st) {
      f32x16 sc2 = f32x16{};
      const bf16_t* ap = Kr + (32 * st + r32) * ML_R + hi * 8; const bf16_t* bp = Qr + jrow * ML_R + hi * 8;
#pragma unroll
      for (int kk = 0; kk < 4; ++kk) sc2 = MFMA32(*(const bf16x8*)(ap + kk * 16), *(const bf16x8*)(bp + kk * 16), sc2);
      float pv[16];
#pragma unroll
      for (int r = 0; r < 16; ++r) { const int s = 32 * st + crow(r, hi); const bool valid = dir ? (s >= jrow) : (s <= jrow);
        const float x = fminf(als[dir * 128 + s] - Mj, 0.f); const float w = valid ? 0.125f * __expf(x) : 0.f;
        pv[r] = sc2[r] * w; den += pv[r]; }
      bf16x8 pa0, pa1; PK4(pv, 0, pa0); PK4(pv, 8, pa1);
#pragma unroll
      for (int d0 = 0; d0 < 2; ++d0) { const bf16_t* vp = Vt + (32 * d0 + r32) * ML_T + 32 * st + hi * 8;
        o[d0] = MFMA32(pa0, *(const bf16x8*)(vp), o[d0]); o[d0] = MFMA32(pa1, *(const bf16x8*)(vp + 16), o[d0]); }
    }
    { const bf16_t* ap = Qf + dir * 128 * ML_R + jrow * ML_R + hi * 8;
#pragma unroll
      for (int kk = 0; kk < 4; ++kk) { const bf16x8 a = *(const bf16x8*)(ap + kk * 16);
#pragma unroll
        for (int d0 = 0; d0 < 2; ++d0) o[d0] = MFMA32(a, *(const bf16x8*)(St + dir * 64 * ML_R + (32 * d0 + r32) * ML_R + kk * 16 + hi * 8), o[d0]); } }
    den += __shfl_xor(den, 32);
    den += dqs[dir * 128 + jrow];
    const float flo = __expf(-(bbs[dir * 128 + jrow] + Mj));
    const float inv = __builtin_amdgcn_rcpf(fmaxf(fabsf(den), flo));
    if (hi == 0) invs[wid * 32 + r32] = inv;
    asm volatile("s_waitcnt lgkmcnt(0)" ::: "memory");
  }
  if (dir == 0) {
#pragma unroll
    for (int r = 0; r < 16; ++r) { const int jr = crow(r, hi); const float iv = invs[wid * 32 + jr];
      H[(32 * jb + jr) * 64 + r32] = o[0][r] * iv; H[(32 * jb + jr) * 64 + 32 + r32] = o[1][r] * iv; }
  }
  __syncthreads();
  if (dir == 1) {
#pragma unroll
    for (int r = 0; r < 16; ++r) { const int jr = crow(r, hi); const float iv = invs[wid * 32 + jr];
      H[(32 * jb + jr) * 64 + r32] += o[0][r] * iv; H[(32 * jb + jr) * 64 + 32 + r32] += o[1][r] * iv; }
  }
  __syncthreads();
  { const int j = tid >> 2, qd = tid & 3; float hv[16]; float s = 0.f;
#pragma unroll
    for (int e = 0; e < 16; ++e) { hv[e] = H[j * 64 + qd * 16 + e]; s += hv[e]; }
    s += __shfl_xor(s, 1); s += __shfl_xor(s, 2);
    const float mu = s * (1.f / 64.f); float q = 0.f;
#pragma unroll
    for (int e = 0; e < 16; ++e) { const float d = hv[e] - mu; q += d * d; }
    q += __shfl_xor(q, 1); q += __shfl_xor(q, 2);
    const float rstd = rsqrtf(q * (1.f / 64.f) + LN_EPS);
    const bf16_t* op = proj + (m0 + j) * NPROJ + C_OM + hh * 64 + qd * 16;
    const u32x4 oa = *(const u32x4*)op, ob = *(const u32x4*)(op + 8);
    const float* ng = norm_g + hh * 64 + qd * 16;
    float y[16];
#pragma unroll
    for (int k = 0; k < 4; ++k) {
      const float g0 = bflo(oa[k]), g1 = bfhi(oa[k]), g2 = bflo(ob[k]), g3 = bfhi(ob[k]);
      y[2 * k] = (hv[2 * k] - mu) * rstd * ng[2 * k] * __builtin_amdgcn_rcpf(1.f + __builtin_amdgcn_exp2f(-1.4426950408889634f * g0));
      y[2 * k + 1] = (hv[2 * k + 1] - mu) * rstd * ng[2 * k + 1] * __builtin_amdgcn_rcpf(1.f + __builtin_amdgcn_exp2f(-1.4426950408889634f * g1));
      y[8 + 2 * k] = (hv[8 + 2 * k] - mu) * rstd * ng[8 + 2 * k] * __builtin_amdgcn_rcpf(1.f + __builtin_amdgcn_exp2f(-1.4426950408889634f * g2));
      y[8 + 2 * k + 1] = (hv[8 + 2 * k + 1] - mu) * rstd * ng[8 + 2 * k + 1] * __builtin_amdgcn_rcpf(1.f + __builtin_amdgcn_exp2f(-1.4426950408889634f * g3));
    }
    u32x4 w0 = {pk2(y[0], y[1]), pk2(y[2], y[3]), pk2(y[4], y[5]), pk2(y[6], y[7])}, w1 = {pk2(y[8], y[9]), pk2(y[10], y[11]), pk2(y[12], y[13]), pk2(y[14], y[15])};
    bf16_t* yp = Y + (m0 + j) * 1024 + 768 + hh * 64 + qd * 16;
    *(u32x4*)yp = w0; *(u32x4*)(yp + 8) = w1; }
  __syncthreads();
}

__device__ __forceinline__ bool tile_order(int i, int G, int c, int nM, int nN, int& pm, int& pn) {
  const int nwg = nM * nN; const long L = (long)i * G + c; if (L >= nwg) return false;
  int wgid = (int)L; { const int q = nwg / 8, r = nwg % 8, xcd = wgid % 8, off = wgid / 8; wgid = (xcd < r ? xcd * (q + 1) : r * (q + 1) + (xcd - r) * q) + off; }
  const int nig = 8 * nN, gid = wgid / nig, fm = gid * 8, gsz = (nM - fm) < 8 ? (nM - fm) : 8;
  pm = fm + ((wgid % nig) % gsz); pn = (wgid % nig) / gsz; return true;
}

#define XB_TMO      128
#define XB_XCNT(j)  (256  + 64 * (j))
#define XB_XSUB(j)  (1280 + 64 * (j))
#define XB_XGEN(j)  (2304 + 64 * (j))
#define XB_TOP      3328
#define XB_TOPGEN   3392
#define XCD_BAR_WORDS 3456
#define XB_SPIN_CAP (1u << 18)
#define LAS __attribute__((address_space(3)))

__device__ __forceinline__ unsigned xb_ld(unsigned* p)              { return __hip_atomic_load(p, __ATOMIC_RELAXED, __HIP_MEMORY_SCOPE_AGENT); }
__device__ __forceinline__ unsigned xb_add(unsigned* p, unsigned v) { return __hip_atomic_fetch_add(p, v, __ATOMIC_RELAXED, __HIP_MEMORY_SCOPE_AGENT); }
__device__ __forceinline__ unsigned xb_xcc_id() { return (unsigned)__builtin_amdgcn_s_getreg((3 << 11) | 20) & 0xFu; }
#define XB_SPIN(cond, bar) do { unsigned _sp = 0; while (cond) { __builtin_amdgcn_s_sleep(1); \
    if ((++_sp & 255u) == 0u) { if (xb_ld(&(bar)[XB_TMO])) break; if (_sp > XB_SPIN_CAP) { atomicAdd(&(bar)[XB_TMO], 1u); break; } } } } while (0)

struct XcdBarrier {
    unsigned* bar; unsigned x;
    volatile LAS unsigned* st;
};

__device__ __forceinline__ XcdBarrier xcd_barrier_post(unsigned* bar, volatile LAS unsigned* st) {
    XcdBarrier b; b.bar = bar; b.x = xb_xcc_id(); b.st = st;
    if (threadIdx.x == 0) (void)xb_add(&bar[XB_XCNT(b.x)], 1u);
    return b;
}
__device__ __forceinline__ void xcd_barrier_complete(unsigned* bar, unsigned x, unsigned& nloc, unsigned& nx) {
    const unsigned G = gridDim.x * gridDim.y * gridDim.z;
    unsigned sum, cnt, mine, sp = 0u;
    for (;;) {
        sum = 0u; cnt = 0u; mine = 0u;
#pragma unroll
        for (unsigned j = 0; j < 16; ++j) { const unsigned c = xb_ld(&bar[XB_XCNT(j)]); sum += c; cnt += (c > 0u) ? 1u : 0u; mine = (j == x) ? c : mine; }
        if (sum == G) break;
        __builtin_amdgcn_s_sleep(1);
        if ((++sp & 255u) == 0u) { if (xb_ld(&bar[XB_TMO])) break; if (sp > XB_SPIN_CAP) { atomicAdd(&bar[XB_TMO], 1u); break; } }
    }
    nloc = mine > 0u ? mine : 1u; nx = cnt > 0u ? cnt : 1u;
}

__device__ __forceinline__ void xcd_barrier(const XcdBarrier& b) {
    asm volatile("s_waitcnt vmcnt(0)" ::: "memory");
    __syncthreads();
    if (threadIdx.x == 0) {
        unsigned* bar = b.bar;
        __builtin_amdgcn_s_waitcnt(0);
        unsigned nloc = b.st[0], nx = b.st[1];
        if (nloc == 0u) { xcd_barrier_complete(bar, b.x, nloc, nx); b.st[0] = nloc; b.st[1] = nx; }
        const unsigned old = xb_add(&bar[XB_XSUB(b.x)], 1u);
        const unsigned gen = old / nloc;
        if (old + 1u == (gen + 1u) * nloc) {
            __builtin_amdgcn_fence(__ATOMIC_RELEASE, "agent");
            asm volatile("s_waitcnt vmcnt(0)" ::: "memory");
            const unsigned og = xb_add(&bar[XB_TOP], 1u);
            const unsigned tg = og / nx;
            if (og + 1u == (tg + 1u) * nx) xb_add(&bar[XB_TOPGEN], 1u);
            else XB_SPIN(xb_ld(&bar[XB_TOPGEN]) == tg, bar);
            __builtin_amdgcn_fence(__ATOMIC_ACQUIRE, "agent");
            xb_add(&bar[XB_XGEN(b.x)], 1u);
            asm volatile("s_waitcnt vmcnt(0)" ::: "memory");
        } else {
            XB_SPIN(xb_ld(&bar[XB_XGEN(b.x)]) == gen, bar);
            __builtin_amdgcn_fence(__ATOMIC_ACQUIRE, "agent");
            asm volatile("s_waitcnt vmcnt(0)" ::: "memory");
        }
    }
    __syncthreads();
}

constexpr int PH_PER_TRUNK = 1 + 8 * DEPTH, N_PHASES = 1 + 2 * PH_PER_TRUNK;

__device__ void run_phase(const Params& p, int ph, char* smem) {
  if (ph == 0) { if (blockIdx.x == 0) { const int t0 = otid();
      ((unsigned*)(p.ws + OFF_CNT))[t0] = 0u; ((unsigned*)(p.ws + OFF_CNT))[t0 + NTHR] = 0u;
      float* idv = (float*)(p.ws + OFF_ID); idv[t0] = 1.f; idv[t0 + NTHR] = 1.f; idv[1024 + t0] = 0.f; idv[1024 + t0 + NTHR] = 0.f; }
    phase_prep(p, smem); return; }
  const int tr = (ph - 1) / PH_PER_TRUNK, q = (ph - 1) % PH_PER_TRUNK;
  const int S = tr ? 2048 : 16384, slog = tr ? 11 : 14, nseq = tr ? 16 : 2;
  float* x32 = p.out + (size_t)tr * MT * 1024;
  unsigned char* ws = p.ws;
  bf16_t* XB = (bf16_t*)(ws + OFF_XB); bf16_t* Y = (bf16_t*)(ws + OFF_Y); bf16_t* PROJ = (bf16_t*)(ws + OFF_PROJ);
  bf16_t* Qb = (bf16_t*)(ws + OFF_Q); bf16_t* KN = (bf16_t*)(ws + OFF_KN); bf16_t* VT = (bf16_t*)(ws + OFF_VT); bf16_t* KR = (bf16_t*)(ws + OFF_KR);
  float* GATES = (float*)(ws + OFF_GATES); float* STU = (float*)(ws + OFF_STU); float* STN = (float*)(ws + OFF_STN); float* STS = (float*)(ws + OFF_STS);
  bf16_t* HID = (bf16_t*)(ws + OFF_HID); const f32x2* ROPE = (const f32x2*)(ws + OFF_ROPE);
  f32x2* STAT = (f32x2*)(ws + OFF_STAT); const float* IDV = (const float*)(ws + OFF_ID);
  if (q == 0) { phase_ln(p.in[tr], x32, XB, p.in[2], p.in[3], MT, STAT, true); return; }
  const int l = (q - 1) / 8, sub = (q - 1) % 8;
  const unsigned char* wl = ws + OFF_W + (size_t)l * W_LAYER;
  const int G = gridDim.x, B = blockIdx.x;
#ifdef ONLY_SUB
  switch (ONLY_SUB) {
#else
  switch (sub) {
#endif
    case 0: {
      pg8::Gemm g{XB, (const bf16_t*)(wl + W_IN), MT, NPROJ, 1024, 1024}; pg8::StaticOrder So; So.init(MT, NPROJ, G, B);
      pg8::EpiInProj2 E{PROJ, GATES};
      pg8::gemm_phase<pg8::EpiInProj2, pg8::StaticOrder, true, true>((PG8_LAS unsigned char*)smem, g, So, E);
    } break;
    case 1: {
      float* rs = (float*)(smem + G_SMEM_BYTES);
      for (int rep1 = 0; rep1 < REP_P1; ++rep1) {
      for (int i = 0, pm, pn; tile_order(i, G, B, 128, 3, pm, pn); ++i) {
        row_rms(PROJ + C_CQ, NPROJ, 256, pm * 256, rs); EpiQUp E{Qb, rs, ROPE, S - 1};
        gemm_tile(PROJ + C_CQ, NPROJ, (const bf16_t*)(wl + W_UQ), 256, pm * 256, pn * 256, smem, E);
        __syncthreads();
      }
      for (int i = 0, pm, pn; tile_order(i, G, B, 128, 4, pm, pn); ++i) {
        row_rms(PROJ + C_CKV, NPROJ, 128, pm * 256, rs); EpiKVUp E{KN, VT, rs, S, slog, S - 1};
        gemm_tile(PROJ + C_CKV, NPROJ, (const bf16_t*)(wl + W_UKV), 128, pm * 256, pn * 256, smem, E);
        __syncthreads();
      }
      phase_pool_rope(PROJ, Y, KR, ROPE, S);
      for (int t = B; t < 256 * 4; t += G) mlstm_pass1(t >> 2, t & 3, PROJ, GATES, p.in[11] + l * 16, STU, STN, STS, smem);
      }
    } break;
    case 2: {
      unsigned* cnt = (unsigned*)(ws + OFF_CNT) + (tr * DEPTH + l) * 64;
      if (B < 128) {
        if (tr == 0) mlstm_pass2<1, 32>(B >> 3, B & 7, S >> 7, STU, STN, STS); else mlstm_pass2<8, 4>(B, 0, S >> 7, STU, STN, STS);
        __builtin_amdgcn_fence(__ATOMIC_RELEASE, "agent");
        asm volatile("s_waitcnt vmcnt(0)" ::: "memory");
        __syncthreads();
        if (threadIdx.x == 0) __hip_atomic_fetch_add(cnt, 1u, __ATOMIC_RELEASE, __HIP_MEMORY_SCOPE_AGENT);
      }
      const int nqb = S >> 8;
      for (int t = B; t < 1024; t += G) { const int qb = t % nqb, bh = t / nqb; attn_unit(Qb, KN, VT, KR, Y, S, bh >> 3, bh & 7, qb, smem); }
      if (threadIdx.x == 0) { while (__hip_atomic_load(cnt, __ATOMIC_ACQUIRE, __HIP_MEMORY_SCOPE_AGENT) < 128u) __builtin_amdgcn_s_sleep(2); }
      __syncthreads();
      __builtin_amdgcn_fence(__ATOMIC_ACQUIRE, "agent");
      asm volatile("s_waitcnt vmcnt(0)" ::: "memory");
      for (int t = B; t < 256 * 4; t += G) mlstm_pass3(t >> 2, t & 3, PROJ, GATES, p.in[11] + l * 16, p.in[12] + l * 256, STU, STN, STS, Y, smem);
    } break;
    case 3: {
      pg8::Gemm g{Y, (const bf16_t*)(wl + W_OUT), MT, 1024, 1024, 1024}; pg8::StaticOrder So; So.init(MT, 1024, G, B);
      pg8::EpiResid2 E{x32, STAT, l ? p.in[19] + (l - 1) * 1024 : IDV, l ? p.in[20] + (l - 1) * 1024 : IDV + 1024};
      pg8::gemm_phase<pg8::EpiResid2, pg8::StaticOrder, true, true>((PG8_LAS unsigned char*)smem, g, So, E);
    } break;
    case 4: phase_ln(x32, nullptr, XB, p.in[14] + l * 1024, p.in[15] + l * 1024, MT, STAT, false); break;
    case 5: {
      pg8::Gemm g{XB, (const bf16_t*)(wl + W_GU), MT, NGU, 1024, 1024}; pg8::StaticOrder So; So.init(MT, NGU, G, B);
      pg8::EpiGU2 E{HID};
      pg8::gemm_phase<pg8::EpiGU2, pg8::StaticOrder, true, true>((PG8_LAS unsigned char*)smem, g, So, E);
    } break;
    case 6: {
      pg8::Gemm g{HID, (const bf16_t*)(wl + W_DN), MT, 1024, DFF, DFF}; pg8::StaticOrder So; So.init(MT, 1024, G, B);
      pg8::EpiResid2 E{x32, STAT, p.in[14] + l * 1024, p.in[15] + l * 1024};
      pg8::gemm_phase<pg8::EpiResid2, pg8::StaticOrder, true, true>((PG8_LAS unsigned char*)smem, g, So, E);
    } break;
    case 7: phase_ln(x32, (l == DEPTH - 1) ? x32 : nullptr, XB, p.in[19] + l * 1024, p.in[20] + l * 1024, MT, STAT, false); break;
  }
}

__global__ void __launch_bounds__(NTHR) fwd_kernel(Params p) {
  extern __shared__ __attribute__((aligned(16))) char smem[];
  cg::grid_group grid = cg::this_grid();
  volatile LAS unsigned* st = (volatile LAS unsigned*)((LAS unsigned char*)smem + (LDS_BYTES - 16));
  if (threadIdx.x < 2) st[threadIdx.x] = 0u;
  __syncthreads();
  XcdBarrier xb = xcd_barrier_post((unsigned*)(p.ws + OFF_XBAR), st);
  for (int ph = p.ph_lo; ph < p.ph_hi; ++ph) {
    run_phase(p, ph, smem);
    if (ph + 1 < p.ph_hi) {
      if (p.ph_hi < 0) grid.sync();
      xcd_barrier(xb);
    }
  }
}

extern "C" void kernel_launch(void* const* d_in, const int* in_sizes, int n_in, void* d_out, int out_size, void* d_ws, size_t ws_size, hipStream_t stream) {
  static int grid_blocks = 0;
  if (!grid_blocks) {
    int dev = 0, cus = 0, per_cu = 0;
    hipGetDevice(&dev);
    hipDeviceGetAttribute(&cus, hipDeviceAttributeMultiprocessorCount, dev);
    hipFuncSetAttribute((const void*)fwd_kernel, hipFuncAttributeMaxDynamicSharedMemorySize, LDS_BYTES);
    hipOccupancyMaxActiveBlocksPerMultiprocessor(&per_cu, (const void*)fwd_kernel, NTHR, LDS_BYTES);
    if (per_cu < 1) per_cu = 1;
    grid_blocks = cus * per_cu;
    if (ws_size < OFF_END) fprintf(stderr, "kernel_launch: workspace too small (%zu < %zu)\n", ws_size, (size_t)OFF_END);
  }
  Params p{};
  for (int i = 0; i < 21; ++i) p.in[i] = (const float*)d_in[i];
  p.out = (float*)d_out; p.ws = (unsigned char*)d_ws;
#if ONE_LAUNCH
  p.ph_lo = 0; p.ph_hi = N_PHASES;
  (void)hipMemsetAsync((char*)d_ws + OFF_XBAR, 0, XCD_BAR_WORDS * 4, stream);
  void* args[] = {&p};
  hipError_t e = hipLaunchCooperativeKernel((const void*)fwd_kernel, dim3(grid_blocks), dim3(NTHR), args, LDS_BYTES, stream);
  if (e != hipSuccess) fprintf(stderr, "cooperative launch failed: %s (grid %d)\n", hipGetErrorString(e), grid_blocks);
#else
  for (int ph = 0; ph < N_PHASES; ++ph) { p.ph_lo = ph; p.ph_hi = ph + 1; hipLaunchKernelGGL(fwd_kernel, dim3(grid_blocks), dim3(NTHR), LDS_BYTES, stream, p); }
#endif
}
```

```cpp
#include <hip/hip_runtime.h>
#include <hip/hip_cooperative_groups.h>
#include <stdint.h>
#include <stdio.h>
namespace cg = cooperative_groups;

#ifndef REP_P1
#define REP_P1 1
#endif
#ifndef REP_P3
#define REP_P3 1
#endif
#ifndef REP_LN
#define REP_LN 1
#endif
#ifndef ONE_LAUNCH
#define ONE_LAUNCH 1
#endif

typedef unsigned short bf16_t;
typedef short bf16x8 __attribute__((ext_vector_type(8)));
typedef float f32x16 __attribute__((ext_vector_type(16)));
typedef float f32x4 __attribute__((ext_vector_type(4)));
typedef float f32x2 __attribute__((ext_vector_type(2)));
typedef unsigned u32x4 __attribute__((ext_vector_type(4)));
typedef unsigned u32x2 __attribute__((ext_vector_type(2)));
typedef __bf16 bf16x2_t __attribute__((ext_vector_type(2)));

constexpr int DM = 1024, DEPTH = 4, MT = 32768;
constexpr int NPROJ = 1792, INW = 1712, DFF = 2816, NGU = 5632;
constexpr int C_CQ = 0, C_CKV = 256, C_KR = 384, C_POOL = 416, C_QM = 672, C_KM = 928, C_VM = 1184, C_OM = 1440, C_G = 1696;
constexpr float LN_EPS = 1e-5f;
constexpr float DN_ALPHA = 1.6817928305074290f;
constexpr float QSCALE = 0.10206207261596577f * 1.4426950408889634f;
constexpr int NTHR = 512;

constexpr size_t MiB = 1u << 20;
constexpr size_t W_IN = 0, W_UQ = W_IN + (size_t)NPROJ * 1024 * 2, W_UKV = W_UQ + 768 * 256 * 2, W_OUT = W_UKV + 1024 * 128 * 2,
                 W_GU = W_OUT + 1024 * 1024 * 2, W_DN = W_GU + (size_t)NGU * 1024 * 2, W_LAYER = W_DN + (size_t)1024 * DFF * 2;
static_assert(W_LAYER * 4 <= 96 * MiB, "weights");
constexpr size_t OFF_W = 0, OFF_ROPE = 96 * MiB, OFF_XB = 98 * MiB, OFF_Y = 162 * MiB, OFF_R = 226 * MiB;
constexpr size_t OFF_PROJ = OFF_R, OFF_Q = OFF_R + 112 * MiB, OFF_KN = OFF_Q + 48 * MiB, OFF_VT = OFF_KN + 32 * MiB, OFF_KR = OFF_VT + 32 * MiB,
                 OFF_GATES = OFF_KR + 2 * MiB, OFF_STU = OFF_GATES + 2 * MiB, OFF_STN = OFF_STU + 32 * MiB, OFF_STS = OFF_STN + 1 * MiB, OFF_END = OFF_STS + 1 * MiB;
constexpr size_t OFF_HID = OFF_R;
constexpr size_t OFF_CNT = OFF_END;
constexpr size_t OFF_XBAR = OFF_END + 4096;
constexpr size_t OFF_STAT = OFF_XBAR + 16384;
constexpr size_t OFF_ID = OFF_STAT + (size_t)MT * 8;
static_assert(OFF_ID + 8192 <= 512 * MiB, "ws");
static_assert(OFF_HID + (size_t)MT * DFF * 2 <= OFF_END, "hid");

constexpr int LDS_BYTES = 151552;

struct Params {
  const float* in[21];
  float* out;
  unsigned char* ws;
  int ph_lo, ph_hi;
};

__device__ __forceinline__ unsigned pk2(float lo, float hi) { f32x2 v = {lo, hi}; bf16x2_t b = __builtin_convertvector(v, bf16x2_t); return __builtin_bit_cast(unsigned, b); }
__device__ __forceinline__ bf16_t f2bf(float x) { return (bf16_t)(pk2(x, 0.f) & 0xffffu); }
__device__ __forceinline__ float bf2f(bf16_t b) { return __uint_as_float(((unsigned)b) << 16); }
__device__ __forceinline__ float bflo(unsigned w) { return __uint_as_float(w << 16); }
__device__ __forceinline__ float bfhi(unsigned w) { return __uint_as_float(w & 0xffff0000u); }
__device__ __forceinline__ int crow(int r, int hi) { return (r & 3) + 8 * (r >> 2) + 4 * hi; }
__device__ __forceinline__ float wave_sum(float v) {
  v += __shfl_xor(v, 32); v += __shfl_xor(v, 16); v += __shfl_xor(v, 8); v += __shfl_xor(v, 4); v += __shfl_xor(v, 2); v += __shfl_xor(v, 1); return v;
}
__device__ __forceinline__ int otid() { int t = threadIdx.x; asm volatile("" : "+v"(t)); return t; }
#define MFMA32(a, b, c) __builtin_amdgcn_mfma_f32_32x32x16_bf16((a), (b), (c), 0, 0, 0)
#define PK4(P, BASE, OUT) do { unsigned a0_ = pk2(P[BASE + 0], P[BASE + 1]), a1_ = pk2(P[BASE + 2], P[BASE + 3]);   \
    unsigned b0_ = pk2(P[BASE + 4], P[BASE + 5]), b1_ = pk2(P[BASE + 6], P[BASE + 7]);                              \
    auto r0_ = __builtin_amdgcn_permlane32_swap(a0_, b0_, false, false); auto r1_ = __builtin_amdgcn_permlane32_swap(a1_, b1_, false, false); \
    u32x4 w_ = {r0_[0], r1_[0], r0_[1], r1_[1]}; OUT = __builtin_bit_cast(bf16x8, w_); } while (0)

__device__ void prep_tile(const float* srcA, int colA, int limA, const float* srcB, int colB, int limB, int ld, int k0,
                          const float* kscale, float mul, bf16_t* dst, int ldd, int n0, float* tile) {
  const int tid = otid();
#pragma unroll
  for (int i = 0; i < 8; ++i) {
    const int kk = (tid >> 6) + 8 * i, nn = tid & 63;
    float v = 0.f;
    if (nn < 32) { const int c = colA + nn; if (c < limA) v = srcA[(size_t)(k0 + kk) * ld + c]; }
    else { const int c = colB + nn - 32; if (c < limB) v = srcB[(size_t)(k0 + kk) * ld + c]; }
    if (kscale) v *= kscale[k0 + kk];
    tile[kk * 65 + nn] = v * mul;
  }
  __syncthreads();
#pragma unroll
  for (int i = 0; i < 8; ++i) {
    const int nn = (tid >> 6) + 8 * i, kk = tid & 63;
    dst[(size_t)(n0 + nn) * ldd + k0 + kk] = f2bf(tile[kk * 65 + nn]);
  }
  __syncthreads();
}

__device__ void phase_prep(const Params& p, char* smem) {
  float* tile = (float*)smem;
  const int tid = otid();
  constexpr int N_IN = 28 * 16, N_UQ = 12 * 4, N_UKV = 16 * 2, N_OUT = 16 * 12, N_PF = 4 * 16, N_GU = 88 * 16, N_DN = 16 * 44;
  constexpr int PER_LAYER = N_IN + N_UQ + N_UKV + N_OUT + N_PF + N_GU + N_DN;
  constexpr int N_ROPE = 16384 * 16 / NTHR;
  const int total = PER_LAYER * DEPTH + N_ROPE;
  for (int it = blockIdx.x; it < total; it += gridDim.x) {
    if (it >= PER_LAYER * DEPTH) {
      const int e = (it - PER_LAYER * DEPTH) * NTHR + tid, pos = e >> 4, i = e & 15;
      const float inv = exp2f(-(float)i * (13.287712379549449f / 16.0f));
      const float ang = (float)pos * inv;
      double rev = (double)ang * 0.15915494309189535; rev -= floor(rev);
      const float fr = (float)rev;
      f32x2 cs = {__builtin_amdgcn_cosf(fr), __builtin_amdgcn_sinf(fr)};
      ((f32x2*)(p.ws + OFF_ROPE))[e] = cs;
      continue;
    }
    const int l = it / PER_LAYER; int j = it % PER_LAYER;
    unsigned char* wl = p.ws + OFF_W + (size_t)l * W_LAYER;
    if (j < N_IN) { const int nt = j / 16, kt = j % 16; const float* s = p.in[4] + (size_t)l * 1024 * INW;
      prep_tile(s, nt * 64, INW, s, nt * 64 + 32, INW, INW, kt * 64, nullptr, 1.f, (bf16_t*)(wl + W_IN), 1024, nt * 64, tile); continue; }
    j -= N_IN;
    if (j < N_UQ) { const int nt = j / 4, kt = j % 4; const float* s = p.in[6] + (size_t)l * 256 * 768;
      prep_tile(s, nt * 64, 768, s, nt * 64 + 32, 768, 768, kt * 64, p.in[5] + l * 256, QSCALE, (bf16_t*)(wl + W_UQ), 256, nt * 64, tile); continue; }
    j -= N_UQ;
    if (j < N_UKV) { const int nt = j / 2, kt = j % 2; const float* s = p.in[8] + (size_t)l * 128 * 1024;
      prep_tile(s, nt * 64, 1024, s, nt * 64 + 32, 1024, 1024, kt * 64, p.in[7] + l * 128, 1.f, (bf16_t*)(wl + W_UKV), 128, nt * 64, tile); continue; }
    j -= N_UKV;
    if (j < N_OUT) { const int nt = j / 12; int kt = j % 12; if (kt >= 8) kt += 4; const float* s = p.in[13] + (size_t)l * 1024 * 1024;
      prep_tile(s, nt * 64, 1024, s, nt * 64 + 32, 1024, 1024, kt * 64, nullptr, 1.f, (bf16_t*)(wl + W_OUT), 1024, nt * 64, tile); continue; }
    j -= N_OUT;
    if (j < N_PF) {
      const int g = j / 16, n0 = (j % 16) * 64, nn = tid & 63;
      const float* wo = p.in[13] + (size_t)l * 1024 * 1024 + (size_t)(512 + g * 64) * 1024 + n0 + nn;
      const float* wp = p.in[9] + (size_t)l * 4 * 64 * 64 + (size_t)g * 64 * 64;
      const float* ps = p.in[10] + l * 256 + g * 64;
      bf16_t* dst = (bf16_t*)(wl + W_OUT);
      for (int i = 0; i < 8; ++i) {
        const int c = (tid >> 6) + 8 * i; float s = 0.f;
        for (int d = 0; d < 64; ++d) s += wp[c * 64 + d] * ps[d] * wo[(size_t)d * 1024];
        dst[(size_t)(n0 + nn) * 1024 + 512 + g * 64 + c] = f2bf(s);
      }
      continue; }
    j -= N_PF;
    if (j < N_GU) { const int nt = j / 16, kt = j % 16, T = nt >> 2, sb = nt & 3;
      const float* s = ((sb < 2) ? p.in[16] : p.in[17]) + (size_t)l * 1024 * DFF; const int c0 = 128 * T + 64 * (sb & 1);
      prep_tile(s, c0, DFF, s, c0 + 32, DFF, DFF, kt * 64, nullptr, 1.f, (bf16_t*)(wl + W_GU), 1024, nt * 64, tile); continue; }
    j -= N_GU;
    { const int nt = j / 44, kt = j % 44; const float* s = p.in[18] + (size_t)l * DFF * 1024;
      prep_tile(s, nt * 64, 1024, s, nt * 64 + 32, 1024, 1024, kt * 64, nullptr, 1.f, (bf16_t*)(wl + W_DN), DFF, nt * 64, tile); }
  }
}

__device__ void phase_ln(const float* src, float* dst32, bf16_t* dstb, const float* g, const float* bta, int nrows, f32x2* stats, bool ident) {
  const int tid = otid(); const int lane = tid & 63, wid = tid >> 6;
  f32x4 gv[4], bv[4];
#pragma unroll
  for (int j = 0; j < 4; ++j) { gv[j] = *(const f32x4*)(g + j * 256 + lane * 4); bv[j] = *(const f32x4*)(bta + j * 256 + lane * 4); }
  const int rstride = gridDim.x * 8;
  for (int row0 = blockIdx.x * 8 + wid; row0 < nrows; row0 += 2 * rstride) {
    f32x4 v[2][4];
    const bool two = (row0 + rstride) < nrows;
#pragma unroll
    for (int j = 0; j < 4; ++j) v[0][j] = *(const f32x4*)(src + (size_t)row0 * 1024 + j * 256 + lane * 4);
    if (two) {
#pragma unroll
      for (int j = 0; j < 4; ++j) v[1][j] = *(const f32x4*)(src + (size_t)(row0 + rstride) * 1024 + j * 256 + lane * 4);
    }
#pragma unroll
    for (int u = 0; u < 2; ++u) {
      if (u == 1 && !two) break;
      const int row = row0 + u * rstride;
      float s = 0.f;
#pragma unroll
      for (int j = 0; j < 4; ++j) s += (v[u][j][0] + v[u][j][1]) + (v[u][j][2] + v[u][j][3]);
      const float mean = wave_sum(s) * (1.f / 1024.f);
      float q = 0.f;
#pragma unroll
      for (int j = 0; j < 4; ++j) { f32x4 d = v[u][j] - mean; q += (d[0] * d[0] + d[1] * d[1]) + (d[2] * d[2] + d[3] * d[3]); }
      const float rstd = rsqrtf(wave_sum(q) * (1.f / 1024.f) + LN_EPS);
      if (lane == 0) { f32x2 sv = {ident ? 0.f : mean, ident ? 1.f : rstd}; stats[row] = sv; }
#pragma unroll
      for (int j = 0; j < 4; ++j) {
        f32x4 o = (v[u][j] - mean) * rstd * gv[j] + bv[j];
        if (dst32) *(f32x4*)(dst32 + (size_t)row * 1024 + j * 256 + lane * 4) = o;
        u32x2 w = {pk2(o[0], o[1]), pk2(o[2], o[3])};
        *(u32x2*)(dstb + (size_t)row * 1024 + j * 256 + lane * 4) = w;
      }
    }
  }
}

constexpr int G_BUF = 256 * 64;
constexpr int G_SMEM_BYTES = 4 * G_BUF * 2;
#define LAS3 __attribute__((address_space(3)))

template <class Epi>
__device__ __forceinline__ void gemm_tile(const bf16_t* __restrict__ A, int lda, const bf16_t* __restrict__ Bt, int K, int m0, int n0, char* smem, const Epi& epi) {
  const int tid = otid(), lane = tid & 63, wid = tid >> 6, wm = wid >> 2, wn = wid & 3, r32 = lane & 31, hi = lane >> 5;
  LAS3 unsigned char* lds = (LAS3 unsigned char*)smem;
  const int rowl = wid * 8 + (lane >> 3), gch = (lane & 7) ^ ((rowl >> 1) & 7);
  const bf16_t* pa = A + (size_t)(m0 + rowl) * lda + gch * 8;
  const bf16_t* pb = Bt + (size_t)(n0 + rowl) * K + gch * 8;
  const size_t sa = (size_t)64 * lda, sb = (size_t)64 * K;
  const unsigned wbase = (unsigned)__builtin_amdgcn_readfirstlane(wid * 1024);
#define G_DMA(buf, k0) do { _Pragma("unroll") for (int j_ = 0; j_ < 4; ++j_) { \
    __builtin_amdgcn_global_load_lds((const unsigned*)(pa + j_ * sa + (k0)), (LAS3 unsigned*)(lds + (buf) * 32768 + j_ * 8192 + wbase), 16, 0, 0); \
    __builtin_amdgcn_global_load_lds((const unsigned*)(pb + j_ * sb + (k0)), (LAS3 unsigned*)(lds + 65536 + (buf) * 32768 + j_ * 8192 + wbase), 16, 0, 0); } } while (0)
  f32x16 acc[2][4];
#pragma unroll
  for (int a = 0; a < 2; ++a)
#pragma unroll
    for (int b = 0; b < 4; ++b) acc[a][b] = f32x16{};
  G_DMA(0, 0);
  asm volatile("s_waitcnt vmcnt(0)" ::: "memory");
  __syncthreads();
  const int nk = K >> 6;
  const int swz = (r32 >> 1) & 7;
  int koff[4];
#pragma unroll
  for (int kk = 0; kk < 4; ++kk) koff[kk] = ((kk * 2 + hi) ^ swz) * 16;
  const int aoff = (wm * 128 + r32) * 128, boff = 65536 + (wn * 64 + r32) * 128;
  for (int t = 0; t < nk; ++t) {
    const int buf = t & 1;
    if (t + 1 < nk) G_DMA(buf ^ 1, (t + 1) * 64);
    const LAS3 unsigned char* as = lds + buf * 32768 + aoff; const LAS3 unsigned char* bs = lds + buf * 32768 + boff;
    bf16x8 af[2][4], bfr[2][2];
#define G_LDF(S, KK) do { _Pragma("unroll") for (int mt = 0; mt < 4; ++mt) af[S][mt] = *(const LAS3 bf16x8*)(as + mt * 4096 + koff[KK]); \
      _Pragma("unroll") for (int nt = 0; nt < 2; ++nt) bfr[S][nt] = *(const LAS3 bf16x8*)(bs + nt * 4096 + koff[KK]); } while (0)
    G_LDF(0, 0);
#pragma unroll
    for (int kk = 0; kk < 4; ++kk) {
      if (kk < 3) G_LDF((kk + 1) & 1, kk + 1);
      __builtin_amdgcn_sched_barrier(0);
#pragma unroll
      for (int nt = 0; nt < 2; ++nt)
#pragma unroll
        for (int mt = 0; mt < 4; ++mt) acc[nt][mt] = MFMA32(bfr[kk & 1][nt], af[kk & 1][mt], acc[nt][mt]);
      __builtin_amdgcn_sched_barrier(0);
    }
#undef G_LDF
    asm volatile("s_waitcnt vmcnt(0)" ::: "memory");
    __syncthreads();
  }
#undef G_DMA
  epi(acc, m0, n0, wm, wn, r32, hi);
}

struct EpiInProj {
  bf16_t* proj; float* gates; char* smem;
  __device__ __forceinline__ void operator()(const f32x16 (&acc)[2][4], int m0, int n0, int wm, int wn, int r32, int hi) const {
    const int lane = r32 + 32 * hi, wid = wm * 4 + wn;
    bf16_t* wl = (bf16_t*)smem + wid * (32 * 72);
    const int c = lane & 7, rq = lane >> 3;
#pragma unroll
    for (int mt = 0; mt < 4; ++mt) {
      const int m = m0 + wm * 128 + mt * 32 + r32;
#pragma unroll
      for (int nt = 0; nt < 2; ++nt)
#pragma unroll
        for (int g = 0; g < 4; ++g) {
          const int nb = n0 + wn * 64 + nt * 32 + g * 8 + hi * 4;
          const f32x16& a = acc[nt][mt];
          u32x2 w = {pk2(a[4 * g], a[4 * g + 1]), pk2(a[4 * g + 2], a[4 * g + 3])};
          *(u32x2*)(wl + r32 * 72 + nt * 32 + g * 8 + hi * 4) = w;
          if (nb >= C_G && nb < INW) { f32x4 v = {a[4 * g], a[4 * g + 1], a[4 * g + 2], a[4 * g + 3]}; *(f32x4*)(gates + (size_t)m * 16 + (nb - C_G)) = v; }
        }
      asm volatile("s_waitcnt lgkmcnt(0)" ::: "memory");
#pragma unroll
      for (int i = 0; i < 4; ++i) {
        const int rr = rq + 8 * i;
        const u32x4 v = *(const u32x4*)(wl + rr * 72 + c * 8);
        *(u32x4*)(proj + (size_t)(m0 + wm * 128 + mt * 32 + rr) * NPROJ + n0 + wn * 64 + c * 8) = v;
      }
      asm volatile("s_waitcnt lgkmcnt(0)" ::: "memory");
    }
    __syncthreads();
  }
};

struct EpiQUp {
  bf16_t* Q; const float* rs; const f32x2* rope; int smask;
  __device__ __forceinline__ void operator()(const f32x16 (&acc)[2][4], int m0, int n0, int wm, int wn, int r32, int hi) const {
#pragma unroll
    for (int mt = 0; mt < 4; ++mt) {
      const int ml = wm * 128 + mt * 32 + r32, m = m0 + ml; const float r = rs[ml]; const int pos = m & smask;
#pragma unroll
      for (int nt = 0; nt < 2; ++nt) {
        const int nb0 = n0 + wn * 64 + nt * 32; const int t32 = nb0 >> 5; const bool isrope = (t32 % 3) == 2;
        float v[16];
#pragma unroll
        for (int k = 0; k < 16; ++k) v[k] = acc[nt][mt][k] * r;
        if (isrope) {
#pragma unroll
          for (int g = 0; g < 2; ++g)
#pragma unroll
            for (int i = 0; i < 4; ++i) {
              const int dd = 8 * g + 4 * hi + i; const f32x2 cs = rope[pos * 16 + dd];
              const float x1 = v[4 * g + i], x2 = v[4 * g + i + 8];
              v[4 * g + i] = x1 * cs[0] - x2 * cs[1]; v[4 * g + i + 8] = x2 * cs[0] + x1 * cs[1];
            }
        }
#pragma unroll
        for (int g = 0; g < 4; ++g) { u32x2 w = {pk2(v[4 * g], v[4 * g + 1]), pk2(v[4 * g + 2], v[4 * g + 3])}; *(u32x2*)(Q + (size_t)m * 768 + nb0 + g * 8 + hi * 4) = w; }
      }
    }
  }
};

struct EpiKVUp {
  bf16_t* Kn; bf16_t* Vt; const float* rs; int S, slog, smask;
  __device__ __forceinline__ void operator()(const f32x16 (&acc)[2][4], int m0, int n0, int wm, int wn, int r32, int hi) const {
#pragma unroll
    for (int mt = 0; mt < 4; ++mt) {
      const int ml = wm * 128 + mt * 32 + r32, m = m0 + ml; const float r = rs[ml]; const int pos = m & smask, b = m >> slog;
#pragma unroll
      for (int nt = 0; nt < 2; ++nt) {
        const int nb0 = n0 + wn * 64 + nt * 32; const int head = nb0 >> 7, d0 = nb0 & 127;
        if (d0 < 64) {
#pragma unroll
          for (int g = 0; g < 4; ++g) { const f32x16& a = acc[nt][mt];
            u32x2 w = {pk2(a[4 * g] * r, a[4 * g + 1] * r), pk2(a[4 * g + 2] * r, a[4 * g + 3] * r)};
            *(u32x2*)(Kn + (size_t)m * 512 + head * 64 + d0 + g * 8 + hi * 4) = w; }
        } else {
#pragma unroll
          for (int k = 0; k < 16; ++k) { const int dv = d0 - 64 + 8 * (k >> 2) + 4 * hi + (k & 3);
            Vt[((size_t)(b * 8 + head) * 64 + dv) * S + pos] = f2bf(acc[nt][mt][k] * r); }
        }
      }
    }
  }
};

struct EpiResid {
  float* x; char* smem;
  __device__ __forceinline__ void operator()(const f32x16 (&acc)[2][4], int m0, int n0, int wm, int wn, int r32, int hi) const {
    const int lane = r32 + 32 * hi, wid = wm * 4 + wn;
    float* wl = (float*)smem + wid * (32 * 68);
    const int c = lane & 15, rq = lane >> 4;
    float* xb = x + (size_t)(m0 + wm * 128 + rq) * 1024 + n0 + wn * 64 + c * 4;
    f32x4 xc[8], xn[8];
#pragma unroll
    for (int i = 0; i < 8; ++i) xc[i] = *(const f32x4*)(xb + (size_t)(4 * i) * 1024);
#pragma unroll
    for (int mt = 0; mt < 4; ++mt) {
      if (mt < 3) {
#pragma unroll
        for (int i = 0; i < 8; ++i) xn[i] = *(const f32x4*)(xb + (size_t)((mt + 1) * 32 + 4 * i) * 1024);
      }
#pragma unroll
      for (int nt = 0; nt < 2; ++nt)
#pragma unroll
        for (int g = 0; g < 4; ++g) { const f32x16& a = acc[nt][mt];
          f32x4 v = {a[4 * g], a[4 * g + 1], a[4 * g + 2], a[4 * g + 3]};
          *(f32x4*)(wl + r32 * 68 + nt * 32 + g * 8 + hi * 4) = v; }
      asm volatile("s_waitcnt lgkmcnt(0)" ::: "memory");
      f32x4 ov[8];
#pragma unroll
      for (int i = 0; i < 8; ++i) { const f32x4 a = *(const f32x4*)(wl + (rq + 4 * i) * 68 + c * 4); ov[i] = xc[i] * DN_ALPHA + a; }
#pragma unroll
      for (int i = 0; i < 8; ++i) *(f32x4*)(xb + (size_t)(mt * 32 + 4 * i) * 1024) = ov[i];
      asm volatile("s_waitcnt lgkmcnt(0)" ::: "memory");
#pragma unroll
      for (int i = 0; i < 8; ++i) xc[i] = xn[i];
    }
    __syncthreads();
  }
};

struct EpiGU {
  bf16_t* hid; char* smem;
  __device__ __forceinline__ void operator()(const f32x16 (&acc)[2][4], int m0, int n0, int wm, int wn, int r32, int hi) const {
    const int hb = (n0 + wn * 64) >> 1;
    const int lane = r32 + 32 * hi, wid = wm * 4 + wn;
    bf16_t* wl = (bf16_t*)smem + wid * (32 * 40);
    const int c = lane & 3, rq = lane >> 2;
#pragma unroll
    for (int mt = 0; mt < 4; ++mt) {
#pragma unroll
      for (int g = 0; g < 4; ++g) {
        float o[4];
#pragma unroll
        for (int i = 0; i < 4; ++i) { const float gt = acc[0][mt][4 * g + i], up = acc[1][mt][4 * g + i]; o[i] = gt * up * __builtin_amdgcn_rcpf(1.f + __builtin_amdgcn_exp2f(-1.4426950408889634f * gt)); }
        u32x2 w = {pk2(o[0], o[1]), pk2(o[2], o[3])};
        *(u32x2*)(wl + r32 * 40 + g * 8 + hi * 4) = w;
      }
      asm volatile("s_waitcnt lgkmcnt(0)" ::: "memory");
#pragma unroll
      for (int i = 0; i < 2; ++i) {
        const int rr = rq + 16 * i;
        const u32x4 v = *(const u32x4*)(wl + rr * 40 + c * 8);
        *(u32x4*)(hid + (size_t)(m0 + wm * 128 + mt * 32 + rr) * DFF + hb + c * 8) = v;
      }
      asm volatile("s_waitcnt lgkmcnt(0)" ::: "memory");
    }
    __syncthreads();
  }
};

namespace pg8 {
#define PG8_LAS __attribute__((address_space(3)))
typedef unsigned short bf16_t;
typedef short bf16x8 __attribute__((ext_vector_type(8)));
typedef float f32x4 __attribute__((ext_vector_type(4)));
typedef unsigned u32x4 __attribute__((ext_vector_type(4)));
constexpr int BM = 256, BK = 64, HALF = 128, HTB = HALF * BK * 2  , STAGE_BYTES = 8 * HTB, NXCD = 8, WGM = 8;

__host__ __device__ __forceinline__ int lds_byte(int r, int c) { const int st = (r >> 4) * 2 + (c >> 5), rr = r & 15, cc = c & 31, ob = rr * 64 + cc * 2; return st * 1024 + (ob ^ (((ob >> 9) & 1) << 5)); }
__host__ __device__ __forceinline__ void stage_rc(int b, int& R, int& C) { const int st = b / 1024, sb = b % 1024, swz = sb ^ (((sb >> 9) & 1) << 5); R = (st >> 1) * 16 + swz / 64; C = (st & 1) * 32 + (swz % 64) / 2; }
__host__ __device__ __forceinline__ int perm32(int rho) { const int n = rho >> 4, i = rho & 15; return 8 * (i >> 2) + 4 * n + (i & 3); }

struct Unit { int pm, pn; };
struct Gemm { const bf16_t* A; const bf16_t* Bt; int M, N, K, lda; };

struct StaticOrder {
    int nM, nN, nwg, G, c;
    __host__ __device__ void init(int M, int N, int G_, int c_) { nM = M / BM; nN = N / BM; nwg = nM * nN; G = G_; c = c_; }
    __host__ __device__ bool next(int i, Unit& u) const {
        const long L = (long)i * G + c; if (L >= nwg) return false;
        int wgid = (int)L; { const int q = nwg / NXCD, r = nwg % NXCD, xcd = wgid % NXCD, off = wgid / NXCD; wgid = (xcd < r ? xcd * (q + 1) : r * (q + 1) + (xcd - r) * q) + off; }
        const int nig = WGM * nN, gid = wgid / nig, fm = gid * WGM, gsz = (nM - fm) < WGM ? (nM - fm) : WGM;
        u.pm = fm + ((wgid % nig) % gsz); u.pn = (wgid % nig) / gsz; return true;
    }
    __device__ __forceinline__ void a_ready(const Unit&) const {}
    __device__ __forceinline__ void done(const Unit&) const {}
};


struct EpiInProj2 {
  static constexpr bool PERM = true, AFTER_DRAIN = false;
  bf16_t* proj; float* gates;
  __device__ __forceinline__ void operator()(const f32x4 (&acc)[2][2][4][2], const Unit& u, int wr, int wc, int fr, int fq) const {
#pragma unroll
    for (int ai = 0; ai < 2; ++ai)
#pragma unroll
      for (int m = 0; m < 4; ++m) { const size_t row = (size_t)u.pm * BM + ai * HALF + wr * 64 + m * 16 + fr;
#pragma unroll
        for (int bj = 0; bj < 2; ++bj) { const int col0 = u.pn * BM + bj * HALF + wc * 32 + 8 * fq; const f32x4 v0 = acc[ai][bj][m][0], v1 = acc[ai][bj][m][1];
          u32x4 w; w.x = pk2(v0[0], v0[1]); w.y = pk2(v0[2], v0[3]); w.z = pk2(v1[0], v1[1]); w.w = pk2(v1[2], v1[3]);
          *(u32x4*)(proj + row * NPROJ + col0) = w;
          if (col0 >= C_G && col0 < INW) { *(f32x4*)(gates + row * 16 + (col0 - C_G)) = v0; *(f32x4*)(gates + row * 16 + (col0 - C_G) + 4) = v1; } } }
  }
};
struct EpiResid2 {
  static constexpr bool PERM = false, AFTER_DRAIN = false;
  float* x; const f32x2* stats; const float* g; const float* b;
  __device__ __forceinline__ void operator()(const f32x4 (&acc)[2][2][4][2], const Unit& u, int wr, int wc, int fr, int fq) const {
    const int row0 = u.pm * BM + wr * 64 + fr, col0 = u.pn * BM + wc * 32 + 4 * fq;
    float* rb = x + (size_t)row0 * 1024 + col0;
#pragma unroll
    for (int ai = 0; ai < 2; ++ai)
#pragma unroll
      for (int m = 0; m < 4; ++m) {
        f32x4 xc[2][2]; const f32x2 sv = stats[row0 + ai * HALF + m * 16];
#pragma unroll
        for (int bj = 0; bj < 2; ++bj)
#pragma unroll
          for (int n = 0; n < 2; ++n) xc[bj][n] = *(const f32x4*)(rb + (size_t)(ai * HALF + m * 16) * 1024 + bj * HALF + n * 16);
#pragma unroll
        for (int bj = 0; bj < 2; ++bj)
#pragma unroll
          for (int n = 0; n < 2; ++n) { const f32x4 gv = *(const f32x4*)(g + col0 + bj * HALF + n * 16), bv = *(const f32x4*)(b + col0 + bj * HALF + n * 16);
            const f32x4 xn = (xc[bj][n] - sv[0]) * sv[1] * gv + bv;
            *(f32x4*)(rb + (size_t)(ai * HALF + m * 16) * 1024 + bj * HALF + n * 16) = xn * DN_ALPHA + acc[ai][bj][m][n]; }
        asm volatile("" ::: "memory");
      }
  }
};
struct EpiGU2 {
  static constexpr bool PERM = true, AFTER_DRAIN = false;
  bf16_t* hid;
  __device__ __forceinline__ void operator()(const f32x4 (&acc)[2][2][4][2], const Unit& u, int wr, int wc, int fr, int fq) const {
#pragma unroll
    for (int ai = 0; ai < 2; ++ai)
#pragma unroll
      for (int m = 0; m < 4; ++m) { const size_t row = (size_t)u.pm * BM + ai * HALF + wr * 64 + m * 16 + fr; float o[8];
#pragma unroll
        for (int n = 0; n < 2; ++n)
#pragma unroll
          for (int i = 0; i < 4; ++i) { const float gt = acc[ai][0][m][n][i], up = acc[ai][1][m][n][i]; o[4 * n + i] = gt * up * __builtin_amdgcn_rcpf(1.f + __builtin_amdgcn_exp2f(-1.4426950408889634f * gt)); }
        u32x4 w; w.x = pk2(o[0], o[1]); w.y = pk2(o[2], o[3]); w.z = pk2(o[4], o[5]); w.w = pk2(o[6], o[7]);
        *(u32x4*)(hid + row * DFF + u.pn * HALF + wc * 32 + 8 * fq) = w; }
  }
};
template <class Epi, class Sched, bool ALIGN_EPI = false, bool SP2 = false>
__device__ __forceinline__ void gemm_phase(PG8_LAS unsigned char* lds, const Gemm g, const Sched& S, const Epi& E) {
    const int tid = otid(), wid = __builtin_amdgcn_readfirstlane(tid >> 6), lane = tid & 63, wr = wid >> 2, wc = wid & 3, fr = lane & 15, fq = lane >> 4;
    const int K = g.K, nt = K / BK;
    unsigned voffA[2], voffB[2];
#pragma unroll
    for (int i = 0; i < 2; ++i) { int R, C; stage_rc(tid * 16 + i * 8192, R, C); const int Rb = Epi::PERM ? ((R & ~31) + perm32(R & 31)) : R;
        voffA[i] = (unsigned)(R * g.lda + C) * 2u; voffB[i] = (unsigned)(Rb * K + C) * 2u; }
    const size_t kstep = (size_t)(BK * 2);
    const size_t hstepB = (size_t)HALF * K * 2, hstepA = (size_t)HALF * g.lda * 2;
    const size_t tstepA = 2 * hstepA, tstepB = 2 * hstepB;
    const unsigned ldsw = (unsigned)wid * 1024u;
    const int aoff = lds_byte(wr * 64 + fr, fq * 8), boff = lds_byte(wc * 32 + fr, fq * 8);
#define PG8_SA(b, h) (((b) * 2 + (h)) * HTB)
#define PG8_SB(b, h) ((4 + (b) * 2 + (h)) * HTB)
#define PG8_STAGE(bufoff, gbase, voff) do { _Pragma("unroll") for (int _i = 0; _i < 2; ++_i) \
        __builtin_amdgcn_global_load_lds((const unsigned*)((const char*)(gbase) + (voff)[_i]), (PG8_LAS unsigned*)(lds + (bufoff) + ldsw + _i * 8192), 16, 0, 0); } while (0)
#define PG8_LDA(dst, b, h) do { _Pragma("unroll") for (int m = 0; m < 4; ++m) _Pragma("unroll") for (int k = 0; k < 2; ++k) dst[m][k] = *(const PG8_LAS bf16x8*)(lds + PG8_SA(b, h) + aoff + m * 2048 + k * 1024); } while (0)
#define PG8_LDB(dst, b, h) do { _Pragma("unroll") for (int n = 0; n < 2; ++n) _Pragma("unroll") for (int k = 0; k < 2; ++k) dst[n][k] = *(const PG8_LAS bf16x8*)(lds + PG8_SB(b, h) + boff + n * 2048 + k * 1024); } while (0)
#define PG8_MMA(ai, bj, At, Bt) do { __builtin_amdgcn_s_setprio(1); _Pragma("unroll") for (int m = 0; m < 4; ++m) _Pragma("unroll") for (int n = 0; n < 2; ++n) _Pragma("unroll") for (int k = 0; k < 2; ++k) \
        acc[ai][bj][m][n] = __builtin_amdgcn_mfma_f32_16x16x32_bf16(Bt[n][k], At[m][k], acc[ai][bj][m][n], 0, 0, 0); __builtin_amdgcn_s_setprio(0); } while (0)
#define PG8_WAIT_V(n) asm volatile("s_waitcnt vmcnt(" #n ")" ::: "memory")
#define PG8_WAIT_L(n) asm volatile("s_waitcnt lgkmcnt(" #n ")" ::: "memory")
#define PG8_BAR __builtin_amdgcn_s_barrier()
#define PG8_SCHED __builtin_amdgcn_sched_barrier(0)
    Unit cur, nxt; int ui = 0;
    if (!S.next(0, cur)) return;
    f32x4 acc[2][2][4][2];
#pragma unroll
    for (int a = 0; a < 2; ++a)
#pragma unroll
        for (int b = 0; b < 2; ++b)
#pragma unroll
            for (int m = 0; m < 4; ++m)
#pragma unroll
                for (int n = 0; n < 2; ++n) acc[a][b][m][n] = (f32x4){0.f, 0.f, 0.f, 0.f};
    bf16x8 At[4][2], B0[2][2], B1[2][2];
    const char* cA = (const char*)g.A + (size_t)cur.pm * tstepA; const char* cB = (const char*)g.Bt + (size_t)cur.pn * tstepB;
    S.a_ready(cur);
    if constexpr (SP2) {
        PG8_STAGE(PG8_SB(0, 0), cB, voffB); PG8_STAGE(PG8_SB(0, 1), cB + hstepB, voffB); PG8_STAGE(PG8_SA(0, 0), cA, voffA); PG8_STAGE(PG8_SA(0, 1), cA + hstepA, voffA);
        if (wr == 1) PG8_BAR;
        PG8_WAIT_V(2); PG8_BAR;
        PG8_STAGE(PG8_SB(1, 0), cB + kstep, voffB); PG8_STAGE(PG8_SA(1, 0), cA + kstep, voffA); PG8_STAGE(PG8_SB(1, 1), cB + hstepB + kstep, voffB);
        PG8_WAIT_V(6); PG8_BAR;
    } else {
        PG8_STAGE(PG8_SB(0, 0), cB, voffB); PG8_STAGE(PG8_SA(0, 0), cA, voffA); PG8_STAGE(PG8_SB(0, 1), cB + hstepB, voffB); PG8_STAGE(PG8_SA(0, 1), cA + hstepA, voffA);
        if (wr == 1) PG8_BAR;
        PG8_WAIT_V(4); PG8_BAR;
        PG8_STAGE(PG8_SB(1, 0), cB + kstep, voffB); PG8_STAGE(PG8_SA(1, 0), cA + kstep, voffA); PG8_STAGE(PG8_SB(1, 1), cB + hstepB + kstep, voffB);
        PG8_WAIT_V(6); PG8_BAR;
    }
    for (;;) {
        const bool has_next = S.next(ui + 1, nxt);
        const char* nA = has_next ? (const char*)g.A + (size_t)nxt.pm * tstepA : cA; const char* nB = has_next ? (const char*)g.Bt + (size_t)nxt.pn * tstepB : cB;
        for (int t = 0; t < nt; t += 2) {
            const bool last = (t == nt - 2);
            const char* a1 = cA + (size_t)(t + 1) * kstep;
            const char* a2 = last ? nA : cA + (size_t)(t + 2) * kstep; const char* b2 = last ? nB : cB + (size_t)(t + 2) * kstep;
            const char* a3 = a2 + kstep; const char* b3 = b2 + kstep;
            if (last && has_next) S.a_ready(nxt);
            if constexpr (SP2) {
            PG8_LDB(B0, 0, 0); PG8_LDB(B1, 0, 1); PG8_SCHED; PG8_LDA(At, 0, 0); PG8_STAGE(PG8_SA(1, 1), a1 + hstepA, voffA);
            PG8_WAIT_V(8); PG8_WAIT_L(0); PG8_BAR; PG8_MMA(0, 0, At, B0); PG8_MMA(0, 1, At, B1); PG8_BAR; PG8_SCHED;
            PG8_LDA(At, 0, 1); PG8_STAGE(PG8_SB(0, 0), b2, voffB); PG8_STAGE(PG8_SB(0, 1), b2 + hstepB, voffB); PG8_STAGE(PG8_SA(0, 0), a2, voffA);
            PG8_WAIT_V(8); PG8_WAIT_L(0); PG8_BAR; PG8_MMA(1, 0, At, B0); PG8_MMA(1, 1, At, B1); PG8_BAR; PG8_SCHED;
            PG8_LDB(B0, 1, 0); PG8_LDB(B1, 1, 1); PG8_SCHED; PG8_LDA(At, 1, 0); PG8_STAGE(PG8_SA(0, 1), a2 + hstepA, voffA);
            PG8_WAIT_V(8); PG8_WAIT_L(0); PG8_BAR; PG8_MMA(0, 0, At, B0); PG8_MMA(0, 1, At, B1); PG8_BAR; PG8_SCHED;
            PG8_LDA(At, 1, 1); PG8_STAGE(PG8_SB(1, 0), b3, voffB); PG8_STAGE(PG8_SB(1, 1), b3 + hstepB, voffB); PG8_STAGE(PG8_SA(1, 0), a3, voffA);
            PG8_WAIT_V(8); PG8_WAIT_L(0); PG8_BAR; PG8_MMA(1, 0, At, B0); PG8_MMA(1, 1, At, B1); PG8_BAR; PG8_SCHED;
            } else {
            PG8_LDB(B0, 0, 0); PG8_SCHED; PG8_LDA(At, 0, 0); PG8_STAGE(PG8_SA(1, 1), a1 + hstepA, voffA);
            PG8_WAIT_L(8); PG8_BAR; PG8_WAIT_L(0); PG8_MMA(0, 0, At, B0); PG8_BAR; PG8_SCHED;
            PG8_LDB(B1, 0, 1); PG8_STAGE(PG8_SB(0, 0), b2, voffB);
            PG8_BAR; PG8_WAIT_L(0); PG8_MMA(0, 1, At, B1); PG8_BAR;
            PG8_LDA(At, 0, 1); PG8_STAGE(PG8_SA(0, 0), a2, voffA);
            PG8_BAR; PG8_WAIT_L(0); PG8_MMA(1, 0, At, B0); PG8_BAR; PG8_SCHED;
            PG8_STAGE(PG8_SB(0, 1), b2 + hstepB, voffB);
            PG8_WAIT_V(6); PG8_BAR; PG8_MMA(1, 1, At, B1); PG8_BAR;
            PG8_LDB(B0, 1, 0); PG8_SCHED; PG8_LDA(At, 1, 0); PG8_STAGE(PG8_SA(0, 1), a2 + hstepA, voffA);
            PG8_WAIT_L(8); PG8_BAR; PG8_WAIT_L(0); PG8_MMA(0, 0, At, B0); PG8_BAR; PG8_SCHED;
            PG8_LDB(B1, 1, 1); PG8_STAGE(PG8_SB(1, 0), b3, voffB);
            PG8_BAR; PG8_WAIT_L(0); PG8_MMA(0, 1, At, B1); PG8_BAR;
            PG8_LDA(At, 1, 1); PG8_STAGE(PG8_SA(1, 0), a3, voffA);
            PG8_BAR; PG8_WAIT_L(0); PG8_MMA(1, 0, At, B0); PG8_BAR; PG8_SCHED;
            PG8_STAGE(PG8_SB(1, 1), b3 + hstepB, voffB);
            PG8_WAIT_V(6); PG8_BAR; PG8_MMA(1, 1, At, B1); PG8_BAR;
            }
        }
        if constexpr (ALIGN_EPI) { if (wr == 0) PG8_BAR; }
        if constexpr (!Epi::AFTER_DRAIN) { E(acc, cur, wr, wc, fr, fq); S.done(cur); }
        if (!has_next) break;
#pragma unroll
        for (int a = 0; a < 2; ++a)
#pragma unroll
            for (int b = 0; b < 2; ++b)
#pragma unroll
                for (int m = 0; m < 4; ++m)
#pragma unroll
                    for (int n = 0; n < 2; ++n) acc[a][b][m][n] = (f32x4){0.f, 0.f, 0.f, 0.f};
        cur = nxt; cA = nA; cB = nB; ++ui;
        if constexpr (ALIGN_EPI) { if (wr == 1) PG8_BAR; }
    }
    PG8_WAIT_V(0);
    if constexpr (!ALIGN_EPI) { if (wr == 0) PG8_BAR; }
    PG8_BAR;
    if constexpr (Epi::AFTER_DRAIN) { E.fused(acc, cur, wr, wc, fr, fq, lds, wid, lane); S.done(cur); }
#undef PG8_SA
#undef PG8_SB
#undef PG8_STAGE
#undef PG8_LDA
#undef PG8_LDB
#undef PG8_MMA
#undef PG8_WAIT_V
#undef PG8_WAIT_L
#undef PG8_BAR
#undef PG8_SCHED
}
}


__device__ __forceinline__ void row_rms(const bf16_t* A, int lda, int K, int m0, float* rs) {
  const int tid = otid(), row = tid >> 1, half = tid & 1;
  const bf16_t* p = A + (size_t)(m0 + row) * lda + half * (K >> 1);
  float s = 0.f;
  for (int i = 0; i < (K >> 4); ++i) { const u32x4 w = *(const u32x4*)(p + i * 8);
#pragma unroll
    for (int k = 0; k < 4; ++k) { const float a = bflo(w[k]), b = bfhi(w[k]); s += a * a + b * b; } }
  s += __shfl_xor(s, 1);
  if (half == 0) rs[row] = rsqrtf(s / (float)K + LN_EPS);
  __syncthreads();
}

constexpr int A_KS = 104, A_VS = 72;
constexpr int A_KBUF = 64 * A_KS, A_VBUF = 64 * A_VS;
constexpr float A_THR = 8.f;
__device__ void attn_unit(const bf16_t* __restrict__ Q, const bf16_t* __restrict__ Kn, const bf16_t* __restrict__ Vt, const bf16_t* __restrict__ KR,
                          bf16_t* __restrict__ Y, int S, int b, int h, int qb, char* smem) {
  const int tid = otid(), lane = tid & 63, wid = tid >> 6, r32 = lane & 31, hi = lane >> 5;
  bf16_t* Ks = (bf16_t*)smem; bf16_t* Vs = Ks + 2 * A_KBUF; float* wsf = (float*)(Vs + 2 * A_VBUF) + wid * 64;
  const size_t rowbase = (size_t)b * S;
  const int q0 = qb * 256 + wid * 32;
  bf16x8 qr[6];
  { const bf16_t* qp = Q + (rowbase + q0 + r32) * 768 + h * 96 + hi * 8;
#pragma unroll
    for (int d0 = 0; d0 < 6; ++d0) qr[d0] = *(const bf16x8*)(qp + d0 * 16); }
  const bf16_t* kn_src = Kn + (rowbase + (tid >> 3)) * 512 + h * 64 + (tid & 7) * 8;
  const bf16_t* kr_src = KR + (rowbase + (tid >> 2)) * 32 + (tid & 3) * 8;
  const bf16_t* v_src = Vt + ((size_t)(b * 8 + h) * 64 + (tid >> 3)) * S + (tid & 7) * 8;
  const int kn_dst = (tid >> 3) * A_KS + (tid & 7) * 8, kr_dst = (tid >> 2) * A_KS + 64 + (tid & 3) * 8, v_dst = (tid >> 3) * A_VS + (tid & 7) * 8;
  const bool has_kr = tid < 256;
  u32x4 sk, sr, sv;
#define A_LOAD(k0) do { sk = *(const u32x4*)(kn_src + (size_t)(k0) * 512); if (has_kr) sr = *(const u32x4*)(kr_src + (size_t)(k0) * 32); sv = *(const u32x4*)(v_src + (k0)); } while (0)
#define A_STORE(bf) do { *(u32x4*)(Ks + (bf) * A_KBUF + kn_dst) = sk; if (has_kr) *(u32x4*)(Ks + (bf) * A_KBUF + kr_dst) = sr; *(u32x4*)(Vs + (bf) * A_VBUF + v_dst) = sv; } while (0)
  float m_ref = 0.f, l_reg = 0.f; f32x16 o[2], negm; o[0] = f32x16{}; o[1] = f32x16{}; negm = f32x16{};
  const int NT = S >> 6;
  A_LOAD(0); A_STORE(0); __syncthreads();
  for (int j = 0; j < NT; ++j) {
    const int buf = j & 1;
    if (j + 1 < NT) A_LOAD((j + 1) * 64);
#ifndef A_SKEW
#define A_SKEW 1
#endif
    if (A_SKEW > 0 && wid >= 4) __builtin_amdgcn_s_sleep(A_SKEW);
    f32x16 p0, p1;
    bf16x8 vf[8];
    { const bf16_t* kb = Ks + buf * A_KBUF + r32 * A_KS + hi * 8;
      bf16x8 kf[12];
#pragma unroll
      for (int d0 = 0; d0 < 6; ++d0) { kf[2 * d0] = *(const bf16x8*)(kb + d0 * 16); kf[2 * d0 + 1] = *(const bf16x8*)(kb + 32 * A_KS + d0 * 16); }
      __builtin_amdgcn_sched_barrier(0);
      p0 = MFMA32(kf[0], qr[0], negm); p1 = MFMA32(kf[1], qr[0], negm);
#pragma unroll
      for (int d0 = 1; d0 < 6; ++d0) { p0 = MFMA32(kf[2 * d0], qr[d0], p0); p1 = MFMA32(kf[2 * d0 + 1], qr[d0], p1); }
      __builtin_amdgcn_sched_barrier(0);
      const bf16_t* vb = Vs + buf * A_VBUF + r32 * A_VS + hi * 8;
#pragma unroll
      for (int d0 = 0; d0 < 2; ++d0)
#pragma unroll
        for (int ks = 0; ks < 4; ++ks) vf[d0 * 4 + ks] = *(const bf16x8*)(vb + d0 * 32 * A_VS + ks * 16);
      __builtin_amdgcn_sched_barrier(0);
    }
#define MX3(a, b, c) __builtin_fmaxf(__builtin_fmaxf((a), (b)), (c))
    float pmax;
    { float a = MX3(p0[0], p0[1], p0[2]), b2 = MX3(p0[3], p0[4], p0[5]);
      a = MX3(a, p0[6], p0[7]); b2 = MX3(b2, p0[8], p0[9]); a = MX3(a, p0[10], p0[11]); b2 = MX3(b2, p0[12], p0[13]); a = MX3(a, p0[14], p0[15]);
      b2 = MX3(b2, p1[0], p1[1]); a = MX3(a, p1[2], p1[3]); b2 = MX3(b2, p1[4], p1[5]); a = MX3(a, p1[6], p1[7]); b2 = MX3(b2, p1[8], p1[9]);
      a = MX3(a, p1[10], p1[11]); b2 = MX3(b2, p1[12], p1[13]); a = MX3(a, p1[14], p1[15]); pmax = __builtin_fmaxf(a, b2); }
#undef MX3
    { auto rr = __builtin_amdgcn_permlane32_swap(__float_as_uint(pmax), __float_as_uint(pmax), false, false);
      pmax = fmaxf(__uint_as_float(rr[0]), __uint_as_float(rr[1])); }
    if (j == 0 || __any(pmax > A_THR)) {
      const float delta = (j == 0) ? pmax : fmaxf(pmax, 0.f);
#pragma unroll
      for (int r = 0; r < 16; ++r) { p0[r] -= delta; p1[r] -= delta; }
      m_ref += delta;
#pragma unroll
      for (int r = 0; r < 16; ++r) negm[r] = -m_ref;
      if (j > 0) {
        const float al = __builtin_amdgcn_exp2f(-delta); l_reg *= al;
        if (hi == 0) wsf[r32] = al;
        asm volatile("s_waitcnt lgkmcnt(0)" ::: "memory");
#pragma unroll
        for (int r = 0; r < 16; ++r) { const float f = wsf[crow(r, hi)]; o[0][r] *= f; o[1][r] *= f; }
        asm volatile("s_waitcnt lgkmcnt(0)" ::: "memory");
      }
    }
    float ps = 0.f, ps2 = 0.f;
#pragma unroll
    for (int r = 0; r < 16; ++r) { p0[r] = __builtin_amdgcn_exp2f(p0[r]); ps += p0[r]; }
#pragma unroll
    for (int r = 0; r < 16; ++r) { p1[r] = __builtin_amdgcn_exp2f(p1[r]); ps2 += p1[r]; }
    ps += ps2;
    { auto rr = __builtin_amdgcn_permlane32_swap(__float_as_uint(ps), __float_as_uint(ps), false, false);
      ps = __uint_as_float(rr[0]) + __uint_as_float(rr[1]); }
    l_reg += ps;
    bf16x8 pa0, pa1, pa2, pa3;
    PK4(p0, 0, pa0); PK4(p0, 8, pa1); PK4(p1, 0, pa2); PK4(p1, 8, pa3);
    __builtin_amdgcn_sched_barrier(0);
    o[0] = MFMA32(pa0, vf[0], o[0]); o[1] = MFMA32(pa0, vf[4], o[1]);
    o[0] = MFMA32(pa1, vf[1], o[0]); o[1] = MFMA32(pa1, vf[5], o[1]);
    o[0] = MFMA32(pa2, vf[2], o[0]); o[1] = MFMA32(pa2, vf[6], o[1]);
    o[0] = MFMA32(pa3, vf[3], o[0]); o[1] = MFMA32(pa3, vf[7], o[1]);
    __builtin_amdgcn_sched_barrier(0);
    if (j + 1 < NT) A_STORE(buf ^ 1);
    __syncthreads();
  }
#undef A_LOAD
#undef A_STORE
  if (hi == 0) wsf[32 + r32] = l_reg;
  asm volatile("s_waitcnt lgkmcnt(0)" ::: "memory");
  bf16_t* yp = Y + (rowbase + q0) * 1024 + h * 64 + r32;
#pragma unroll
  for (int r = 0; r < 16; ++r) {
    const int orow = crow(r, hi); const float rl = __builtin_amdgcn_rcpf(wsf[32 + orow]);
    yp[(size_t)orow * 1024] = f2bf(o[0][r] * rl); yp[(size_t)orow * 1024 + 32] = f2bf(o[1][r] * rl);
  }
  __syncthreads();
}

__device__ void phase_pool_rope(const bf16_t* __restrict__ proj, bf16_t* __restrict__ Y, bf16_t* __restrict__ KR, const f32x2* __restrict__ rope, int S) {
  const int smask = S - 1;
  const int gtid = blockIdx.x * NTHR + otid(), gstr = gridDim.x * NTHR;
  for (int idx = gtid; idx < MT * 32; idx += gstr) {
    const int m = idx >> 5, c = idx & 31, g = c >> 3, w = 2 << g, pos = m & smask;
    int lo = pos - (w >> 1); if (lo < 0) lo = 0; int hi = pos + (w >> 1); if (hi > S) hi = S;
    const bf16_t* base = proj + (size_t)(m - pos) * NPROJ + C_POOL + c * 8;
    float s[8];
#pragma unroll
    for (int k = 0; k < 8; ++k) s[k] = 0.f;
    for (int t = lo; t < hi; ++t) { const u32x4 v = *(const u32x4*)(base + (size_t)t * NPROJ);
#pragma unroll
      for (int k = 0; k < 4; ++k) { s[2 * k] += bflo(v[k]); s[2 * k + 1] += bfhi(v[k]); } }
    const float rc = 1.f / (float)(hi - lo);
    const u32x4 xv = *(const u32x4*)(base + (size_t)pos * NPROJ);
    u32x4 o;
#pragma unroll
    for (int k = 0; k < 4; ++k) o[k] = pk2(s[2 * k] * rc - bflo(xv[k]), s[2 * k + 1] * rc - bfhi(xv[k]));
    *(u32x4*)(Y + (size_t)m * 1024 + 512 + c * 8) = o;
  }
  for (int idx = gtid; idx < MT * 16; idx += gstr) {
    const int m = idx >> 4, i = idx & 15, pos = m & smask;
    const float x1 = bf2f(proj[(size_t)m * NPROJ + C_KR + i]), x2 = bf2f(proj[(size_t)m * NPROJ + C_KR + 16 + i]);
    const f32x2 cs = rope[pos * 16 + i];
    KR[(size_t)m * 32 + i] = f2bf(x1 * cs[0] - x2 * cs[1]); KR[(size_t)m * 32 + 16 + i] = f2bf(x2 * cs[0] + x1 * cs[1]);
  }
}

__device__ __forceinline__ float logsigmoidf(float f) { return fminf(f, 0.f) - log1pf(__expf(-fabsf(f))); }
constexpr int ML_T = 136;
constexpr int ML_R = 72;

__device__ void mlstm_pass1(int cgi, int hh, const bf16_t* __restrict__ proj, const float* __restrict__ gates, const float* __restrict__ gbias,
                            float* __restrict__ stU, float* __restrict__ stN, float* __restrict__ stS, char* smem) {
  const int tid = otid(), lane = tid & 63, wid = tid >> 6, r32 = lane & 31, hi = lane >> 5;
  bf16_t* Vt = (bf16_t*)smem; bf16_t* Kw = Vt + 64 * ML_T;
  float* sc = (float*)(Kw + 2 * 64 * ML_T); float* lfs = sc; float* als = sc + 256; float* wss = sc + 512; float* red = sc + 768;
  const int item = cgi * 4 + hh; const size_t m0 = (size_t)cgi * 128;
  float ipre = 0.f;
  if (tid < 256) { const int dir = tid >> 7, s = tid & 127; const float* gp = gates + (m0 + s) * 16;
    ipre = gp[(2 * dir) * 4 + hh] + gbias[(2 * dir) * 4 + hh];
    const float f = gp[(2 * dir + 1) * 4 + hh] + gbias[(2 * dir + 1) * 4 + hh];
    lfs[tid] = logsigmoidf(f); }
  __syncthreads();
  if (tid < 256) { const int dir = tid >> 7, s = tid & 127; float b = 0.f;
#pragma unroll
    for (int t4 = 0; t4 < 32; ++t4) { const f32x4 v = *(const f32x4*)(lfs + dir * 128 + 4 * t4);
#pragma unroll
      for (int k = 0; k < 4; ++k) { const int t = 4 * t4 + k; const bool in = dir ? (t >= s) : (t <= s); b += in ? v[k] : 0.f; } }
    als[tid] = ipre - b;
    if (dir == 0 && s == 127) red[0] = b;
    if (dir == 1 && s == 0) red[1] = b; }
  __syncthreads();
  if (tid < 256) { const int dir = tid >> 7, s = tid & 127; float mx = als[dir * 128];
#pragma unroll
    for (int t4 = 0; t4 < 32; ++t4) { const f32x4 v = *(const f32x4*)(als + dir * 128 + 4 * t4); mx = fmaxf(fmaxf(mx, fmaxf(v[0], v[1])), fmaxf(v[2], v[3])); }
    wss[tid] = __expf(als[tid] - mx);
    if (s == 0) { stS[(size_t)(item * 2 + dir) * 4 + 0] = red[dir]; stS[(size_t)(item * 2 + dir) * 4 + 1] = mx; } }
  __syncthreads();
#pragma unroll
  for (int it = 0; it < 2; ++it) { const int idx = tid + NTHR * it, s = idx & 127, c = idx >> 7;
    const bf16_t* rp = proj + (m0 + s) * NPROJ + hh * 64 + c * 8;
    const u32x4 kc = *(const u32x4*)(rp + C_KM), vc = *(const u32x4*)(rp + C_VM);
    const float w0 = wss[s] * 0.125f, w1 = wss[128 + s] * 0.125f;
#pragma unroll
    for (int k = 0; k < 4; ++k) {
      const float ka = bflo(kc[k]), kb = bfhi(kc[k]);
      Kw[(8 * c + 2 * k) * ML_T + s] = f2bf(ka * w0); Kw[(8 * c + 2 * k + 1) * ML_T + s] = f2bf(kb * w0);
      Kw[64 * ML_T + (8 * c + 2 * k) * ML_T + s] = f2bf(ka * w1); Kw[64 * ML_T + (8 * c + 2 * k + 1) * ML_T + s] = f2bf(kb * w1);
      Vt[(8 * c + 2 * k) * ML_T + s] = (bf16_t)(vc[k] & 0xffffu); Vt[(8 * c + 2 * k + 1) * ML_T + s] = (bf16_t)(vc[k] >> 16);
    } }
  __syncthreads();
  { const int dir = wid >> 2, kb = (wid >> 1) & 1, vb = wid & 1;
    f32x16 acc = f32x16{};
    const bf16_t* ap = Kw + dir * 64 * ML_T + (kb * 32 + r32) * ML_T + hi * 8; const bf16_t* bp = Vt + (vb * 32 + r32) * ML_T + hi * 8;
#pragma unroll
    for (int ks = 0; ks < 8; ++ks) acc = MFMA32(*(const bf16x8*)(ap + ks * 16), *(const bf16x8*)(bp + ks * 16), acc);
    float* up = stU + (size_t)(item * 2 + dir) * 4096 + vb * 32 + r32;
#pragma unroll
    for (int r = 0; r < 16; ++r) up[(kb * 32 + crow(r, hi)) * 64] = acc[r]; }
  if (tid < 128) { const int dir = tid >> 6, kd = tid & 63; const bf16_t* kp = Kw + dir * 64 * ML_T + kd * ML_T; float s = 0.f;
    for (int t = 0; t < 128; ++t) s += bf2f(kp[t]);
    stN[(size_t)(item * 2 + dir) * 64 + kd] = s; }
  __syncthreads();
}

template <int EPT, int GS>
__device__ void mlstm_pass2(int ch, int part, int NC, float* __restrict__ stU, float* __restrict__ stN, float* __restrict__ stS) {
  const int tid = otid(); const int b = ch >> 3, hh = (ch >> 1) & 3, dir = ch & 1;
  const int e0 = part * (NTHR * EPT) + tid;
  const bool own_n = (part == 0) && (tid < 64);
  float sv[EPT], nv = 0.f, m = 0.f;
#pragma unroll
  for (int i = 0; i < EPT; ++i) sv[i] = 0.f;
  for (int st0 = 0; st0 < NC; st0 += GS) {
    float uu[GS][EPT], un[GS], bs[GS], ml[GS];
#pragma unroll
    for (int q = 0; q < GS; ++q) {
      const int step = st0 + q, c = dir ? (NC - 1 - step) : step;
      const size_t base = (size_t)(((b * NC + c) * 4 + hh) * 2 + dir);
      bs[q] = stS[base * 4 + 0]; ml[q] = stS[base * 4 + 1];
#pragma unroll
      for (int i = 0; i < EPT; ++i) uu[q][i] = stU[base * 4096 + e0 + NTHR * i];
      un[q] = own_n ? stN[base * 64 + tid] : 0.f;
    }
#pragma unroll
    for (int q = 0; q < GS; ++q) {
      const int step = st0 + q, c = dir ? (NC - 1 - step) : step;
      const size_t base = (size_t)(((b * NC + c) * 4 + hh) * 2 + dir);
      const float mnew = bs[q] + fmaxf(m, ml[q]);
      const float decay = __expf(m + bs[q] - mnew), uf = __expf(ml[q] + bs[q] - mnew);
#pragma unroll
      for (int i = 0; i < EPT; ++i) { stU[base * 4096 + e0 + NTHR * i] = sv[i]; sv[i] = decay * sv[i] + uf * uu[q][i]; }
      if (own_n) { stN[base * 64 + tid] = nv; nv = decay * nv + uf * un[q]; }
      if (part == 0 && tid == 0) stS[base * 4 + 2] = m;
      m = mnew;
    }
  }
}

__device__ void mlstm_pass3(int cgi, int hh, const bf16_t* __restrict__ proj, const float* __restrict__ gates, const float* __restrict__ gbias,
                            const float* __restrict__ norm_g, const float* __restrict__ stU, const float* __restrict__ stN, const float* __restrict__ stS,
                            bf16_t* __restrict__ Y, char* smem) {
  const int tid = otid(), lane = tid & 63, wid = tid >> 6, r32 = lane & 31, hi = lane >> 5;
  bf16_t* Kr = (bf16_t*)smem; bf16_t* Qr = Kr + 128 * ML_R; bf16_t* Vt = Qr + 128 * ML_R; bf16_t* Qf = Vt + 64 * ML_T;
  bf16_t* St = Qf + 2 * 128 * ML_R;
  float* H = (float*)(St + 2 * 64 * ML_R);
  float* sc = H + 128 * 64; float* lfs = sc; float* als = sc + 256; float* bbs = sc + 512; float* Mls = sc + 768; float* ffs = sc + 1024; float* dqs = sc + 1280;
  float* nss = sc + 1536;   float* invs = sc + 1664;
  const int item = cgi * 4 + hh; const size_t m0 = (size_t)cgi * 128;
  float ipre = 0.f;
  if (tid < 256) { const int dir = tid >> 7, s = tid & 127; const float* gp = gates + (m0 + s) * 16;
    ipre = gp[(2 * dir) * 4 + hh] + gbias[(2 * dir) * 4 + hh];
    const float f = gp[(2 * dir + 1) * 4 + hh] + gbias[(2 * dir + 1) * 4 + hh];
    lfs[tid] = logsigmoidf(f); }
  __syncthreads();
  if (tid < 256) { const int dir = tid >> 7, s = tid & 127; float b = 0.f;
#pragma unroll
    for (int t4 = 0; t4 < 32; ++t4) { const f32x4 v = *(const f32x4*)(lfs + dir * 128 + 4 * t4);
#pragma unroll
      for (int k = 0; k < 4; ++k) { const int t = 4 * t4 + k; const bool in = dir ? (t >= s) : (t <= s); b += in ? v[k] : 0.f; } }
    als[tid] = ipre - b; bbs[tid] = b; }
  else if (tid < 384) { const int dir = (tid - 256) >> 6, kd = tid & 63; nss[dir * 64 + kd] = stN[(size_t)(item * 2 + dir) * 64 + kd]; }
  __syncthreads();
  if (tid < 256) { const int dir = tid >> 7, s = tid & 127; const float mst = stS[(size_t)(item * 2 + dir) * 4 + 2]; float mx = mst;
#pragma unroll
    for (int t4 = 0; t4 < 32; ++t4) { const f32x4 v = *(const f32x4*)(als + dir * 128 + 4 * t4);
#pragma unroll
      for (int k = 0; k < 4; ++k) { const int t = 4 * t4 + k; const bool in = dir ? (t >= s) : (t <= s); mx = fmaxf(mx, in ? v[k] : -3.0e38f); } }
    Mls[tid] = mx; ffs[tid] = __expf(mst - mx); }
  __syncthreads();
#pragma unroll
  for (int it = 0; it < 2; ++it) {
    { const int idx = tid + NTHR * it, s = idx >> 3, c = idx & 7;
      const bf16_t* rp = proj + (m0 + s) * NPROJ + hh * 64 + c * 8;
      const u32x4 kc = *(const u32x4*)(rp + C_KM), qc = *(const u32x4*)(rp + C_QM);
      *(u32x4*)(Kr + s * ML_R + c * 8) = kc; *(u32x4*)(Qr + s * ML_R + c * 8) = qc;
      const float f0 = ffs[s], f1 = ffs[128 + s]; u32x4 q0, q1;
#pragma unroll
      for (int k = 0; k < 4; ++k) { const float a = bflo(qc[k]), b2 = bfhi(qc[k]); q0[k] = pk2(a * f0, b2 * f0); q1[k] = pk2(a * f1, b2 * f1); }
      *(u32x4*)(Qf + s * ML_R + c * 8) = q0; *(u32x4*)(Qf + 128 * ML_R + s * ML_R + c * 8) = q1; }
    { const int idx = tid + NTHR * it, s = idx & 127, c = idx >> 7;
      const u32x4 vc = *(const u32x4*)(proj + (m0 + s) * NPROJ + C_VM + hh * 64 + c * 8);
#pragma unroll
      for (int k = 0; k < 4; ++k) { Vt[(8 * c + 2 * k) * ML_T + s] = (bf16_t)(vc[k] & 0xffffu); Vt[(8 * c + 2 * k + 1) * ML_T + s] = (bf16_t)(vc[k] >> 16); } }
  }
#pragma unroll
  for (int dir = 0; dir < 2; ++dir) { const float* sp = stU + (size_t)(item * 2 + dir) * 4096;
#pragma unroll
    for (int it = 0; it < 8; ++it) { const int idx = tid + NTHR * it, d = idx >> 6, e = idx & 63; St[dir * 64 * ML_R + e * ML_R + d] = f2bf(sp[idx]); } }
  __syncthreads();
  if (tid < 256) { const int dir = tid >> 7, j = tid & 127; const bf16_t* qp = Qr + j * ML_R; float s = 0.f;
#pragma unroll
    for (int d8 = 0; d8 < 8; ++d8) { const u32x4 qv = *(const u32x4*)(qp + d8 * 8); const f32x4 n0 = *(const f32x4*)(nss + dir * 64 + d8 * 8), n1 = *(const f32x4*)(nss + dir * 64 + d8 * 8 + 4);
      s += bflo(qv[0]) * n0[0] + bfhi(qv[0]) * n0[1] + bflo(qv[1]) * n0[2] + bfhi(qv[1]) * n0[3] + bflo(qv[2]) * n1[0] + bfhi(qv[2]) * n1[1] + bflo(qv[3]) * n1[2] + bfhi(qv[3]) * n1[3]; }
    dqs[tid] = s * ffs[tid]; }
  __syncthreads();
  f32x16 o[2]; o[0] = f32x16{}; o[1] = f32x16{};
  const int dir = wid >> 2, jb = wid & 3;
  {
    const int jrow = 32 * jb + r32; const float Mj = Mls[dir * 128 + jrow]; float den = 0.f;
    const int st_lo = dir ? jb : 0, st_hi = dir ? 3 : jb;
    for (int st = st_lo; st <= st_hi; ++st) {
      f32x16 sc2 = f32x16{};
      const bf16_t* ap = Kr + (32 * st + r32) * ML_R + hi * 8; const bf16_t* bp = Qr + jrow * ML_R + hi * 8;
#pragma unroll
      for (int kk = 0; kk < 4; ++kk) sc2 = MFMA32(*(const bf16x8*)(ap + kk * 16), *(const bf16x8*)(bp + kk * 16), sc2);
      float pv[16];
#pragma unroll
      for (int r = 0; r < 16; ++r) { const int s = 32 * st + crow(r, hi); const bool valid = dir ? (s >= jrow) : (s <= jrow);
        const float x = fminf(als[dir * 128 + s] - Mj, 0.f); const float w = valid ? 0.125f * __expf(x) : 0.f;
        pv[r] = sc2[r] * w; den += pv[r]; }
      bf16x8 pa0, pa1; PK4(pv, 0, pa0); PK4(pv, 8, pa1);
#pragma unroll
      for (int d0 = 0; d0 < 2; ++d0) { const bf16_t* vp = Vt + (32 * d0 + r32) * ML_T + 32 * st + hi * 8;
        o[d0] = MFMA32(pa0, *(const bf16x8*)(vp), o[d0]); o[d0] = MFMA32(pa1, *(const bf16x8*)(vp + 16), o[d0]); }
    }
    { const bf16_t* ap = Qf + dir * 128 * ML_R + jrow * ML_R + hi * 8;
#pragma unroll
      for (int kk = 0; kk < 4; ++kk) { const bf16x8 a = *(const bf16x8*)(ap + kk * 16);
#pragma unroll
        for (int d0 = 0; d0 < 2; ++d0) o[d0] = MFMA32(a, *(const bf16x8*)(St + dir * 64 * ML_R + (32 * d0 + r32) * ML_R + kk * 16 + hi * 8), o[d0]); } }
    den += __shfl_xor(den, 32);
    den += dqs[dir * 128 + jrow];
    const float flo = __expf(-(bbs[dir * 128 + jrow] + Mj));
    const float inv = __builtin_amdgcn_rcpf(fmaxf(fabsf(den), flo));
    if (hi == 0) invs[wid * 32 + r32] = inv;
    asm volatile("s_waitcnt lgkmcnt(0)" ::: "memory");
  }
  if (dir == 0) {
#pragma unroll
    for (int r = 0; r < 16; ++r) { const int jr = crow(r, hi); const float iv = invs[wid * 32 + jr];
      H[(32 * jb + jr) * 64 + r32] = o[0][r] * iv; H[(32 * jb + jr) * 64 + 32 + r32] = o[1][r] * iv; }
  }
  __syncthreads();
  if (dir == 1) {
#pragma unroll
    for (int r = 0; r < 16; ++r) { const int jr = crow(r, hi); const float iv = invs[wid * 32 + jr];
      H[(32 * jb + jr) * 64 + r32] += o[0][r] * iv; H[(32 * jb + jr) * 64 + 32 + r32] += o[1][r] * iv; }
  }
  __syncthreads();
  { const int j = tid >> 2, qd = tid & 3; float hv[16]; float s = 0.f;
#pragma unroll
    for (int e = 0; e < 16; ++e) { hv[e] = H[j * 64 + qd * 16 + e]; s += hv[e]; }
    s += __shfl_xor(s, 1); s += __shfl_xor(s, 2);
    const float mu = s * (1.f / 64.f); float q = 0.f;
#pragma unroll
    for (int e = 0; e < 16; ++e) { const float d = hv[e] - mu; q += d * d; }
    q += __shfl_xor(q, 1); q += __shfl_xor(q, 2);
    const float rstd = rsqrtf(q * (1.f / 64.f) + LN_EPS);
    const bf16_t* op = proj + (m0 + j) * NPROJ + C_OM + hh * 64 + qd * 16;
    const u32x4 oa = *(const u32x4*)op, ob = *(const u32x4*)(op + 8);
    const float* ng = norm_g + hh * 64 + qd * 16;
    float y[16];
#pragma unroll
    for (int k = 0; k < 4; ++k) {
      const float g0 = bflo(oa[k]), g1 = bfhi(oa[k]), g2 = bflo(ob[k]), g3 = bfhi(ob[k]);
      y[2 * k] = (hv[2 * k] - mu) * rstd * ng[2 * k] * __builtin_amdgcn_rcpf(1.f + __builtin_amdgcn_exp2f(-1.4426950408889634f * g0));
      y[2 * k + 1] = (hv[2 * k + 1] - mu) * rstd * ng[2 * k + 1] * __builtin_amdgcn_rcpf(1.f + __builtin_amdgcn_exp2f(-1.4426950408889634f * g1));
      y[8 + 2 * k] = (hv[8 + 2 * k] - mu) * rstd * ng[8 + 2 * k] * __builtin_amdgcn_rcpf(1.f + __builtin_amdgcn_exp2f(-1.4426950408889634f * g2));
      y[8 + 2 * k + 1] = (hv[8 + 2 * k + 1] - mu) * rstd * ng[8 + 2 * k + 1] * __builtin_amdgcn_rcpf(1.f + __builtin_amdgcn_exp2f(-1.4426950408889634f * g3));
    }
    u32x4 w0 = {pk2(y[0], y[1]), pk2(y[2], y[3]), pk2(y[4], y[5]), pk2(y[6], y[7])}, w1 = {pk2(y[8], y[9]), pk2(y[10], y[11]), pk2(y[12], y[13]), pk2(y[14], y[15])};
    bf16_t* yp = Y + (m0 + j) * 1024 + 768 + hh * 64 + qd * 16;
    *(u32x4*)yp = w0; *(u32x4*)(yp + 8) = w1; }
  __syncthreads();
}

__device__ __forceinline__ bool tile_order(int i, int G, int c, int nM, int nN, int& pm, int& pn) {
  const int nwg = nM * nN; const long L = (long)i * G + c; if (L >= nwg) return false;
  int wgid = (int)L; { const int q = nwg / 8, r = nwg % 8, xcd = wgid % 8, off = wgid / 8; wgid = (xcd < r ? xcd * (q + 1) : r * (q + 1) + (xcd - r) * q) + off; }
  const int nig = 8 * nN, gid = wgid / nig, fm = gid * 8, gsz = (nM - fm) < 8 ? (nM - fm) : 8;
  pm = fm + ((wgid % nig) % gsz); pn = (wgid % nig) / gsz; return true;
}

#define XB_TMO      128
#define XB_XCNT(j)  (256  + 64 * (j))
#define XB_XSUB(j)  (1280 + 64 * (j))
#define XB_XGEN(j)  (2304 + 64 * (j))
#define XB_TOP      3328
#define XB_TOPGEN   3392
#define XCD_BAR_WORDS 3456
#define XB_SPIN_CAP (1u << 18)
#define LAS __attribute__((address_space(3)))

__device__ __forceinline__ unsigned xb_ld(unsigned* p)              { return __hip_atomic_load(p, __ATOMIC_RELAXED, __HIP_MEMORY_SCOPE_AGENT); }
__device__ __forceinline__ unsigned xb_add(unsigned* p, unsigned v) { return __hip_atomic_fetch_add(p, v, __ATOMIC_RELAXED, __HIP_MEMORY_SCOPE_AGENT); }
__device__ __forceinline__ unsigned xb_xcc_id() { return (unsigned)__builtin_amdgcn_s_getreg((3 << 11) | 20) & 0xFu; }
#define XB_SPIN(cond, bar) do { unsigned _sp = 0; while (cond) { __builtin_amdgcn_s_sleep(1); \
    if ((++_sp & 255u) == 0u) { if (xb_ld(&(bar)[XB_TMO])) break; if (_sp > XB_SPIN_CAP) { atomicAdd(&(bar)[XB_TMO], 1u); break; } } } } while (0)

struct XcdBarrier {
    unsigned* bar; unsigned x;
    volatile LAS unsigned* st;
};

__device__ __forceinline__ XcdBarrier xcd_barrier_post(unsigned* bar, volatile LAS unsigned* st) {
    XcdBarrier b; b.bar = bar; b.x = xb_xcc_id(); b.st = st;
    if (threadIdx.x == 0) (void)xb_add(&bar[XB_XCNT(b.x)], 1u);
    return b;
}
__device__ __forceinline__ void xcd_barrier_complete(unsigned* bar, unsigned x, unsigned& nloc, unsigned& nx) {
    const unsigned G = gridDim.x * gridDim.y * gridDim.z;
    unsigned sum, cnt, mine, sp = 0u;
    for (;;) {
        sum = 0u; cnt = 0u; mine = 0u;
#pragma unroll
        for (unsigned j = 0; j < 16; ++j) { const unsigned c = xb_ld(&bar[XB_XCNT(j)]); sum += c; cnt += (c > 0u) ? 1u : 0u; mine = (j == x) ? c : mine; }
        if (sum == G) break;
        __builtin_amdgcn_s_sleep(1);
        if ((++sp & 255u) == 0u) { if (xb_ld(&bar[XB_TMO])) break; if (sp > XB_SPIN_CAP) { atomicAdd(&bar[XB_TMO], 1u); break; } }
    }
    nloc = mine > 0u ? mine : 1u; nx = cnt > 0u ? cnt : 1u;
}

__device__ __forceinline__ void xcd_barrier(const XcdBarrier& b) {
    asm volatile("s_waitcnt vmcnt(0)" ::: "memory");
    __syncthreads();
    if (threadIdx.x == 0) {
        unsigned* bar = b.bar;
        __builtin_amdgcn_s_waitcnt(0);
        unsigned nloc = b.st[0], nx = b.st[1];
        if (nloc == 0u) { xcd_barrier_complete(bar, b.x, nloc, nx); b.st[0] = nloc; b.st[1] = nx; }
        const unsigned old = xb_add(&bar[XB_XSUB(b.x)], 1u);
        const unsigned gen = old / nloc;
        if (old + 1u == (gen + 1u) * nloc) {
            __builtin_amdgcn_fence(__ATOMIC_RELEASE, "agent");
            asm volatile("s_waitcnt vmcnt(0)" ::: "memory");
            const unsigned og = xb_add(&bar[XB_TOP], 1u);
            const unsigned tg = og / nx;
            if (og + 1u == (tg + 1u) * nx) xb_add(&bar[XB_TOPGEN], 1u);
            else XB_SPIN(xb_ld(&bar[XB_TOPGEN]) == tg, bar);
            __builtin_amdgcn_fence(__ATOMIC_ACQUIRE, "agent");
            xb_add(&bar[XB_XGEN(b.x)], 1u);
            asm volatile("s_waitcnt vmcnt(0)" ::: "memory");
        } else {
            XB_SPIN(xb_ld(&bar[XB_XGEN(b.x)]) == gen, bar);
            __builtin_amdgcn_fence(__ATOMIC_ACQUIRE, "agent");
            asm volatile("s_waitcnt vmcnt(0)" ::: "memory");
        }
    }
    __syncthreads();
}

constexpr int PH_PER_TRUNK = 1 + 8 * DEPTH, N_PHASES = 1 + 2 * PH_PER_TRUNK;

__device__ void run_phase(const Params& p, int ph, char* smem) {
  if (ph == 0) { if (blockIdx.x == 0) { const int t0 = otid();
      ((unsigned*)(p.ws + OFF_CNT))[t0] = 0u; ((unsigned*)(p.ws + OFF_CNT))[t0 + NTHR] = 0u;
      float* idv = (float*)(p.ws + OFF_ID); idv[t0] = 1.f; idv[t0 + NTHR] = 1.f; idv[1024 + t0] = 0.f; idv[1024 + t0 + NTHR] = 0.f; }
    phase_prep(p, smem); return; }
  const int tr = (ph - 1) / PH_PER_TRUNK, q = (ph - 1) % PH_PER_TRUNK;
  const int S = tr ? 2048 : 16384, slog = tr ? 11 : 14, nseq = tr ? 16 : 2;
  float* x32 = p.out + (size_t)tr * MT * 1024;
  unsigned char* ws = p.ws;
  bf16_t* XB = (bf16_t*)(ws + OFF_XB); bf16_t* Y = (bf16_t*)(ws + OFF_Y); bf16_t* PROJ = (bf16_t*)(ws + OFF_PROJ);
  bf16_t* Qb = (bf16_t*)(ws + OFF_Q); bf16_t* KN = (bf16_t*)(ws + OFF_KN); bf16_t* VT = (bf16_t*)(ws + OFF_VT); bf16_t* KR = (bf16_t*)(ws + OFF_KR);
  float* GATES = (float*)(ws + OFF_GATES); float* STU = (float*)(ws + OFF_STU); float* STN = (float*)(ws + OFF_STN); float* STS = (float*)(ws + OFF_STS);
  bf16_t* HID = (bf16_t*)(ws + OFF_HID); const f32x2* ROPE = (const f32x2*)(ws + OFF_ROPE);
  f32x2* STAT = (f32x2*)(ws + OFF_STAT); const float* IDV = (const float*)(ws + OFF_ID);
  if (q == 0) { phase_ln(p.in[tr], x32, XB, p.in[2], p.in[3], MT, STAT, true); return; }
  const int l = (q - 1) / 8, sub = (q - 1) % 8;
  const unsigned char* wl = ws + OFF_W + (size_t)l * W_LAYER;
  const int G = gridDim.x, B = blockIdx.x;
#ifdef ONLY_SUB
  switch (ONLY_SUB) {
#else
  switch (sub) {
#endif
    case 0: {
      pg8::Gemm g{XB, (const bf16_t*)(wl + W_IN), MT, NPROJ, 1024, 1024}; pg8::StaticOrder So; So.init(MT, NPROJ, G, B);
      pg8::EpiInProj2 E{PROJ, GATES};
      pg8::gemm_phase<pg8::EpiInProj2, pg8::StaticOrder, true, true>((PG8_LAS unsigned char*)smem, g, So, E);
    } break;
    case 1: {
      float* rs = (float*)(smem + G_SMEM_BYTES);
      for (int rep1 = 0; rep1 < REP_P1; ++rep1) {
      for (int i = 0, pm, pn; tile_order(i, G, B, 128, 3, pm, pn); ++i) {
        row_rms(PROJ + C_CQ, NPROJ, 256, pm * 256, rs); EpiQUp E{Qb, rs, ROPE, S - 1};
        gemm_tile(PROJ + C_CQ, NPROJ, (const bf16_t*)(wl + W_UQ), 256, pm * 256, pn * 256, smem, E);
        __syncthreads();
      }
      for (int i = 0, pm, pn; tile_order(i, G, B, 128, 4, pm, pn); ++i) {
        row_rms(PROJ + C_CKV, NPROJ, 128, pm * 256, rs); EpiKVUp E{KN, VT, rs, S, slog, S - 1};
        gemm_tile(PROJ + C_CKV, NPROJ, (const bf16_t*)(wl + W_UKV), 128, pm * 256, pn * 256, smem, E);
        __syncthreads();
      }
      phase_pool_rope(PROJ, Y, KR, ROPE, S);
      for (int t = B; t < 256 * 4; t += G) mlstm_pass1(t >> 2, t & 3, PROJ, GATES, p.in[11] + l * 16, STU, STN, STS, smem);
      }
    } break;
    case 2: {
      unsigned* cnt = (unsigned*)(ws + OFF_CNT) + (tr * DEPTH + l) * 64;
      if (B < 128) {
        if (tr == 0) mlstm_pass2<1, 32>(B >> 3, B & 7, S >> 7, STU, STN, STS); else mlstm_pass2<8, 4>(B, 0, S >> 7, STU, STN, STS);
        __builtin_amdgcn_fence(__ATOMIC_RELEASE, "agent");
        asm volatile("s_waitcnt vmcnt(0)" ::: "memory");
        __syncthreads();
        if (threadIdx.x == 0) __hip_atomic_fetch_add(cnt, 1u, __ATOMIC_RELEASE, __HIP_MEMORY_SCOPE_AGENT);
      }
      const int nqb = S >> 8;
      for (int t = B; t < 1024; t += G) { const int qb = t % nqb, bh = t / nqb; attn_unit(Qb, KN, VT, KR, Y, S, bh >> 3, bh & 7, qb, smem); }
      if (threadIdx.x == 0) { while (__hip_atomic_load(cnt, __ATOMIC_ACQUIRE, __HIP_MEMORY_SCOPE_AGENT) < 128u) __builtin_amdgcn_s_sleep(2); }
      __syncthreads();
      __builtin_amdgcn_fence(__ATOMIC_ACQUIRE, "agent");
      asm volatile("s_waitcnt vmcnt(0)" ::: "memory");
      for (int t = B; t < 256 * 4; t += G) mlstm_pass3(t >> 2, t & 3, PROJ, GATES, p.in[11] + l * 16, p.in[12] + l * 256, STU, STN, STS, Y, smem);
    } break;
    case 3: {
      pg8::Gemm g{Y, (const bf16_t*)(wl + W_OUT), MT, 1024, 1024, 1024}; pg8::StaticOrder So; So.init(MT, 1024, G, B);
      pg8::EpiResid2 E{x32, STAT, l ? p.in[19] + (l - 1) * 1024 : IDV, l ? p.in[20] + (l - 1) * 1024 : IDV + 1024};
      pg8::gemm_phase<pg8::EpiResid2, pg8::StaticOrder, true, true>((PG8_LAS unsigned char*)smem, g, So, E);
    } break;
    case 4: phase_ln(x32, nullptr, XB, p.in[14] + l * 1024, p.in[15] + l * 1024, MT, STAT, false); break;
    case 5: {
      pg8::Gemm g{XB, (const bf16_t*)(wl + W_GU), MT, NGU, 1024, 1024}; pg8::StaticOrder So; So.init(MT, NGU, G, B);
      pg8::EpiGU2 E{HID};
      pg8::gemm_phase<pg8::EpiGU2, pg8::StaticOrder, true, true>((PG8_LAS unsigned char*)smem, g, So, E);
    } break;
    case 6: {
      pg8::Gemm g{HID, (const bf16_t*)(wl + W_DN), MT, 1024, DFF, DFF}; pg8::StaticOrder So; So.init(MT, 1024, G, B);
      pg8::EpiResid2 E{x32, STAT, p.in[14] + l * 1024, p.in[15] + l * 1024};
      pg8::gemm_phase<pg8::EpiResid2, pg8::StaticOrder, true, true>((PG8_LAS unsigned char*)smem, g, So, E);
    } break;
    case 7: phase_ln(x32, (l == DEPTH - 1) ? x32 : nullptr, XB, p.in[19] + l * 1024, p.in[20] + l * 1024, MT, STAT, false); break;
  }
}

__global__ void __launch_bounds__(NTHR) fwd_kernel(Params p) {
  extern __shared__ __attribute__((aligned(16))) char smem[];
  cg::grid_group grid = cg::this_grid();
  volatile LAS unsigned* st = (volatile LAS unsigned*)((LAS unsigned char*)smem + (LDS_BYTES - 16));
  if (threadIdx.x < 2) st[threadIdx.x] = 0u;
  __syncthreads();
  XcdBarrier xb = xcd_barrier_post((unsigned*)(p.ws + OFF_XBAR), st);
  for (int ph = p.ph_lo; ph < p.ph_hi; ++ph) {
    run_phase(p, ph, smem);
    if (ph + 1 < p.ph_hi) {
      if (ph == p.ph_lo) grid.sync();
      else xcd_barrier(xb);
    }
  }
}

extern "C" void kernel_launch(void* const* d_in, const int* in_sizes, int n_in, void* d_out, int out_size, void* d_ws, size_t ws_size, hipStream_t stream) {
  static int grid_blocks = 0;
  if (!grid_blocks) {
    int dev = 0, cus = 0, per_cu = 0;
    hipGetDevice(&dev);
    hipDeviceGetAttribute(&cus, hipDeviceAttributeMultiprocessorCount, dev);
    hipFuncSetAttribute((const void*)fwd_kernel, hipFuncAttributeMaxDynamicSharedMemorySize, LDS_BYTES);
    hipOccupancyMaxActiveBlocksPerMultiprocessor(&per_cu, (const void*)fwd_kernel, NTHR, LDS_BYTES);
    if (per_cu < 1) per_cu = 1;
    grid_blocks = cus * per_cu;
    if (ws_size < OFF_END) fprintf(stderr, "kernel_launch: workspace too small (%zu < %zu)\n", ws_size, (size_t)OFF_END);
  }
  Params p{};
  for (int i = 0; i < 21; ++i) p.in[i] = (const float*)d_in[i];
  p.out = (float*)d_out; p.ws = (unsigned char*)d_ws;
#if ONE_LAUNCH
  p.ph_lo = 0; p.ph_hi = N_PHASES;
  (void)hipMemsetAsync((char*)d_ws + OFF_XBAR, 0, XCD_BAR_WORDS * 4, stream);
  void* args[] = {&p};
  hipError_t e = hipLaunchCooperativeKernel((const void*)fwd_kernel, dim3(grid_blocks), dim3(NTHR), args, LDS_BYTES, stream);
  if (e != hipSuccess) fprintf(stderr, "cooperative launch failed: %s (grid %d)\n", hipGetErrorString(e), grid_blocks);
#else
  for (int ph = 0; ph < N_PHASES; ++ph) { p.ph_lo = ph; p.ph_hi = ph + 1; hipLaunchKernelGGL(fwd_kernel, dim3(grid_blocks), dim3(NTHR), LDS_BYTES, stream, p); }
#endif
}
```

```cpp
#include <hip/hip_runtime.h>
#include <hip/hip_cooperative_groups.h>
#include <stdint.h>
#include <stdio.h>
namespace cg = cooperative_groups;

#ifndef REP_P1
#define REP_P1 1
#endif
#ifndef REP_P3
#define REP_P3 1
#endif
#ifndef REP_LN
#define REP_LN 1
#endif
#ifndef ONE_LAUNCH
#define ONE_LAUNCH 1
#endif

typedef unsigned short bf16_t;
typedef short bf16x8 __attribute__((ext_vector_type(8)));
typedef float f32x16 __attribute__((ext_vector_type(16)));
typedef float f32x4 __attribute__((ext_vector_type(4)));
typedef float f32x2 __attribute__((ext_vector_type(2)));
typedef unsigned u32x4 __attribute__((ext_vector_type(4)));
typedef unsigned u32x2 __attribute__((ext_vector_type(2)));
typedef __bf16 bf16x2_t __attribute__((ext_vector_type(2)));

constexpr int DM = 1024, DEPTH = 4, MT = 32768;
constexpr int NPROJ = 1792, INW = 1712, DFF = 2816, NGU = 5632;
constexpr int C_CQ = 0, C_CKV = 256, C_KR = 384, C_POOL = 416, C_QM = 672, C_KM = 928, C_VM = 1184, C_OM = 1440, C_G = 1696;
constexpr float LN_EPS = 1e-5f;
constexpr float DN_ALPHA = 1.6817928305074290f;
constexpr float QSCALE = 0.10206207261596577f * 1.4426950408889634f;
constexpr int NTHR = 512;

constexpr size_t MiB = 1u << 20;
constexpr size_t W_IN = 0, W_UQ = W_IN + (size_t)NPROJ * 1024 * 2, W_UKV = W_UQ + 768 * 256 * 2, W_OUT = W_UKV + 1024 * 128 * 2,
                 W_GU = W_OUT + 1024 * 1024 * 2, W_DN = W_GU + (size_t)NGU * 1024 * 2, W_LAYER = W_DN + (size_t)1024 * DFF * 2;
static_assert(W_LAYER * 4 <= 96 * MiB, "weights");
constexpr size_t OFF_W = 0, OFF_ROPE = 96 * MiB, OFF_XB = 98 * MiB, OFF_Y = 162 * MiB, OFF_R = 226 * MiB;
constexpr size_t OFF_PROJ = OFF_R, OFF_Q = OFF_R + 112 * MiB, OFF_KN = OFF_Q + 48 * MiB, OFF_VT = OFF_KN + 32 * MiB, OFF_KR = OFF_VT + 32 * MiB,
                 OFF_GATES = OFF_KR + 2 * MiB, OFF_STU = OFF_GATES + 2 * MiB, OFF_STN = OFF_STU + 32 * MiB, OFF_STS = OFF_STN + 1 * MiB, OFF_END = OFF_STS + 1 * MiB;
constexpr size_t OFF_HID = OFF_R;
constexpr size_t OFF_CNT = OFF_END;
constexpr size_t OFF_XBAR = OFF_END + 4096;
constexpr size_t OFF_STAT = OFF_XBAR + 16384;
constexpr size_t OFF_ID = OFF_STAT + (size_t)MT * 8;
static_assert(OFF_ID + 8192 <= 512 * MiB, "ws");
static_assert(OFF_HID + (size_t)MT * DFF * 2 <= OFF_END, "hid");

constexpr int LDS_BYTES = 151552;

struct Params {
  const float* in[21];
  float* out;
  unsigned char* ws;
  int ph_lo, ph_hi;
};

__device__ __forceinline__ unsigned pk2(float lo, float hi) { f32x2 v = {lo, hi}; bf16x2_t b = __builtin_convertvector(v, bf16x2_t); return __builtin_bit_cast(unsigned, b); }
__device__ __forceinline__ bf16_t f2bf(float x) { return (bf16_t)(pk2(x, 0.f) & 0xffffu); }
__device__ __forceinline__ float bf2f(bf16_t b) { return __uint_as_float(((unsigned)b) << 16); }
__device__ __forceinline__ float bflo(unsigned w) { return __uint_as_float(w << 16); }
__device__ __forceinline__ float bfhi(unsigned w) { return __uint_as_float(w & 0xffff0000u); }
__device__ __forceinline__ int crow(int r, int hi) { return (r & 3) + 8 * (r >> 2) + 4 * hi; }
__device__ __forceinline__ float wave_sum(float v) {
  v += __shfl_xor(v, 32); v += __shfl_xor(v, 16); v += __shfl_xor(v, 8); v += __shfl_xor(v, 4); v += __shfl_xor(v, 2); v += __shfl_xor(v, 1); return v;
}
__device__ __forceinline__ int otid() { int t = threadIdx.x; asm volatile("" : "+v"(t)); return t; }
#define MFMA32(a, b, c) __builtin_amdgcn_mfma_f32_32x32x16_bf16((a), (b), (c), 0, 0, 0)
#define PK4(P, BASE, OUT) do { unsigned a0_ = pk2(P[BASE + 0], P[BASE + 1]), a1_ = pk2(P[BASE + 2], P[BASE + 3]);   \
    unsigned b0_ = pk2(P[BASE + 4], P[BASE + 5]), b1_ = pk2(P[BASE + 6], P[BASE + 7]);                              \
    auto r0_ = __builtin_amdgcn_permlane32_swap(a0_, b0_, false, false); auto r1_ = __builtin_amdgcn_permlane32_swap(a1_, b1_, false, false); \
    u32x4 w_ = {r0_[0], r1_[0], r0_[1], r1_[1]}; OUT = __builtin_bit_cast(bf16x8, w_); } while (0)

__device__ void prep_tile(const float* srcA, int colA, int limA, const float* srcB, int colB, int limB, int ld, int k0,
                          const float* kscale, float mul, bf16_t* dst, int ldd, int n0, float* tile) {
  const int tid = otid();
#pragma unroll
  for (int i = 0; i < 8; ++i) {
    const int kk = (tid >> 6) + 8 * i, nn = tid & 63;
    float v = 0.f;
    if (nn < 32) { const int c = colA + nn; if (c < limA) v = srcA[(size_t)(k0 + kk) * ld + c]; }
    else { const int c = colB + nn - 32; if (c < limB) v = srcB[(size_t)(k0 + kk) * ld + c]; }
    if (kscale) v *= kscale[k0 + kk];
    tile[kk * 65 + nn] = v * mul;
  }
  __syncthreads();
#pragma unroll
  for (int i = 0; i < 8; ++i) {
    const int nn = (tid >> 6) + 8 * i, kk = tid & 63;
    dst[(size_t)(n0 + nn) * ldd + k0 + kk] = f2bf(tile[kk * 65 + nn]);
  }
  __syncthreads();
}

__device__ void phase_prep(const Params& p, char* smem) {
  float* tile = (float*)smem;
  const int tid = otid();
  constexpr int N_IN = 28 * 16, N_UQ = 12 * 4, N_UKV = 16 * 2, N_OUT = 16 * 12, N_PF = 4 * 16, N_GU = 88 * 16, N_DN = 16 * 44;
  constexpr int PER_LAYER = N_IN + N_UQ + N_UKV + N_OUT + N_PF + N_GU + N_DN;
  constexpr int N_ROPE = 16384 * 16 / NTHR;
  const int total = PER_LAYER * DEPTH + N_ROPE;
  for (int it = blockIdx.x; it < total; it += gridDim.x) {
    if (it >= PER_LAYER * DEPTH) {
      const int e = (it - PER_LAYER * DEPTH) * NTHR + tid, pos = e >> 4, i = e & 15;
      const float inv = exp2f(-(float)i * (13.287712379549449f / 16.0f));
      const float ang = (float)pos * inv;
      double rev = (double)ang * 0.15915494309189535; rev -= floor(rev);
      const float fr = (float)rev;
      f32x2 cs = {__builtin_amdgcn_cosf(fr), __builtin_amdgcn_sinf(fr)};
      ((f32x2*)(p.ws + OFF_ROPE))[e] = cs;
      continue;
    }
    const int l = it / PER_LAYER; int j = it % PER_LAYER;
    unsigned char* wl = p.ws + OFF_W + (size_t)l * W_LAYER;
    if (j < N_IN) { const int nt = j / 16, kt = j % 16; const float* s = p.in[4] + (size_t)l * 1024 * INW;
      prep_tile(s, nt * 64, INW, s, nt * 64 + 32, INW, INW, kt * 64, nullptr, 1.f, (bf16_t*)(wl + W_IN), 1024, nt * 64, tile); continue; }
    j -= N_IN;
    if (j < N_UQ) { const int nt = j / 4, kt = j % 4; const float* s = p.in[6] + (size_t)l * 256 * 768;
      prep_tile(s, nt * 64, 768, s, nt * 64 + 32, 768, 768, kt * 64, p.in[5] + l * 256, QSCALE, (bf16_t*)(wl + W_UQ), 256, nt * 64, tile); continue; }
    j -= N_UQ;
    if (j < N_UKV) { const int nt = j / 2, kt = j % 2; const float* s = p.in[8] + (size_t)l * 128 * 1024;
      prep_tile(s, nt * 64, 1024, s, nt * 64 + 32, 1024, 1024, kt * 64, p.in[7] + l * 128, 1.f, (bf16_t*)(wl + W_UKV), 128, nt * 64, tile); continue; }
    j -= N_UKV;
    if (j < N_OUT) { const int nt = j / 12; int kt = j % 12; if (kt >= 8) kt += 4; const float* s = p.in[13] + (size_t)l * 1024 * 1024;
      prep_tile(s, nt * 64, 1024, s, nt * 64 + 32, 1024, 1024, kt * 64, nullptr, 1.f, (bf16_t*)(wl + W_OUT), 1024, nt * 64, tile); continue; }
    j -= N_OUT;
    if (j < N_PF) {
      const int g = j / 16, n0 = (j % 16) * 64, nn = tid & 63;
      const float* wo = p.in[13] + (size_t)l * 1024 * 1024 + (size_t)(512 + g * 64) * 1024 + n0 + nn;
      const float* wp = p.in[9] + (size_t)l * 4 * 64 * 64 + (size_t)g * 64 * 64;
      const float* ps = p.in[10] + l * 256 + g * 64;
      bf16_t* dst = (bf16_t*)(wl + W_OUT);
      for (int i = 0; i < 8; ++i) {
        const int c = (tid >> 6) + 8 * i; float s = 0.f;
        for (int d = 0; d < 64; ++d) s += wp[c * 64 + d] * ps[d] * wo[(size_t)d * 1024];
        dst[(size_t)(n0 + nn) * 1024 + 512 + g * 64 + c] = f2bf(s);
      }
      continue; }
    j -= N_PF;
    if (j < N_GU) { const int nt = j / 16, kt = j % 16, T = nt >> 2, sb = nt & 3;
      const float* s = ((sb < 2) ? p.in[16] : p.in[17]) + (size_t)l * 1024 * DFF; const int c0 = 128 * T + 64 * (sb & 1);
      prep_tile(s, c0, DFF, s, c0 + 32, DFF, DFF, kt * 64, nullptr, 1.f, (bf16_t*)(wl + W_GU), 1024, nt * 64, tile); continue; }
    j -= N_GU;
    { const int nt = j / 44, kt = j % 44; const float* s = p.in[18] + (size_t)l * DFF * 1024;
      prep_tile(s, nt * 64, 1024, s, nt * 64 + 32, 1024, 1024, kt * 64, nullptr, 1.f, (bf16_t*)(wl + W_DN), DFF, nt * 64, tile); }
  }
}

__device__ void phase_ln(const float* src, float* dst32, bf16_t* dstb, const float* g, const float* bta, int nrows, f32x2* stats, bool ident) {
  const int tid = otid(); const int lane = tid & 63, wid = tid >> 6;
  f32x4 gv[4], bv[4];
#pragma unroll
  for (int j = 0; j < 4; ++j) { gv[j] = *(const f32x4*)(g + j * 256 + lane * 4); bv[j] = *(const f32x4*)(bta + j * 256 + lane * 4); }
  const int rstride = gridDim.x * 8;
  for (int row0 = blockIdx.x * 8 + wid; row0 < nrows; row0 += 2 * rstride) {
    f32x4 v[2][4];
    const bool two = (row0 + rstride) < nrows;
#pragma unroll
    for (int j = 0; j < 4; ++j) v[0][j] = *(const f32x4*)(src + (size_t)row0 * 1024 + j * 256 + lane * 4);
    if (two) {
#pragma unroll
      for (int j = 0; j < 4; ++j) v[1][j] = *(const f32x4*)(src + (size_t)(row0 + rstride) * 1024 + j * 256 + lane * 4);
    }
#pragma unroll
    for (int u = 0; u < 2; ++u) {
      if (u == 1 && !two) break;
      const int row = row0 + u * rstride;
      float s = 0.f;
#pragma unroll
      for (int j = 0; j < 4; ++j) s += (v[u][j][0] + v[u][j][1]) + (v[u][j][2] + v[u][j][3]);
      const float mean = wave_sum(s) * (1.f / 1024.f);
      float q = 0.f;
#pragma unroll
      for (int j = 0; j < 4; ++j) { f32x4 d = v[u][j] - mean; q += (d[0] * d[0] + d[1] * d[1]) + (d[2] * d[2] + d[3] * d[3]); }
      const float rstd = rsqrtf(wave_sum(q) * (1.f / 1024.f) + LN_EPS);
      if (lane == 0) { f32x2 sv = {ident ? 0.f : mean, ident ? 1.f : rstd}; stats[row] = sv; }
#pragma unroll
      for (int j = 0; j < 4; ++j) {
        f32x4 o = (v[u][j] - mean) * rstd * gv[j] + bv[j];
        if (dst32) *(f32x4*)(dst32 + (size_t)row * 1024 + j * 256 + lane * 4) = o;
        u32x2 w = {pk2(o[0], o[1]), pk2(o[2], o[3])};
        *(u32x2*)(dstb + (size_t)row * 1024 + j * 256 + lane * 4) = w;
      }
    }
  }
}

constexpr int G_BUF = 256 * 64;
constexpr int G_SMEM_BYTES = 4 * G_BUF * 2;
#define LAS3 __attribute__((address_space(3)))

template <class Epi>
__device__ __forceinline__ void gemm_tile(const bf16_t* __restrict__ A, int lda, const bf16_t* __restrict__ Bt, int K, int m0, int n0, char* smem, const Epi& epi) {
  const int tid = otid(), lane = tid & 63, wid = tid >> 6, wm = wid >> 2, wn = wid & 3, r32 = lane & 31, hi = lane >> 5;
  LAS3 unsigned char* lds = (LAS3 unsigned char*)smem;
  const int rowl = wid * 8 + (lane >> 3), gch = (lane & 7) ^ ((rowl >> 1) & 7);
  const bf16_t* pa = A + (size_t)(m0 + rowl) * lda + gch * 8;
  const bf16_t* pb = Bt + (size_t)(n0 + rowl) * K + gch * 8;
  const size_t sa = (size_t)64 * lda, sb = (size_t)64 * K;
  const unsigned wbase = (unsigned)__builtin_amdgcn_readfirstlane(wid * 1024);
#define G_DMA(buf, k0) do { _Pragma("unroll") for (int j_ = 0; j_ < 4; ++j_) { \
    __builtin_amdgcn_global_load_lds((const unsigned*)(pa + j_ * sa + (k0)), (LAS3 unsigned*)(lds + (buf) * 32768 + j_ * 8192 + wbase), 16, 0, 0); \
    __builtin_amdgcn_global_load_lds((const unsigned*)(pb + j_ * sb + (k0)), (LAS3 unsigned*)(lds + 65536 + (buf) * 32768 + j_ * 8192 + wbase), 16, 0, 0); } } while (0)
  f32x16 acc[2][4];
#pragma unroll
  for (int a = 0; a < 2; ++a)
#pragma unroll
    for (int b = 0; b < 4; ++b) acc[a][b] = f32x16{};
  G_DMA(0, 0);
  asm volatile("s_waitcnt vmcnt(0)" ::: "memory");
  __syncthreads();
  const int nk = K >> 6;
  const int swz = (r32 >> 1) & 7;
  int koff[4];
#pragma unroll
  for (int kk = 0; kk < 4; ++kk) koff[kk] = ((kk * 2 + hi) ^ swz) * 16;
  const int aoff = (wm * 128 + r32) * 128, boff = 65536 + (wn * 64 + r32) * 128;
  for (int t = 0; t < nk; ++t) {
    const int buf = t & 1;
    if (t + 1 < nk) G_DMA(buf ^ 1, (t + 1) * 64);
    const LAS3 unsigned char* as = lds + buf * 32768 + aoff; const LAS3 unsigned char* bs = lds + buf * 32768 + boff;
    bf16x8 af[2][4], bfr[2][2];
#define G_LDF(S, KK) do { _Pragma("unroll") for (int mt = 0; mt < 4; ++mt) af[S][mt] = *(const LAS3 bf16x8*)(as + mt * 4096 + koff[KK]); \
      _Pragma("unroll") for (int nt = 0; nt < 2; ++nt) bfr[S][nt] = *(const LAS3 bf16x8*)(bs + nt * 4096 + koff[KK]); } while (0)
    G_LDF(0, 0);
#pragma unroll
    for (int kk = 0; kk < 4; ++kk) {
      if (kk < 3) G_LDF((kk + 1) & 1, kk + 1);
      __builtin_amdgcn_sched_barrier(0);
#pragma unroll
      for (int nt = 0; nt < 2; ++nt)
#pragma unroll
        for (int mt = 0; mt < 4; ++mt) acc[nt][mt] = MFMA32(bfr[kk & 1][nt], af[kk & 1][mt], acc[nt][mt]);
      __builtin_amdgcn_sched_barrier(0);
    }
#undef G_LDF
    asm volatile("s_waitcnt vmcnt(0)" ::: "memory");
    __syncthreads();
  }
#undef G_DMA
  epi(acc, m0, n0, wm, wn, r32, hi);
}

struct EpiInProj {
  bf16_t* proj; float* gates; char* smem;
  __device__ __forceinline__ void operator()(const f32x16 (&acc)[2][4], int m0, int n0, int wm, int wn, int r32, int hi) const {
    const int lane = r32 + 32 * hi, wid = wm * 4 + wn;
    bf16_t* wl = (bf16_t*)smem + wid * (32 * 72);
    const int c = lane & 7, rq = lane >> 3;
#pragma unroll
    for (int mt = 0; mt < 4; ++mt) {
      const int m = m0 + wm * 128 + mt * 32 + r32;
#pragma unroll
      for (int nt = 0; nt < 2; ++nt)
#pragma unroll
        for (int g = 0; g < 4; ++g) {
          const int nb = n0 + wn * 64 + nt * 32 + g * 8 + hi * 4;
          const f32x16& a = acc[nt][mt];
          u32x2 w = {pk2(a[4 * g], a[4 * g + 1]), pk2(a[4 * g + 2], a[4 * g + 3])};
          *(u32x2*)(wl + r32 * 72 + nt * 32 + g * 8 + hi * 4) = w;
          if (nb >= C_G && nb < INW) { f32x4 v = {a[4 * g], a[4 * g + 1], a[4 * g + 2], a[4 * g + 3]}; *(f32x4*)(gates + (size_t)m * 16 + (nb - C_G)) = v; }
        }
      asm volatile("s_waitcnt lgkmcnt(0)" ::: "memory");
#pragma unroll
      for (int i = 0; i < 4; ++i) {
        const int rr = rq + 8 * i;
        const u32x4 v = *(const u32x4*)(wl + rr * 72 + c * 8);
        *(u32x4*)(proj + (size_t)(m0 + wm * 128 + mt * 32 + rr) * NPROJ + n0 + wn * 64 + c * 8) = v;
      }
      asm volatile("s_waitcnt lgkmcnt(0)" ::: "memory");
    }
    __syncthreads();
  }
};

struct EpiQUp {
  bf16_t* Q; const float* rs; const f32x2* rope; int smask; char* smem;
  __device__ __forceinline__ void operator()(const f32x16 (&acc)[2][4], int m0, int n0, int wm, int wn, int r32, int hi) const {
    const int lane = r32 + 32 * hi, wid = wm * 4 + wn;
    bf16_t* wl = (bf16_t*)smem + wid * 2560;
    const int c = lane & 7, rq = lane >> 3;
#pragma unroll
    for (int mt = 0; mt < 4; ++mt) {
      const int ml = wm * 128 + mt * 32 + r32, m = m0 + ml; const float r = rs[ml]; const int pos = m & smask;
#pragma unroll
      for (int nt = 0; nt < 2; ++nt) {
        const int nb0 = n0 + wn * 64 + nt * 32; const int t32 = nb0 >> 5; const bool isrope = (t32 % 3) == 2;
        float v[16];
#pragma unroll
        for (int k = 0; k < 16; ++k) v[k] = acc[nt][mt][k] * r;
        if (isrope) {
#pragma unroll
          for (int g = 0; g < 2; ++g)
#pragma unroll
            for (int i = 0; i < 4; ++i) {
              const int dd = 8 * g + 4 * hi + i; const f32x2 cs = rope[pos * 16 + dd];
              const float x1 = v[4 * g + i], x2 = v[4 * g + i + 8];
              v[4 * g + i] = x1 * cs[0] - x2 * cs[1]; v[4 * g + i + 8] = x2 * cs[0] + x1 * cs[1];
            }
        }
#pragma unroll
        for (int g = 0; g < 4; ++g) { u32x2 w = {pk2(v[4 * g], v[4 * g + 1]), pk2(v[4 * g + 2], v[4 * g + 3])}; *(u32x2*)(wl + r32 * 72 + nt * 32 + g * 8 + hi * 4) = w; }
      }
      asm volatile("s_waitcnt lgkmcnt(0)" ::: "memory");
#pragma unroll
      for (int i = 0; i < 4; ++i) { const int rr = rq + 8 * i; const u32x4 w = *(const u32x4*)(wl + rr * 72 + c * 8);
        *(u32x4*)(Q + (size_t)(m0 + wm * 128 + mt * 32 + rr) * 768 + n0 + wn * 64 + c * 8) = w; }
      asm volatile("s_waitcnt lgkmcnt(0)" ::: "memory");
    }
  }
};

struct EpiKVUp {
  bf16_t* Kn; bf16_t* Vt; const float* rs; int S, slog, smask; char* smem;
  __device__ __forceinline__ void operator()(const f32x16 (&acc)[2][4], int m0, int n0, int wm, int wn, int r32, int hi) const {
    const int lane = r32 + 32 * hi, wid = wm * 4 + wn;
    bf16_t* wl = (bf16_t*)smem + wid * 2560;
    const int nbw = n0 + wn * 64, head = nbw >> 7; const bool isv = (nbw & 64) != 0;
#pragma unroll
    for (int mt = 0; mt < 4; ++mt) {
      const int ml = wm * 128 + mt * 32 + r32; const float r = rs[ml];
      const int mg = m0 + wm * 128 + mt * 32;
      if (!isv) {
#pragma unroll
        for (int nt = 0; nt < 2; ++nt)
#pragma unroll
          for (int g = 0; g < 4; ++g) { const f32x16& a = acc[nt][mt];
            u32x2 w = {pk2(a[4 * g] * r, a[4 * g + 1] * r), pk2(a[4 * g + 2] * r, a[4 * g + 3] * r)};
            *(u32x2*)(wl + r32 * 72 + nt * 32 + g * 8 + hi * 4) = w; }
        asm volatile("s_waitcnt lgkmcnt(0)" ::: "memory");
        const int c = lane & 7, rq = lane >> 3;
#pragma unroll
        for (int i = 0; i < 4; ++i) { const int rr = rq + 8 * i; const u32x4 w = *(const u32x4*)(wl + rr * 72 + c * 8);
          *(u32x4*)(Kn + (size_t)(mg + rr) * 512 + head * 64 + c * 8) = w; }
      } else {
#pragma unroll
        for (int nt = 0; nt < 2; ++nt)
#pragma unroll
          for (int k = 0; k < 16; ++k) { const int dv = nt * 32 + 8 * (k >> 2) + 4 * hi + (k & 3); wl[dv * 40 + r32] = f2bf(acc[nt][mt][k] * r); }
        asm volatile("s_waitcnt lgkmcnt(0)" ::: "memory");
        const int cc = lane & 3, dq = lane >> 2; const int pos0 = mg & smask, bb = mg >> slog;
#pragma unroll
        for (int i = 0; i < 4; ++i) { const int dvr = dq + 16 * i; const u32x4 w = *(const u32x4*)(wl + dvr * 40 + cc * 8);
          *(u32x4*)(Vt + ((size_t)(bb * 8 + head) * 64 + dvr) * S + pos0 + cc * 8) = w; }
      }
      asm volatile("s_waitcnt lgkmcnt(0)" ::: "memory");
    }
  }
};

struct EpiResid {
  float* x; char* smem;
  __device__ __forceinline__ void operator()(const f32x16 (&acc)[2][4], int m0, int n0, int wm, int wn, int r32, int hi) const {
    const int lane = r32 + 32 * hi, wid = wm * 4 + wn;
    float* wl = (float*)smem + wid * (32 * 68);
    const int c = lane & 15, rq = lane >> 4;
    float* xb = x + (size_t)(m0 + wm * 128 + rq) * 1024 + n0 + wn * 64 + c * 4;
    f32x4 xc[8], xn[8];
#pragma unroll
    for (int i = 0; i < 8; ++i) xc[i] = *(const f32x4*)(xb + (size_t)(4 * i) * 1024);
#pragma unroll
    for (int mt = 0; mt < 4; ++mt) {
      if (mt < 3) {
#pragma unroll
        for (int i = 0; i < 8; ++i) xn[i] = *(const f32x4*)(xb + (size_t)((mt + 1) * 32 + 4 * i) * 1024);
      }
#pragma unroll
      for (int nt = 0; nt < 2; ++nt)
#pragma unroll
        for (int g = 0; g < 4; ++g) { const f32x16& a = acc[nt][mt];
          f32x4 v = {a[4 * g], a[4 * g + 1], a[4 * g + 2], a[4 * g + 3]};
          *(f32x4*)(wl + r32 * 68 + nt * 32 + g * 8 + hi * 4) = v; }
      asm volatile("s_waitcnt lgkmcnt(0)" ::: "memory");
      f32x4 ov[8];
#pragma unroll
      for (int i = 0; i < 8; ++i) { const f32x4 a = *(const f32x4*)(wl + (rq + 4 * i) * 68 + c * 4); ov[i] = xc[i] * DN_ALPHA + a; }
#pragma unroll
      for (int i = 0; i < 8; ++i) *(f32x4*)(xb + (size_t)(mt * 32 + 4 * i) * 1024) = ov[i];
      asm volatile("s_waitcnt lgkmcnt(0)" ::: "memory");
#pragma unroll
      for (int i = 0; i < 8; ++i) xc[i] = xn[i];
    }
    __syncthreads();
  }
};

struct EpiGU {
  bf16_t* hid; char* smem;
  __device__ __forceinline__ void operator()(const f32x16 (&acc)[2][4], int m0, int n0, int wm, int wn, int r32, int hi) const {
    const int hb = (n0 + wn * 64) >> 1;
    const int lane = r32 + 32 * hi, wid = wm * 4 + wn;
    bf16_t* wl = (bf16_t*)smem + wid * (32 * 40);
    const int c = lane & 3, rq = lane >> 2;
#pragma unroll
    for (int mt = 0; mt < 4; ++mt) {
#pragma unroll
      for (int g = 0; g < 4; ++g) {
        float o[4];
#pragma unroll
        for (int i = 0; i < 4; ++i) { const float gt = acc[0][mt][4 * g + i], up = acc[1][mt][4 * g + i]; o[i] = gt * up * __builtin_amdgcn_rcpf(1.f + __builtin_amdgcn_exp2f(-1.4426950408889634f * gt)); }
        u32x2 w = {pk2(o[0], o[1]), pk2(o[2], o[3])};
        *(u32x2*)(wl + r32 * 40 + g * 8 + hi * 4) = w;
      }
      asm volatile("s_waitcnt lgkmcnt(0)" ::: "memory");
#pragma unroll
      for (int i = 0; i < 2; ++i) {
        const int rr = rq + 16 * i;
        const u32x4 v = *(const u32x4*)(wl + rr * 40 + c * 8);
        *(u32x4*)(hid + (size_t)(m0 + wm * 128 + mt * 32 + rr) * DFF + hb + c * 8) = v;
      }
      asm volatile("s_waitcnt lgkmcnt(0)" ::: "memory");
    }
    __syncthreads();
  }
};

namespace pg8 {
#define PG8_LAS __attribute__((address_space(3)))
typedef unsigned short bf16_t;
typedef short bf16x8 __attribute__((ext_vector_type(8)));
typedef float f32x4 __attribute__((ext_vector_type(4)));
typedef unsigned u32x4 __attribute__((ext_vector_type(4)));
constexpr int BM = 256, BK = 64, HALF = 128, HTB = HALF * BK * 2  , STAGE_BYTES = 8 * HTB, NXCD = 8, WGM = 8;

__host__ __device__ __forceinline__ int lds_byte(int r, int c) { const int st = (r >> 4) * 2 + (c >> 5), rr = r & 15, cc = c & 31, ob = rr * 64 + cc * 2; return st * 1024 + (ob ^ (((ob >> 9) & 1) << 5)); }
__host__ __device__ __forceinline__ void stage_rc(int b, int& R, int& C) { const int st = b / 1024, sb = b % 1024, swz = sb ^ (((sb >> 9) & 1) << 5); R = (st >> 1) * 16 + swz / 64; C = (st & 1) * 32 + (swz % 64) / 2; }
__host__ __device__ __forceinline__ int perm32(int rho) { const int n = rho >> 4, i = rho & 15; return 8 * (i >> 2) + 4 * n + (i & 3); }

struct Unit { int pm, pn; };
struct Gemm { const bf16_t* A; const bf16_t* Bt; int M, N, K, lda; };

struct StaticOrder {
    int nM, nN, nwg, G, c;
    __host__ __device__ void init(int M, int N, int G_, int c_) { nM = M / BM; nN = N / BM; nwg = nM * nN; G = G_; c = c_; }
    __host__ __device__ bool next(int i, Unit& u) const {
        const long L = (long)i * G + c; if (L >= nwg) return false;
        int wgid = (int)L; { const int q = nwg / NXCD, r = nwg % NXCD, xcd = wgid % NXCD, off = wgid / NXCD; wgid = (xcd < r ? xcd * (q + 1) : r * (q + 1) + (xcd - r) * q) + off; }
        const int nig = WGM * nN, gid = wgid / nig, fm = gid * WGM, gsz = (nM - fm) < WGM ? (nM - fm) : WGM;
        u.pm = fm + ((wgid % nig) % gsz); u.pn = (wgid % nig) / gsz; return true;
    }
    __device__ __forceinline__ void a_ready(const Unit&) const {}
    __device__ __forceinline__ void done(const Unit&) const {}
};


struct EpiInProj2 {
  static constexpr bool PERM = true, AFTER_DRAIN = false;
  bf16_t* proj; float* gates;
  __device__ __forceinline__ void operator()(const f32x4 (&acc)[2][2][4][2], const Unit& u, int wr, int wc, int fr, int fq) const {
#pragma unroll
    for (int ai = 0; ai < 2; ++ai)
#pragma unroll
      for (int m = 0; m < 4; ++m) { const size_t row = (size_t)u.pm * BM + ai * HALF + wr * 64 + m * 16 + fr;
#pragma unroll
        for (int bj = 0; bj < 2; ++bj) { const int col0 = u.pn * BM + bj * HALF + wc * 32 + 8 * fq; const f32x4 v0 = acc[ai][bj][m][0], v1 = acc[ai][bj][m][1];
          u32x4 w; w.x = pk2(v0[0], v0[1]); w.y = pk2(v0[2], v0[3]); w.z = pk2(v1[0], v1[1]); w.w = pk2(v1[2], v1[3]);
          *(u32x4*)(proj + row * NPROJ + col0) = w;
          if (col0 >= C_G && col0 < INW) { *(f32x4*)(gates + row * 16 + (col0 - C_G)) = v0; *(f32x4*)(gates + row * 16 + (col0 - C_G) + 4) = v1; } } }
  }
};
struct EpiResid2 {
  static constexpr bool PERM = false, AFTER_DRAIN = false;
  float* x; const f32x2* stats; const float* g; const float* b;
  __device__ __forceinline__ void operator()(const f32x4 (&acc)[2][2][4][2], const Unit& u, int wr, int wc, int fr, int fq) const {
    const int row0 = u.pm * BM + wr * 64 + fr, col0 = u.pn * BM + wc * 32 + 4 * fq;
    float* rb = x + (size_t)row0 * 1024 + col0;
#pragma unroll
    for (int ai = 0; ai < 2; ++ai)
#pragma unroll
      for (int m = 0; m < 4; ++m) {
        f32x4 xc[2][2]; const f32x2 sv = stats[row0 + ai * HALF + m * 16];
#pragma unroll
        for (int bj = 0; bj < 2; ++bj)
#pragma unroll
          for (int n = 0; n < 2; ++n) xc[bj][n] = *(const f32x4*)(rb + (size_t)(ai * HALF + m * 16) * 1024 + bj * HALF + n * 16);
#pragma unroll
        for (int bj = 0; bj < 2; ++bj)
#pragma unroll
          for (int n = 0; n < 2; ++n) { const f32x4 gv = *(const f32x4*)(g + col0 + bj * HALF + n * 16), bv = *(const f32x4*)(b + col0 + bj * HALF + n * 16);
            const f32x4 xn = (xc[bj][n] - sv[0]) * sv[1] * gv + bv;
            *(f32x4*)(rb + (size_t)(ai * HALF + m * 16) * 1024 + bj * HALF + n * 16) = xn * DN_ALPHA + acc[ai][bj][m][n]; }
        asm volatile("" ::: "memory");
      }
  }
};
struct EpiGU2 {
  static constexpr bool PERM = true, AFTER_DRAIN = false;
  bf16_t* hid;
  __device__ __forceinline__ void operator()(const f32x4 (&acc)[2][2][4][2], const Unit& u, int wr, int wc, int fr, int fq) const {
#pragma unroll
    for (int ai = 0; ai < 2; ++ai)
#pragma unroll
      for (int m = 0; m < 4; ++m) { const size_t row = (size_t)u.pm * BM + ai * HALF + wr * 64 + m * 16 + fr; float o[8];
#pragma unroll
        for (int n = 0; n < 2; ++n)
#pragma unroll
          for (int i = 0; i < 4; ++i) { const float gt = acc[ai][0][m][n][i], up = acc[ai][1][m][n][i]; o[4 * n + i] = gt * up * __builtin_amdgcn_rcpf(1.f + __builtin_amdgcn_exp2f(-1.4426950408889634f * gt)); }
        u32x4 w; w.x = pk2(o[0], o[1]); w.y = pk2(o[2], o[3]); w.z = pk2(o[4], o[5]); w.w = pk2(o[6], o[7]);
        *(u32x4*)(hid + row * DFF + u.pn * HALF + wc * 32 + 8 * fq) = w; }
  }
};
template <class Epi, class Sched, bool ALIGN_EPI = false, bool SP2 = false>
__device__ __forceinline__ void gemm_phase(PG8_LAS unsigned char* lds, const Gemm g, const Sched& S, const Epi& E) {
    const int tid = otid(), wid = __builtin_amdgcn_readfirstlane(tid >> 6), lane = tid & 63, wr = wid >> 2, wc = wid & 3, fr = lane & 15, fq = lane >> 4;
    const int K = g.K, nt = K / BK;
    unsigned voffA[2], voffB[2];
#pragma unroll
    for (int i = 0; i < 2; ++i) { int R, C; stage_rc(tid * 16 + i * 8192, R, C); const int Rb = Epi::PERM ? ((R & ~31) + perm32(R & 31)) : R;
        voffA[i] = (unsigned)(R * g.lda + C) * 2u; voffB[i] = (unsigned)(Rb * K + C) * 2u; }
    const size_t kstep = (size_t)(BK * 2);
    const size_t hstepB = (size_t)HALF * K * 2, hstepA = (size_t)HALF * g.lda * 2;
    const size_t tstepA = 2 * hstepA, tstepB = 2 * hstepB;
    const unsigned ldsw = (unsigned)wid * 1024u;
    const int aoff = lds_byte(wr * 64 + fr, fq * 8), boff = lds_byte(wc * 32 + fr, fq * 8);
#define PG8_SA(b, h) (((b) * 2 + (h)) * HTB)
#define PG8_SB(b, h) ((4 + (b) * 2 + (h)) * HTB)
#define PG8_STAGE(bufoff, gbase, voff) do { _Pragma("unroll") for (int _i = 0; _i < 2; ++_i) \
        __builtin_amdgcn_global_load_lds((const unsigned*)((const char*)(gbase) + (voff)[_i]), (PG8_LAS unsigned*)(lds + (bufoff) + ldsw + _i * 8192), 16, 0, 0); } while (0)
#define PG8_LDA(dst, b, h) do { _Pragma("unroll") for (int m = 0; m < 4; ++m) _Pragma("unroll") for (int k = 0; k < 2; ++k) dst[m][k] = *(const PG8_LAS bf16x8*)(lds + PG8_SA(b, h) + aoff + m * 2048 + k * 1024); } while (0)
#define PG8_LDB(dst, b, h) do { _Pragma("unroll") for (int n = 0; n < 2; ++n) _Pragma("unroll") for (int k = 0; k < 2; ++k) dst[n][k] = *(const PG8_LAS bf16x8*)(lds + PG8_SB(b, h) + boff + n * 2048 + k * 1024); } while (0)
#define PG8_MMA(ai, bj, At, Bt) do { __builtin_amdgcn_s_setprio(1); _Pragma("unroll") for (int m = 0; m < 4; ++m) _Pragma("unroll") for (int n = 0; n < 2; ++n) _Pragma("unroll") for (int k = 0; k < 2; ++k) \
        acc[ai][bj][m][n] = __builtin_amdgcn_mfma_f32_16x16x32_bf16(Bt[n][k], At[m][k], acc[ai][bj][m][n], 0, 0, 0); __builtin_amdgcn_s_setprio(0); } while (0)
#define PG8_WAIT_V(n) asm volatile("s_waitcnt vmcnt(" #n ")" ::: "memory")
#define PG8_WAIT_L(n) asm volatile("s_waitcnt lgkmcnt(" #n ")" ::: "memory")
#define PG8_BAR __builtin_amdgcn_s_barrier()
#define PG8_SCHED __builtin_amdgcn_sched_barrier(0)
    Unit cur, nxt; int ui = 0;
    if (!S.next(0, cur)) return;
    f32x4 acc[2][2][4][2];
#pragma unroll
    for (int a = 0; a < 2; ++a)
#pragma unroll
        for (int b = 0; b < 2; ++b)
#pragma unroll
            for (int m = 0; m < 4; ++m)
#pragma unroll
                for (int n = 0; n < 2; ++n) acc[a][b][m][n] = (f32x4){0.f, 0.f, 0.f, 0.f};
    bf16x8 At[4][2], B0[2][2], B1[2][2];
    const char* cA = (const char*)g.A + (size_t)cur.pm * tstepA; const char* cB = (const char*)g.Bt + (size_t)cur.pn * tstepB;
    S.a_ready(cur);
    if constexpr (SP2) {
        PG8_STAGE(PG8_SB(0, 0), cB, voffB); PG8_STAGE(PG8_SB(0, 1), cB + hstepB, voffB); PG8_STAGE(PG8_SA(0, 0), cA, voffA); PG8_STAGE(PG8_SA(0, 1), cA + hstepA, voffA);
        if (wr == 1) PG8_BAR;
        PG8_WAIT_V(2); PG8_BAR;
        PG8_STAGE(PG8_SB(1, 0), cB + kstep, voffB); PG8_STAGE(PG8_SA(1, 0), cA + kstep, voffA); PG8_STAGE(PG8_SB(1, 1), cB + hstepB + kstep, voffB);
        PG8_WAIT_V(6); PG8_BAR;
    } else {
        PG8_STAGE(PG8_SB(0, 0), cB, voffB); PG8_STAGE(PG8_SA(0, 0), cA, voffA); PG8_STAGE(PG8_SB(0, 1), cB + hstepB, voffB); PG8_STAGE(PG8_SA(0, 1), cA + hstepA, voffA);
        if (wr == 1) PG8_BAR;
        PG8_WAIT_V(4); PG8_BAR;
        PG8_STAGE(PG8_SB(1, 0), cB + kstep, voffB); PG8_STAGE(PG8_SA(1, 0), cA + kstep, voffA); PG8_STAGE(PG8_SB(1, 1), cB + hstepB + kstep, voffB);
        PG8_WAIT_V(6); PG8_BAR;
    }
    for (;;) {
        const bool has_next = S.next(ui + 1, nxt);
        const char* nA = has_next ? (const char*)g.A + (size_t)nxt.pm * tstepA : cA; const char* nB = has_next ? (const char*)g.Bt + (size_t)nxt.pn * tstepB : cB;
        for (int t = 0; t < nt; t += 2) {
            const bool last = (t == nt - 2);
            const char* a1 = cA + (size_t)(t + 1) * kstep;
            const char* a2 = last ? nA : cA + (size_t)(t + 2) * kstep; const char* b2 = last ? nB : cB + (size_t)(t + 2) * kstep;
            const char* a3 = a2 + kstep; const char* b3 = b2 + kstep;
            if (last && has_next) S.a_ready(nxt);
            if constexpr (SP2) {
            PG8_LDB(B0, 0, 0); PG8_LDB(B1, 0, 1); PG8_SCHED; PG8_LDA(At, 0, 0); PG8_STAGE(PG8_SA(1, 1), a1 + hstepA, voffA);
            PG8_WAIT_V(8); PG8_WAIT_L(0); PG8_BAR; PG8_MMA(0, 0, At, B0); PG8_MMA(0, 1, At, B1); PG8_BAR; PG8_SCHED;
            PG8_LDA(At, 0, 1); PG8_STAGE(PG8_SB(0, 0), b2, voffB); PG8_STAGE(PG8_SB(0, 1), b2 + hstepB, voffB); PG8_STAGE(PG8_SA(0, 0), a2, voffA);
            PG8_WAIT_V(8); PG8_WAIT_L(0); PG8_BAR; PG8_MMA(1, 0, At, B0); PG8_MMA(1, 1, At, B1); PG8_BAR; PG8_SCHED;
            PG8_LDB(B0, 1, 0); PG8_LDB(B1, 1, 1); PG8_SCHED; PG8_LDA(At, 1, 0); PG8_STAGE(PG8_SA(0, 1), a2 + hstepA, voffA);
            PG8_WAIT_V(8); PG8_WAIT_L(0); PG8_BAR; PG8_MMA(0, 0, At, B0); PG8_MMA(0, 1, At, B1); PG8_BAR; PG8_SCHED;
            PG8_LDA(At, 1, 1); PG8_STAGE(PG8_SB(1, 0), b3, voffB); PG8_STAGE(PG8_SB(1, 1), b3 + hstepB, voffB); PG8_STAGE(PG8_SA(1, 0), a3, voffA);
            PG8_WAIT_V(8); PG8_WAIT_L(0); PG8_BAR; PG8_MMA(1, 0, At, B0); PG8_MMA(1, 1, At, B1); PG8_BAR; PG8_SCHED;
            } else {
            PG8_LDB(B0, 0, 0); PG8_SCHED; PG8_LDA(At, 0, 0); PG8_STAGE(PG8_SA(1, 1), a1 + hstepA, voffA);
            PG8_WAIT_L(8); PG8_BAR; PG8_WAIT_L(0); PG8_MMA(0, 0, At, B0); PG8_BAR; PG8_SCHED;
            PG8_LDB(B1, 0, 1); PG8_STAGE(PG8_SB(0, 0), b2, voffB);
            PG8_BAR; PG8_WAIT_L(0); PG8_MMA(0, 1, At, B1); PG8_BAR;
            PG8_LDA(At, 0, 1); PG8_STAGE(PG8_SA(0, 0), a2, voffA);
            PG8_BAR; PG8_WAIT_L(0); PG8_MMA(1, 0, At, B0); PG8_BAR; PG8_SCHED;
            PG8_STAGE(PG8_SB(0, 1), b2 + hstepB, voffB);
            PG8_WAIT_V(6); PG8_BAR; PG8_MMA(1, 1, At, B1); PG8_BAR;
            PG8_LDB(B0, 1, 0); PG8_SCHED; PG8_LDA(At, 1, 0); PG8_STAGE(PG8_SA(0, 1), a2 + hstepA, voffA);
            PG8_WAIT_L(8); PG8_BAR; PG8_WAIT_L(0); PG8_MMA(0, 0, At, B0); PG8_BAR; PG8_SCHED;
            PG8_LDB(B1, 1, 1); PG8_STAGE(PG8_SB(1, 0), b3, voffB);
            PG8_BAR; PG8_WAIT_L(0); PG8_MMA(0, 1, At, B1); PG8_BAR;
            PG8_LDA(At, 1, 1); PG8_STAGE(PG8_SA(1, 0), a3, voffA);
            PG8_BAR; PG8_WAIT_L(0); PG8_MMA(1, 0, At, B0); PG8_BAR; PG8_SCHED;
            PG8_STAGE(PG8_SB(1, 1), b3 + hstepB, voffB);
            PG8_WAIT_V(6); PG8_BAR; PG8_MMA(1, 1, At, B1); PG8_BAR;
            }
        }
        if constexpr (ALIGN_EPI) { if (wr == 0) PG8_BAR; }
        if constexpr (!Epi::AFTER_DRAIN) { E(acc, cur, wr, wc, fr, fq); S.done(cur); }
        if (!has_next) break;
#pragma unroll
        for (int a = 0; a < 2; ++a)
#pragma unroll
            for (int b = 0; b < 2; ++b)
#pragma unroll
                for (int m = 0; m < 4; ++m)
#pragma unroll
                    for (int n = 0; n < 2; ++n) acc[a][b][m][n] = (f32x4){0.f, 0.f, 0.f, 0.f};
        cur = nxt; cA = nA; cB = nB; ++ui;
        if constexpr (ALIGN_EPI) { if (wr == 1) PG8_BAR; }
    }
    PG8_WAIT_V(0);
    if constexpr (!ALIGN_EPI) { if (wr == 0) PG8_BAR; }
    PG8_BAR;
    if constexpr (Epi::AFTER_DRAIN) { E.fused(acc, cur, wr, wc, fr, fq, lds, wid, lane); S.done(cur); }
#undef PG8_SA
#undef PG8_SB
#undef PG8_STAGE
#undef PG8_LDA
#undef PG8_LDB
#undef PG8_MMA
#undef PG8_WAIT_V
#undef PG8_WAIT_L
#undef PG8_BAR
#undef PG8_SCHED
}
}


__device__ __forceinline__ void row_rms(const bf16_t* A, int lda, int K, int m0, float* rs) {
  const int tid = otid(), row = tid >> 1, half = tid & 1;
  const bf16_t* p = A + (size_t)(m0 + row) * lda + half * (K >> 1);
  float s = 0.f;
  for (int i = 0; i < (K >> 4); ++i) { const u32x4 w = *(const u32x4*)(p + i * 8);
#pragma unroll
    for (int k = 0; k < 4; ++k) { const float a = bflo(w[k]), b = bfhi(w[k]); s += a * a + b * b; } }
  s += __shfl_xor(s, 1);
  if (half == 0) rs[row] = rsqrtf(s / (float)K + LN_EPS);
  __syncthreads();
}

constexpr int A_KS = 104, A_VS = 72;
constexpr int A_KBUF = 64 * A_KS, A_VBUF = 64 * A_VS;
constexpr float A_THR = 8.f;
__device__ void attn_unit(const bf16_t* __restrict__ Q, const bf16_t* __restrict__ Kn, const bf16_t* __restrict__ Vt, const bf16_t* __restrict__ KR,
                          bf16_t* __restrict__ Y, int S, int b, int h, int qb, char* smem) {
  const int tid = otid(), lane = tid & 63, wid = tid >> 6, r32 = lane & 31, hi = lane >> 5;
  bf16_t* Ks = (bf16_t*)smem; bf16_t* Vs = Ks + 2 * A_KBUF; float* wsf = (float*)(Vs + 2 * A_VBUF) + wid * 64;
  const size_t rowbase = (size_t)b * S;
  const int q0 = qb * 256 + wid * 32;
  bf16x8 qr[6];
  { const bf16_t* qp = Q + (rowbase + q0 + r32) * 768 + h * 96 + hi * 8;
#pragma unroll
    for (int d0 = 0; d0 < 6; ++d0) qr[d0] = *(const bf16x8*)(qp + d0 * 16); }
  const bf16_t* kn_src = Kn + (rowbase + (tid >> 3)) * 512 + h * 64 + (tid & 7) * 8;
  const bf16_t* kr_src = KR + (rowbase + (tid >> 2)) * 32 + (tid & 3) * 8;
  const bf16_t* v_src = Vt + ((size_t)(b * 8 + h) * 64 + (tid >> 3)) * S + (tid & 7) * 8;
  const int kn_dst = (tid >> 3) * A_KS + (tid & 7) * 8, kr_dst = (tid >> 2) * A_KS + 64 + (tid & 3) * 8, v_dst = (tid >> 3) * A_VS + (tid & 7) * 8;
  const bool has_kr = tid < 256;
  u32x4 sk, sr, sv;
#define A_LOAD(k0) do { sk = *(const u32x4*)(kn_src + (size_t)(k0) * 512); if (has_kr) sr = *(const u32x4*)(kr_src + (size_t)(k0) * 32); sv = *(const u32x4*)(v_src + (k0)); } while (0)
#define A_STORE(bf) do { *(u32x4*)(Ks + (bf) * A_KBUF + kn_dst) = sk; if (has_kr) *(u32x4*)(Ks + (bf) * A_KBUF + kr_dst) = sr; *(u32x4*)(Vs + (bf) * A_VBUF + v_dst) = sv; } while (0)
  float m_ref = 0.f, l_reg = 0.f; f32x16 o[2], negm; o[0] = f32x16{}; o[1] = f32x16{}; negm = f32x16{};
  const int NT = S >> 6;
  A_LOAD(0); A_STORE(0); __syncthreads();
  for (int j = 0; j < NT; ++j) {
    const int buf = j & 1;
    if (j + 1 < NT) A_LOAD((j + 1) * 64);
#ifndef A_SKEW
#define A_SKEW 1
#endif
    if (A_SKEW > 0 && wid >= 4) __builtin_amdgcn_s_sleep(A_SKEW);
    f32x16 p0, p1;
    bf16x8 vf[8];
    { const bf16_t* kb = Ks + buf * A_KBUF + r32 * A_KS + hi * 8;
      bf16x8 kf[12];
#pragma unroll
      for (int d0 = 0; d0 < 6; ++d0) { kf[2 * d0] = *(const bf16x8*)(kb + d0 * 16); kf[2 * d0 + 1] = *(const bf16x8*)(kb + 32 * A_KS + d0 * 16); }
      __builtin_amdgcn_sched_barrier(0);
      p0 = MFMA32(kf[0], qr[0], negm); p1 = MFMA32(kf[1], qr[0], negm);
#pragma unroll
      for (int d0 = 1; d0 < 6; ++d0) { p0 = MFMA32(kf[2 * d0], qr[d0], p0); p1 = MFMA32(kf[2 * d0 + 1], qr[d0], p1); }
      __builtin_amdgcn_sched_barrier(0);
      const bf16_t* vb = Vs + buf * A_VBUF + r32 * A_VS + hi * 8;
#pragma unroll
      for (int d0 = 0; d0 < 2; ++d0)
#pragma unroll
        for (int ks = 0; ks < 4; ++ks) vf[d0 * 4 + ks] = *(const bf16x8*)(vb + d0 * 32 * A_VS + ks * 16);
      __builtin_amdgcn_sched_barrier(0);
    }
#define MX3(a, b, c) __builtin_fmaxf(__builtin_fmaxf((a), (b)), (c))
    float pmax;
    { float a = MX3(p0[0], p0[1], p0[2]), b2 = MX3(p0[3], p0[4], p0[5]);
      a = MX3(a, p0[6], p0[7]); b2 = MX3(b2, p0[8], p0[9]); a = MX3(a, p0[10], p0[11]); b2 = MX3(b2, p0[12], p0[13]); a = MX3(a, p0[14], p0[15]);
      b2 = MX3(b2, p1[0], p1[1]); a = MX3(a, p1[2], p1[3]); b2 = MX3(b2, p1[4], p1[5]); a = MX3(a, p1[6], p1[7]); b2 = MX3(b2, p1[8], p1[9]);
      a = MX3(a, p1[10], p1[11]); b2 = MX3(b2, p1[12], p1[13]); a = MX3(a, p1[14], p1[15]); pmax = __builtin_fmaxf(a, b2); }
#undef MX3
    { auto rr = __builtin_amdgcn_permlane32_swap(__float_as_uint(pmax), __float_as_uint(pmax), false, false);
      pmax = fmaxf(__uint_as_float(rr[0]), __uint_as_float(rr[1])); }
    if (j == 0 || __any(pmax > A_THR)) {
      const float delta = (j == 0) ? pmax : fmaxf(pmax, 0.f);
#pragma unroll
      for (int r = 0; r < 16; ++r) { p0[r] -= delta; p1[r] -= delta; }
      m_ref += delta;
#pragma unroll
      for (int r = 0; r < 16; ++r) negm[r] = -m_ref;
      if (j > 0) {
        const float al = __builtin_amdgcn_exp2f(-delta); l_reg *= al;
        if (hi == 0) wsf[r32] = al;
        asm volatile("s_waitcnt lgkmcnt(0)" ::: "memory");
#pragma unroll
        for (int r = 0; r < 16; ++r) { const float f = wsf[crow(r, hi)]; o[0][r] *= f; o[1][r] *= f; }
        asm volatile("s_waitcnt lgkmcnt(0)" ::: "memory");
      }
    }
    float ps = 0.f, ps2 = 0.f;
#pragma unroll
    for (int r = 0; r < 16; ++r) { p0[r] = __builtin_amdgcn_exp2f(p0[r]); ps += p0[r]; }
#pragma unroll
    for (int r = 0; r < 16; ++r) { p1[r] = __builtin_amdgcn_exp2f(p1[r]); ps2 += p1[r]; }
    ps += ps2;
    { auto rr = __builtin_amdgcn_permlane32_swap(__float_as_uint(ps), __float_as_uint(ps), false, false);
      ps = __uint_as_float(rr[0]) + __uint_as_float(rr[1]); }
    l_reg += ps;
    bf16x8 pa0, pa1, pa2, pa3;
    PK4(p0, 0, pa0); PK4(p0, 8, pa1); PK4(p1, 0, pa2); PK4(p1, 8, pa3);
    __builtin_amdgcn_sched_barrier(0);
    o[0] = MFMA32(pa0, vf[0], o[0]); o[1] = MFMA32(pa0, vf[4], o[1]);
    o[0] = MFMA32(pa1, vf[1], o[0]); o[1] = MFMA32(pa1, vf[5], o[1]);
    o[0] = MFMA32(pa2, vf[2], o[0]); o[1] = MFMA32(pa2, vf[6], o[1]);
    o[0] = MFMA32(pa3, vf[3], o[0]); o[1] = MFMA32(pa3, vf[7], o[1]);
    __builtin_amdgcn_sched_barrier(0);
    if (j + 1 < NT) A_STORE(buf ^ 1);
    __syncthreads();
  }
#undef A_LOAD
#undef A_STORE
  if (hi == 0) wsf[32 + r32] = l_reg;
  asm volatile("s_waitcnt lgkmcnt(0)" ::: "memory");
  bf16_t* yp = Y + (rowbase + q0) * 1024 + h * 64 + r32;
#pragma unroll
  for (int r = 0; r < 16; ++r) {
    const int orow = crow(r, hi); const float rl = __builtin_amdgcn_rcpf(wsf[32 + orow]);
    yp[(size_t)orow * 1024] = f2bf(o[0][r] * rl); yp[(size_t)orow * 1024 + 32] = f2bf(o[1][r] * rl);
  }
  __syncthreads();
}

__device__ void phase_pool_rope(const bf16_t* __restrict__ proj, bf16_t* __restrict__ Y, bf16_t* __restrict__ KR, const f32x2* __restrict__ rope, int S) {
  const int smask = S - 1;
  const int gtid = blockIdx.x * NTHR + otid(), gstr = gridDim.x * NTHR;
  for (int idx = gtid; idx < (MT / 8) * 32; idx += gstr) {
    const int tb = idx >> 5, c = idx & 31, g = c >> 3, half = 1 << g, t0 = tb * 8, pos0 = t0 & smask;
    const bf16_t* base = proj + (size_t)(t0 - pos0) * NPROJ + C_POOL + c * 8;
    float sum[8];
#pragma unroll
    for (int k = 0; k < 8; ++k) sum[k] = 0.f;
    { int lo = pos0 - half; if (lo < 0) lo = 0; int hi = pos0 + half; if (hi > S) hi = S;
      for (int t = lo; t < hi; ++t) { const u32x4 v = *(const u32x4*)(base + (size_t)t * NPROJ);
#pragma unroll
        for (int k = 0; k < 4; ++k) { sum[2 * k] += bflo(v[k]); sum[2 * k + 1] += bfhi(v[k]); } } }
#pragma unroll
    for (int q = 0; q < 8; ++q) {
      const int pos = pos0 + q; int lo = pos - half; if (lo < 0) lo = 0; int hi = pos + half; if (hi > S) hi = S;
      const float rc = 1.f / (float)(hi - lo);
      const u32x4 xv = *(const u32x4*)(base + (size_t)pos * NPROJ);
      u32x4 o;
#pragma unroll
      for (int k = 0; k < 4; ++k) o[k] = pk2(sum[2 * k] * rc - bflo(xv[k]), sum[2 * k + 1] * rc - bfhi(xv[k]));
      *(u32x4*)(Y + (size_t)(t0 + q) * 1024 + 512 + c * 8) = o;
      if (q < 7) {
        if (pos + half < S) { const u32x4 v = *(const u32x4*)(base + (size_t)(pos + half) * NPROJ);
#pragma unroll
          for (int k = 0; k < 4; ++k) { sum[2 * k] += bflo(v[k]); sum[2 * k + 1] += bfhi(v[k]); } }
        if (pos - half >= 0) { const u32x4 v = *(const u32x4*)(base + (size_t)(pos - half) * NPROJ);
#pragma unroll
          for (int k = 0; k < 4; ++k) { sum[2 * k] -= bflo(v[k]); sum[2 * k + 1] -= bfhi(v[k]); } }
      }
    }
  }
  for (int idx = gtid; idx < MT * 2; idx += gstr) {
    const int m = idx >> 1, hf = idx & 1, pos = m & smask;
    const bf16_t* pp = proj + (size_t)m * NPROJ + C_KR + hf * 8;
    const u32x4 a = *(const u32x4*)pp, b2 = *(const u32x4*)(pp + 16);
    u32x4 o1, o2;
#pragma unroll
    for (int k = 0; k < 4; ++k) {
      const f32x2 c0 = rope[pos * 16 + hf * 8 + 2 * k], c1 = rope[pos * 16 + hf * 8 + 2 * k + 1];
      const float x1a = bflo(a[k]), x1b = bfhi(a[k]), x2a = bflo(b2[k]), x2b = bfhi(b2[k]);
      o1[k] = pk2(x1a * c0[0] - x2a * c0[1], x1b * c1[0] - x2b * c1[1]);
      o2[k] = pk2(x2a * c0[0] + x1a * c0[1], x2b * c1[0] + x1b * c1[1]);
    }
    *(u32x4*)(KR + (size_t)m * 32 + hf * 8) = o1; *(u32x4*)(KR + (size_t)m * 32 + 16 + hf * 8) = o2;
  }
}

__device__ __forceinline__ float logsigmoidf(float f) { return fminf(f, 0.f) - log1pf(__expf(-fabsf(f))); }
constexpr int ML_T = 136;
constexpr int ML_R = 72;

__device__ void mlstm_pass1(int cgi, int hh, const bf16_t* __restrict__ proj, const float* __restrict__ gates, const float* __restrict__ gbias,
                            float* __restrict__ stU, float* __restrict__ stN, float* __restrict__ stS, char* smem) {
  const int tid = otid(), lane = tid & 63, wid = tid >> 6, r32 = lane & 31, hi = lane >> 5;
  bf16_t* Vt = (bf16_t*)smem; bf16_t* Kw = Vt + 64 * ML_T;
  float* sc = (float*)(Kw + 2 * 64 * ML_T); float* lfs = sc; float* als = sc + 256; float* wss = sc + 512; float* red = sc + 768;
  const int item = cgi * 4 + hh; const size_t m0 = (size_t)cgi * 128;
  float ipre = 0.f;
  if (tid < 256) { const int dir = tid >> 7, s = tid & 127; const float* gp = gates + (m0 + s) * 16;
    ipre = gp[(2 * dir) * 4 + hh] + gbias[(2 * dir) * 4 + hh];
    const float f = gp[(2 * dir + 1) * 4 + hh] + gbias[(2 * dir + 1) * 4 + hh];
    lfs[tid] = logsigmoidf(f); }
  __syncthreads();
  if (tid < 256) { const int dir = tid >> 7, s = tid & 127; float b = 0.f;
#pragma unroll
    for (int t4 = 0; t4 < 32; ++t4) { const f32x4 v = *(const f32x4*)(lfs + dir * 128 + 4 * t4);
#pragma unroll
      for (int k = 0; k < 4; ++k) { const int t = 4 * t4 + k; const bool in = dir ? (t >= s) : (t <= s); b += in ? v[k] : 0.f; } }
    als[tid] = ipre - b;
    if (dir == 0 && s == 127) red[0] = b;
    if (dir == 1 && s == 0) red[1] = b; }
  __syncthreads();
  if (tid < 256) { const int dir = tid >> 7, s = tid & 127; float mx = als[dir * 128];
#pragma unroll
    for (int t4 = 0; t4 < 32; ++t4) { const f32x4 v = *(const f32x4*)(als + dir * 128 + 4 * t4); mx = fmaxf(fmaxf(mx, fmaxf(v[0], v[1])), fmaxf(v[2], v[3])); }
    wss[tid] = __expf(als[tid] - mx);
    if (s == 0) { stS[(size_t)(item * 2 + dir) * 4 + 0] = red[dir]; stS[(size_t)(item * 2 + dir) * 4 + 1] = mx; } }
  __syncthreads();
#pragma unroll
  for (int it = 0; it < 2; ++it) { const int idx = tid + NTHR * it, s = idx & 127, c = idx >> 7;
    const bf16_t* rp = proj + (m0 + s) * NPROJ + hh * 64 + c * 8;
    const u32x4 kc = *(const u32x4*)(rp + C_KM), vc = *(const u32x4*)(rp + C_VM);
    const float w0 = wss[s] * 0.125f, w1 = wss[128 + s] * 0.125f;
#pragma unroll
    for (int k = 0; k < 4; ++k) {
      const float ka = bflo(kc[k]), kb = bfhi(kc[k]);
      Kw[(8 * c + 2 * k) * ML_T + s] = f2bf(ka * w0); Kw[(8 * c + 2 * k + 1) * ML_T + s] = f2bf(kb * w0);
      Kw[64 * ML_T + (8 * c + 2 * k) * ML_T + s] = f2bf(ka * w1); Kw[64 * ML_T + (8 * c + 2 * k + 1) * ML_T + s] = f2bf(kb * w1);
      Vt[(8 * c + 2 * k) * ML_T + s] = (bf16_t)(vc[k] & 0xffffu); Vt[(8 * c + 2 * k + 1) * ML_T + s] = (bf16_t)(vc[k] >> 16);
    } }
  __syncthreads();
  { const int dir = wid >> 2, kb = (wid >> 1) & 1, vb = wid & 1;
    f32x16 acc = f32x16{};
    const bf16_t* ap = Kw + dir * 64 * ML_T + (kb * 32 + r32) * ML_T + hi * 8; const bf16_t* bp = Vt + (vb * 32 + r32) * ML_T + hi * 8;
#pragma unroll
    for (int ks = 0; ks < 8; ++ks) acc = MFMA32(*(const bf16x8*)(ap + ks * 16), *(const bf16x8*)(bp + ks * 16), acc);
    float* up = stU + (size_t)(item * 2 + dir) * 4096 + vb * 32 + r32;
#pragma unroll
    for (int r = 0; r < 16; ++r) up[(kb * 32 + crow(r, hi)) * 64] = acc[r]; }
  if (tid < 128) { const int dir = tid >> 6, kd = tid & 63; const bf16_t* kp = Kw + dir * 64 * ML_T + kd * ML_T; float s = 0.f;
    for (int t = 0; t < 128; ++t) s += bf2f(kp[t]);
    stN[(size_t)(item * 2 + dir) * 64 + kd] = s; }
  __syncthreads();
}

template <int EPT, int GS>
__device__ void mlstm_pass2(int ch, int part, int NC, float* __restrict__ stU, float* __restrict__ stN, float* __restrict__ stS) {
  const int tid = otid(); const int b = ch >> 3, hh = (ch >> 1) & 3, dir = ch & 1;
  const int e0 = part * (NTHR * EPT) + tid;
  const bool own_n = (part == 0) && (tid < 64);
  float sv[EPT], nv = 0.f, m = 0.f;
#pragma unroll
  for (int i = 0; i < EPT; ++i) sv[i] = 0.f;
  for (int st0 = 0; st0 < NC; st0 += GS) {
    float uu[GS][EPT], un[GS], bs[GS], ml[GS];
#pragma unroll
    for (int q = 0; q < GS; ++q) {
      const int step = st0 + q, c = dir ? (NC - 1 - step) : step;
      const size_t base = (size_t)(((b * NC + c) * 4 + hh) * 2 + dir);
      bs[q] = stS[base * 4 + 0]; ml[q] = stS[base * 4 + 1];
#pragma unroll
      for (int i = 0; i < EPT; ++i) uu[q][i] = stU[base * 4096 + e0 + NTHR * i];
      un[q] = own_n ? stN[base * 64 + tid] : 0.f;
    }
#pragma unroll
    for (int q = 0; q < GS; ++q) {
      const int step = st0 + q, c = dir ? (NC - 1 - step) : step;
      const size_t base = (size_t)(((b * NC + c) * 4 + hh) * 2 + dir);
      const float mnew = bs[q] + fmaxf(m, ml[q]);
      const float decay = __expf(m + bs[q] - mnew), uf = __expf(ml[q] + bs[q] - mnew);
#pragma unroll
      for (int i = 0; i < EPT; ++i) { stU[base * 4096 + e0 + NTHR * i] = sv[i]; sv[i] = decay * sv[i] + uf * uu[q][i]; }
      if (own_n) { stN[base * 64 + tid] = nv; nv = decay * nv + uf * un[q]; }
      if (part == 0 && tid == 0) stS[base * 4 + 2] = m;
      m = mnew;
    }
  }
}

__device__ void mlstm_pass3(int cgi, int hh, const bf16_t* __restrict__ proj, const float* __restrict__ gates, const float* __restrict__ gbias,
                            const float* __restrict__ norm_g, const float* __restrict__ stU, const float* __restrict__ stN, const float* __restrict__ stS,
                            bf16_t* __restrict__ Y, char* smem) {
  const int tid = otid(), lane = tid & 63, wid = tid >> 6, r32 = lane & 31, hi = lane >> 5;
  bf16_t* Kr = (bf16_t*)smem; bf16_t* Qr = Kr + 128 * ML_R; bf16_t* Vt = Qr + 128 * ML_R; bf16_t* Qf = Vt + 64 * ML_T;
  bf16_t* St = Qf + 2 * 128 * ML_R;
  float* H = (float*)(St + 2 * 64 * ML_R);
  float* sc = H + 128 * 64; float* lfs = sc; float* als = sc + 256; float* bbs = sc + 512; float* Mls = sc + 768; float* ffs = sc + 1024; float* dqs = sc + 1280;
  float* nss = sc + 1536;   float* invs = sc + 1664;
  const int item = cgi * 4 + hh; const size_t m0 = (size_t)cgi * 128;
  float ipre = 0.f;
  if (tid < 256) { const int dir = tid >> 7, s = tid & 127; const float* gp = gates + (m0 + s) * 16;
    ipre = gp[(2 * dir) * 4 + hh] + gbias[(2 * dir) * 4 + hh];
    const float f = gp[(2 * dir + 1) * 4 + hh] + gbias[(2 * dir + 1) * 4 + hh];
    lfs[tid] = logsigmoidf(f); }
  __syncthreads();
  if (tid < 256) { const int dir = tid >> 7, s = tid & 127; float b = 0.f;
#pragma unroll
    for (int t4 = 0; t4 < 32; ++t4) { const f32x4 v = *(const f32x4*)(lfs + dir * 128 + 4 * t4);
#pragma unroll
      for (int k = 0; k < 4; ++k) { const int t = 4 * t4 + k; const bool in = dir ? (t >= s) : (t <= s); b += in ? v[k] : 0.f; } }
    als[tid] = ipre - b; bbs[tid] = b; }
  else if (tid < 384) { const int dir = (tid - 256) >> 6, kd = tid & 63; nss[dir * 64 + kd] = stN[(size_t)(item * 2 + dir) * 64 + kd]; }
  __syncthreads();
  if (tid < 256) { const int dir = tid >> 7, s = tid & 127; const float mst = stS[(size_t)(item * 2 + dir) * 4 + 2]; float mx = mst;
#pragma unroll
    for (int t4 = 0; t4 < 32; ++t4) { const f32x4 v = *(const f32x4*)(als + dir * 128 + 4 * t4);
#pragma unroll
      for (int k = 0; k < 4; ++k) { const int t = 4 * t4 + k; const bool in = dir ? (t >= s) : (t <= s); mx = fmaxf(mx, in ? v[k] : -3.0e38f); } }
    Mls[tid] = mx; ffs[tid] = __expf(mst - mx); }
  __syncthreads();
#pragma unroll
  for (int it = 0; it < 2; ++it) {
    { const int idx = tid + NTHR * it, s = idx >> 3, c = idx & 7;
      const bf16_t* rp = proj + (m0 + s) * NPROJ + hh * 64 + c * 8;
      const u32x4 kc = *(const u32x4*)(rp + C_KM), qc = *(const u32x4*)(rp + C_QM);
      *(u32x4*)(Kr + s * ML_R + c * 8) = kc; *(u32x4*)(Qr + s * ML_R + c * 8) = qc;
      const float f0 = ffs[s], f1 = ffs[128 + s]; u32x4 q0, q1;
#pragma unroll
      for (int k = 0; k < 4; ++k) { const float a = bflo(qc[k]), b2 = bfhi(qc[k]); q0[k] = pk2(a * f0, b2 * f0); q1[k] = pk2(a * f1, b2 * f1); }
      *(u32x4*)(Qf + s * ML_R + c * 8) = q0; *(u32x4*)(Qf + 128 * ML_R + s * ML_R + c * 8) = q1; }
    { const int idx = tid + NTHR * it, s = idx & 127, c = idx >> 7;
      const u32x4 vc = *(const u32x4*)(proj + (m0 + s) * NPROJ + C_VM + hh * 64 + c * 8);
#pragma unroll
      for (int k = 0; k < 4; ++k) { Vt[(8 * c + 2 * k) * ML_T + s] = (bf16_t)(vc[k] & 0xffffu); Vt[(8 * c + 2 * k + 1) * ML_T + s] = (bf16_t)(vc[k] >> 16); } }
  }
#pragma unroll
  for (int dir = 0; dir < 2; ++dir) { const float* sp = stU + (size_t)(item * 2 + dir) * 4096;
#pragma unroll
    for (int it = 0; it < 8; ++it) { const int idx = tid + NTHR * it, d = idx >> 6, e = idx & 63; St[dir * 64 * ML_R + e * ML_R + d] = f2bf(sp[idx]); } }
  __syncthreads();
  if (tid < 256) { const int dir = tid >> 7, j = tid & 127; const bf16_t* qp = Qr + j * ML_R; float s = 0.f;
#pragma unroll
    for (int d8 = 0; d8 < 8; ++d8) { const u32x4 qv = *(const u32x4*)(qp + d8 * 8); const f32x4 n0 = *(const f32x4*)(nss + dir * 64 + d8 * 8), n1 = *(const f32x4*)(nss + dir * 64 + d8 * 8 + 4);
      s += bflo(qv[0]) * n0[0] + bfhi(qv[0]) * n0[1] + bflo(qv[1]) * n0[2] + bfhi(qv[1]) * n0[3] + bflo(qv[2]) * n1[0] + bfhi(qv[2]) * n1[1] + bflo(qv[3]) * n1[2] + bfhi(qv[3]) * n1[3]; }
    dqs[tid] = s * ffs[tid]; }
  __syncthreads();
  f32x16 o[2]; o[0] = f32x16{}; o[1] = f32x16{};
  const int dir = wid >> 2, jb = wid & 3;
  {
    const int jrow = 32 * jb + r32; const float Mj = Mls[dir * 128 + jrow]; float den = 0.f;
    const int st_lo = dir ? jb : 0, st_hi = dir ? 3 : jb;
    for (int st = st_lo; st <= st_hi; ++st) {
      f32x16 sc2 = f32x16{};
      const bf16_t* ap = Kr + (32 * st + r32) * ML_R + hi * 8; const bf16_t* bp = Qr + jrow * ML_R + hi * 8;
#pragma unroll
      for (int kk = 0; kk < 4; ++kk) sc2 = MFMA32(*(const bf16x8*)(ap + kk * 16), *(const bf16x8*)(bp + kk * 16), sc2);
      float pv[16];
#pragma unroll
      for (int r = 0; r < 16; ++r) { const int s = 32 * st + crow(r, hi); const bool valid = dir ? (s >= jrow) : (s <= jrow);
        const float x = fminf(als[dir * 128 + s] - Mj, 0.f); const float w = valid ? 0.125f * __expf(x) : 0.f;
        pv[r] = sc2[r] * w; den += pv[r]; }
      bf16x8 pa0, pa1; PK4(pv, 0, pa0); PK4(pv, 8, pa1);
#pragma unroll
      for (int d0 = 0; d0 < 2; ++d0) { const bf16_t* vp = Vt + (32 * d0 + r32) * ML_T + 32 * st + hi * 8;
        o[d0] = MFMA32(pa0, *(const bf16x8*)(vp), o[d0]); o[d0] = MFMA32(pa1, *(const bf16x8*)(vp + 16), o[d0]); }
    }
    { const bf16_t* ap = Qf + dir * 128 * ML_R + jrow * ML_R + hi * 8;
#pragma unroll
      for (int kk = 0; kk < 4; ++kk) { const bf16x8 a = *(const bf16x8*)(ap + kk * 16);
#pragma unroll
        for (int d0 = 0; d0 < 2; ++d0) o[d0] = MFMA32(a, *(const bf16x8*)(St + dir * 64 * ML_R + (32 * d0 + r32) * ML_R + kk * 16 + hi * 8), o[d0]); } }
    den += __shfl_xor(den, 32);
    den += dqs[dir * 128 + jrow];
    const float flo = __expf(-(bbs[dir * 128 + jrow] + Mj));
    const float inv = __builtin_amdgcn_rcpf(fmaxf(fabsf(den), flo));
    if (hi == 0) invs[wid * 32 + r32] = inv;
    asm volatile("s_waitcnt lgkmcnt(0)" ::: "memory");
  }
  if (dir == 0) {
#pragma unroll
    for (int r = 0; r < 16; ++r) { const int jr = crow(r, hi); const float iv = invs[wid * 32 + jr];
      H[(32 * jb + jr) * 64 + r32] = o[0][r] * iv; H[(32 * jb + jr) * 64 + 32 + r32] = o[1][r] * iv; }
  }
  __syncthreads();
  if (dir == 1) {
#pragma unroll
    for (int r = 0; r < 16; ++r) { const int jr = crow(r, hi); const float iv = invs[wid * 32 + jr];
      H[(32 * jb + jr) * 64 + r32] += o[0][r] * iv; H[(32 * jb + jr) * 64 + 32 + r32] += o[1][r] * iv; }
  }
  __syncthreads();
  { const int j = tid >> 2, qd = tid & 3; float hv[16]; float s = 0.f;
#pragma unroll
    for (int e = 0; e < 16; ++e) { hv[e] = H[j * 64 + qd * 16 + e]; s += hv[e]; }
    s += __shfl_xor(s, 1); s += __shfl_xor(s, 2);
    const float mu = s * (1.f / 64.f); float q = 0.f;
#pragma unroll
    for (int e = 0; e < 16; ++e) { const float d = hv[e] - mu; q += d * d; }
    q += __shfl_xor(q, 1); q += __shfl_xor(q, 2);
    const float rstd = rsqrtf(q * (1.f / 64.f) + LN_EPS);
    const bf16_t* op = proj + (m0 + j) * NPROJ + C_OM + hh * 64 + qd * 16;
    const u32x4 oa = *(const u32x4*)op, ob = *(const u32x4*)(op + 8);
    const float* ng = norm_g + hh * 64 + qd * 16;
    float y[16];
#pragma unroll
    for (int k = 0; k < 4; ++k) {
      const float g0 = bflo(oa[k]), g1 = bfhi(oa[k]), g2 = bflo(ob[k]), g3 = bfhi(ob[k]);
      y[2 * k] = (hv[2 * k] - mu) * rstd * ng[2 * k] * __builtin_amdgcn_rcpf(1.f + __builtin_amdgcn_exp2f(-1.4426950408889634f * g0));
      y[2 * k + 1] = (hv[2 * k + 1] - mu) * rstd * ng[2 * k + 1] * __builtin_amdgcn_rcpf(1.f + __builtin_amdgcn_exp2f(-1.4426950408889634f * g1));
      y[8 + 2 * k] = (hv[8 + 2 * k] - mu) * rstd * ng[8 + 2 * k] * __builtin_amdgcn_rcpf(1.f + __builtin_amdgcn_exp2f(-1.4426950408889634f * g2));
      y[8 + 2 * k + 1] = (hv[8 + 2 * k + 1] - mu) * rstd * ng[8 + 2 * k + 1] * __builtin_amdgcn_rcpf(1.f + __builtin_amdgcn_exp2f(-1.4426950408889634f * g3));
    }
    u32x4 w0 = {pk2(y[0], y[1]), pk2(y[2], y[3]), pk2(y[4], y[5]), pk2(y[6], y[7])}, w1 = {pk2(y[8], y[9]), pk2(y[10], y[11]), pk2(y[12], y[13]), pk2(y[14], y[15])};
    bf16_t* yp = Y + (m0 + j) * 1024 + 768 + hh * 64 + qd * 16;
    *(u32x4*)yp = w0; *(u32x4*)(yp + 8) = w1; }
  __syncthreads();
}

__device__ __forceinline__ bool tile_order(int i, int G, int c, int nM, int nN, int& pm, int& pn) {
  const int nwg = nM * nN; const long L = (long)i * G + c; if (L >= nwg) return false;
  int wgid = (int)L; { const int q = nwg / 8, r = nwg % 8, xcd = wgid % 8, off = wgid / 8; wgid = (xcd < r ? xcd * (q + 1) : r * (q + 1) + (xcd - r) * q) + off; }
  const int nig = 8 * nN, gid = wgid / nig, fm = gid * 8, gsz = (nM - fm) < 8 ? (nM - fm) : 8;
  pm = fm + ((wgid % nig) % gsz); pn = (wgid % nig) / gsz; return true;
}

#define XB_TMO      128
#define XB_XCNT(j)  (256  + 64 * (j))
#define XB_XSUB(j)  (1280 + 64 * (j))
#define XB_XGEN(j)  (2304 + 64 * (j))
#define XB_TOP      3328
#define XB_TOPGEN   3392
#define XCD_BAR_WORDS 3456
#define XB_SPIN_CAP (1u << 18)
#define LAS __attribute__((address_space(3)))

__device__ __forceinline__ unsigned xb_ld(unsigned* p)              { return __hip_atomic_load(p, __ATOMIC_RELAXED, __HIP_MEMORY_SCOPE_AGENT); }
__device__ __forceinline__ unsigned xb_add(unsigned* p, unsigned v) { return __hip_atomic_fetch_add(p, v, __ATOMIC_RELAXED, __HIP_MEMORY_SCOPE_AGENT); }
__device__ __forceinline__ unsigned xb_xcc_id() { return (unsigned)__builtin_amdgcn_s_getreg((3 << 11) | 20) & 0xFu; }
#define XB_SPIN(cond, bar) do { unsigned _sp = 0; while (cond) { __builtin_amdgcn_s_sleep(1); \
    if ((++_sp & 255u) == 0u) { if (xb_ld(&(bar)[XB_TMO])) break; if (_sp > XB_SPIN_CAP) { atomicAdd(&(bar)[XB_TMO], 1u); break; } } } } while (0)

struct XcdBarrier {
    unsigned* bar; unsigned x;
    volatile LAS unsigned* st;
};

__device__ __forceinline__ XcdBarrier xcd_barrier_post(unsigned* bar, volatile LAS unsigned* st) {
    XcdBarrier b; b.bar = bar; b.x = xb_xcc_id(); b.st = st;
    if (threadIdx.x == 0) (void)xb_add(&bar[XB_XCNT(b.x)], 1u);
    return b;
}
__device__ __forceinline__ void xcd_barrier_complete(unsigned* bar, unsigned x, unsigned& nloc, unsigned& nx) {
    const unsigned G = gridDim.x * gridDim.y * gridDim.z;
    unsigned sum, cnt, mine, sp = 0u;
    for (;;) {
        sum = 0u; cnt = 0u; mine = 0u;
#pragma unroll
        for (unsigned j = 0; j < 16; ++j) { const unsigned c = xb_ld(&bar[XB_XCNT(j)]); sum += c; cnt += (c > 0u) ? 1u : 0u; mine = (j == x) ? c : mine; }
        if (sum == G) break;
        __builtin_amdgcn_s_sleep(1);
        if ((++sp & 255u) == 0u) { if (xb_ld(&bar[XB_TMO])) break; if (sp > XB_SPIN_CAP) { atomicAdd(&bar[XB_TMO], 1u); break; } }
    }
    nloc = mine > 0u ? mine : 1u; nx = cnt > 0u ? cnt : 1u;
}

__device__ __forceinline__ void xcd_barrier(const XcdBarrier& b) {
    asm volatile("s_waitcnt vmcnt(0)" ::: "memory");
    __syncthreads();
    if (threadIdx.x == 0) {
        unsigned* bar = b.bar;
        __builtin_amdgcn_s_waitcnt(0);
        unsigned nloc = b.st[0], nx = b.st[1];
        if (nloc == 0u) { xcd_barrier_complete(bar, b.x, nloc, nx); b.st[0] = nloc; b.st[1] = nx; }
        const unsigned old = xb_add(&bar[XB_XSUB(b.x)], 1u);
        const unsigned gen = old / nloc;
        if (old + 1u == (gen + 1u) * nloc) {
            __builtin_amdgcn_fence(__ATOMIC_RELEASE, "agent");
            asm volatile("s_waitcnt vmcnt(0)" ::: "memory");
            const unsigned og = xb_add(&bar[XB_TOP], 1u);
            const unsigned tg = og / nx;
            if (og + 1u == (tg + 1u) * nx) xb_add(&bar[XB_TOPGEN], 1u);
            else XB_SPIN(xb_ld(&bar[XB_TOPGEN]) == tg, bar);
            __builtin_amdgcn_fence(__ATOMIC_ACQUIRE, "agent");
            xb_add(&bar[XB_XGEN(b.x)], 1u);
            asm volatile("s_waitcnt vmcnt(0)" ::: "memory");
        } else {
            XB_SPIN(xb_ld(&bar[XB_XGEN(b.x)]) == gen, bar);
            __builtin_amdgcn_fence(__ATOMIC_ACQUIRE, "agent");
            asm volatile("s_waitcnt vmcnt(0)" ::: "memory");
        }
    }
    __syncthreads();
}

constexpr int PH_PER_TRUNK = 1 + 8 * DEPTH, N_PHASES = 1 + 2 * PH_PER_TRUNK;

__device__ void run_phase(const Params& p, int ph, char* smem) {
  if (ph == 0) { if (blockIdx.x == 0) { const int t0 = otid();
      ((unsigned*)(p.ws + OFF_CNT))[t0] = 0u; ((unsigned*)(p.ws + OFF_CNT))[t0 + NTHR] = 0u;
      float* idv = (float*)(p.ws + OFF_ID); idv[t0] = 1.f; idv[t0 + NTHR] = 1.f; idv[1024 + t0] = 0.f; idv[1024 + t0 + NTHR] = 0.f; }
    phase_prep(p, smem); return; }
  const int tr = (ph - 1) / PH_PER_TRUNK, q = (ph - 1) % PH_PER_TRUNK;
  const int S = tr ? 2048 : 16384, slog = tr ? 11 : 14, nseq = tr ? 16 : 2;
  float* x32 = p.out + (size_t)tr * MT * 1024;
  unsigned char* ws = p.ws;
  bf16_t* XB = (bf16_t*)(ws + OFF_XB); bf16_t* Y = (bf16_t*)(ws + OFF_Y); bf16_t* PROJ = (bf16_t*)(ws + OFF_PROJ);
  bf16_t* Qb = (bf16_t*)(ws + OFF_Q); bf16_t* KN = (bf16_t*)(ws + OFF_KN); bf16_t* VT = (bf16_t*)(ws + OFF_VT); bf16_t* KR = (bf16_t*)(ws + OFF_KR);
  float* GATES = (float*)(ws + OFF_GATES); float* STU = (float*)(ws + OFF_STU); float* STN = (float*)(ws + OFF_STN); float* STS = (float*)(ws + OFF_STS);
  bf16_t* HID = (bf16_t*)(ws + OFF_HID); const f32x2* ROPE = (const f32x2*)(ws + OFF_ROPE);
  f32x2* STAT = (f32x2*)(ws + OFF_STAT); const float* IDV = (const float*)(ws + OFF_ID);
  if (q == 0) { phase_ln(p.in[tr], x32, XB, p.in[2], p.in[3], MT, STAT, true); return; }
  const int l = (q - 1) / 8, sub = (q - 1) % 8;
  const unsigned char* wl = ws + OFF_W + (size_t)l * W_LAYER;
  const int G = gridDim.x, B = blockIdx.x;
#ifdef ONLY_SUB
  switch (ONLY_SUB) {
#else
  switch (sub) {
#endif
    case 0: {
      pg8::Gemm g{XB, (const bf16_t*)(wl + W_IN), MT, NPROJ, 1024, 1024}; pg8::StaticOrder So; So.init(MT, NPROJ, G, B);
      pg8::EpiInProj2 E{PROJ, GATES};
      pg8::gemm_phase<pg8::EpiInProj2, pg8::StaticOrder, true, true>((PG8_LAS unsigned char*)smem, g, So, E);
    } break;
    case 1: {
      float* rs = (float*)(smem + G_SMEM_BYTES);
      for (int rep1 = 0; rep1 < REP_P1; ++rep1) {
      for (int i = 0, pm, pn; tile_order(i, G, B, 128, 3, pm, pn); ++i) {
        row_rms(PROJ + C_CQ, NPROJ, 256, pm * 256, rs); EpiQUp E{Qb, rs, ROPE, S - 1, smem};
        gemm_tile(PROJ + C_CQ, NPROJ, (const bf16_t*)(wl + W_UQ), 256, pm * 256, pn * 256, smem, E);
        __syncthreads();
      }
      for (int i = 0, pm, pn; tile_order(i, G, B, 128, 4, pm, pn); ++i) {
        row_rms(PROJ + C_CKV, NPROJ, 128, pm * 256, rs); EpiKVUp E{KN, VT, rs, S, slog, S - 1, smem};
        gemm_tile(PROJ + C_CKV, NPROJ, (const bf16_t*)(wl + W_UKV), 128, pm * 256, pn * 256, smem, E);
        __syncthreads();
      }
      phase_pool_rope(PROJ, Y, KR, ROPE, S);
      for (int t = B; t < 256 * 4; t += G) mlstm_pass1(t >> 2, t & 3, PROJ, GATES, p.in[11] + l * 16, STU, STN, STS, smem);
      }
    } break;
    case 2: {
      unsigned* cnt = (unsigned*)(ws + OFF_CNT) + (tr * DEPTH + l) * 64;
      if (B < 128) {
        if (tr == 0) mlstm_pass2<1, 32>(B >> 3, B & 7, S >> 7, STU, STN, STS); else mlstm_pass2<8, 4>(B, 0, S >> 7, STU, STN, STS);
        __builtin_amdgcn_fence(__ATOMIC_RELEASE, "agent");
        asm volatile("s_waitcnt vmcnt(0)" ::: "memory");
        __syncthreads();
        if (threadIdx.x == 0) __hip_atomic_fetch_add(cnt, 1u, __ATOMIC_RELEASE, __HIP_MEMORY_SCOPE_AGENT);
      }
      const int nqb = S >> 8;
      for (int t0 = B; t0 < 1024; t0 += G) { const int t = (G == 256) ? (t0 & ~255) + (B & 7) * 32 + (B >> 3) : t0; const int qb = t % nqb, bh = t / nqb; attn_unit(Qb, KN, VT, KR, Y, S, bh >> 3, bh & 7, qb, smem); }
      if (threadIdx.x == 0) { while (__hip_atomic_load(cnt, __ATOMIC_ACQUIRE, __HIP_MEMORY_SCOPE_AGENT) < 128u) __builtin_amdgcn_s_sleep(2); }
      __syncthreads();
      __builtin_amdgcn_fence(__ATOMIC_ACQUIRE, "agent");
      asm volatile("s_waitcnt vmcnt(0)" ::: "memory");
      for (int t = B; t < 256 * 4; t += G) mlstm_pass3(t >> 2, t & 3, PROJ, GATES, p.in[11] + l * 16, p.in[12] + l * 256, STU, STN, STS, Y, smem);
    } break;
    case 3: {
      pg8::Gemm g{Y, (const bf16_t*)(wl + W_OUT), MT, 1024, 1024, 1024}; pg8::StaticOrder So; So.init(MT, 1024, G, B);
      pg8::EpiResid2 E{x32, STAT, l ? p.in[19] + (l - 1) * 1024 : IDV, l ? p.in[20] + (l - 1) * 1024 : IDV + 1024};
      pg8::gemm_phase<pg8::EpiResid2, pg8::StaticOrder, true, true>((PG8_LAS unsigned char*)smem, g, So, E);
    } break;
    case 4: phase_ln(x32, nullptr, XB, p.in[14] + l * 1024, p.in[15] + l * 1024, MT, STAT, false); break;
    case 5: {
      pg8::Gemm g{XB, (const bf16_t*)(wl + W_GU), MT, NGU, 1024, 1024}; pg8::StaticOrder So; So.init(MT, NGU, G, B);
      pg8::EpiGU2 E{HID};
      pg8::gemm_phase<pg8::EpiGU2, pg8::StaticOrder, true, true>((PG8_LAS unsigned char*)smem, g, So, E);
    } break;
    case 6: {
      pg8::Gemm g{HID, (const bf16_t*)(wl + W_DN), MT, 1024, DFF, DFF}; pg8::StaticOrder So; So.init(MT, 1024, G, B);
      pg8::EpiResid2 E{x32, STAT, p.in[14] + l * 1024, p.in[15] + l * 1024};
      pg8::gemm_phase<pg8::EpiResid2, pg8::StaticOrder, true, true>((PG8_LAS unsigned char*)smem, g, So, E);
    } break;
    case 7: phase_ln(x32, (l == DEPTH - 1) ? x32 : nullptr, XB, p.in[19] + l * 1024, p.in[20] + l * 1024, MT, STAT, false); break;
  }
}

__global__ void __launch_bounds__(NTHR) fwd_kernel(Params p) {
  extern __shared__ __attribute__((aligned(16))) char smem[];
  cg::grid_group grid = cg::this_grid();
  volatile LAS unsigned* st = (volatile LAS unsigned*)((LAS unsigned char*)smem + (LDS_BYTES - 16));
  if (threadIdx.x < 2) st[threadIdx.x] = 0u;
  __syncthreads();
  XcdBarrier xb = xcd_barrier_post((unsigned*)(p.ws + OFF_XBAR), st);
  for (int ph = p.ph_lo; ph < p.ph_hi; ++ph) {
    run_phase(p, ph, smem);
    if (ph + 1 < p.ph_hi) {
      if (ph == p.ph_lo) grid.sync();
      else xcd_barrier(xb);
    }
  }
}

extern "C" void kernel_launch(void* const* d_in, const int* in_sizes, int n_in, void* d_out, int out_size, void* d_ws, size_t ws_size, hipStream_t stream) {
  static int grid_blocks = 0;
  if (!grid_blocks) {
    int dev = 0, cus = 0, per_cu = 0;
    hipGetDevice(&dev);
    hipDeviceGetAttribute(&cus, hipDeviceAttributeMultiprocessorCount, dev);
    hipFuncSetAttribute((const void*)fwd_kernel, hipFuncAttributeMaxDynamicSharedMemorySize, LDS_BYTES);
    hipOccupancyMaxActiveBlocksPerMultiprocessor(&per_cu, (const void*)fwd_kernel, NTHR, LDS_BYTES);
    if (per_cu < 1) per_cu = 1;
    grid_blocks = cus * per_cu;
    if (ws_size < OFF_END) fprintf(stderr, "kernel_launch: workspace too small (%zu < %zu)\n", ws_size, (size_t)OFF_END);
  }
  Params p{};
  for (int i = 0; i < 21; ++i) p.in[i] = (const float*)d_in[i];
  p.out = (float*)d_out; p.ws = (unsigned char*)d_ws;
#if ONE_LAUNCH
  p.ph_lo = 0; p.ph_hi = N_PHASES;
  (void)hipMemsetAsync((char*)d_ws + OFF_XBAR, 0, XCD_BAR_WORDS * 4, stream);
  void* args[] = {&p};
  hipError_t e = hipLaunchCooperativeKernel((const void*)fwd_kernel, dim3(grid_blocks), dim3(NTHR), args, LDS_BYTES, stream);
  if (e != hipSuccess) fprintf(stderr, "cooperative launch failed: %s (grid %d)\n", hipGetErrorString(e), grid_blocks);
#else
  for (int ph = 0; ph < N_PHASES; ++ph) { p.ph_lo = ph; p.ph_hi = ph + 1; hipLaunchKernelGGL(fwd_kernel, dim3(grid_blocks), dim3(NTHR), LDS_BYTES, stream, p); }
#endif
}
```

```cpp
#include <hip/hip_runtime.h>
#include <hip/hip_cooperative_groups.h>
#include <stdint.h>
#include <stdio.h>
namespace cg = cooperative_groups;

#ifndef REP_P1
#define REP_P1 1
#endif
#ifndef REP_P3
#define REP_P3 1
#endif
#ifndef REP_LN
#define REP_LN 1
#endif
#ifndef ONE_LAUNCH
#define ONE_LAUNCH 1
#endif

typedef unsigned short bf16_t;
typedef short bf16x8 __attribute__((ext_vector_type(8)));
typedef float f32x16 __attribute__((ext_vector_type(16)));
typedef float f32x4 __attribute__((ext_vector_type(4)));
typedef float f32x2 __attribute__((ext_vector_type(2)));
typedef unsigned u32x4 __attribute__((ext_vector_type(4)));
typedef unsigned u32x2 __attribute__((ext_vector_type(2)));
typedef __bf16 bf16x2_t __attribute__((ext_vector_type(2)));

constexpr int DM = 1024, DEPTH = 4, MT = 32768;
constexpr int NPROJ = 1792, INW = 1712, DFF = 2816, NGU = 5632;
constexpr int C_CQ = 0, C_CKV = 256, C_KR = 384, C_POOL = 416, C_QM = 672, C_KM = 928, C_VM = 1184, C_OM = 1440, C_G = 1696;
constexpr float LN_EPS = 1e-5f;
constexpr float DN_ALPHA = 1.6817928305074290f;
constexpr float QSCALE = 0.10206207261596577f * 1.4426950408889634f;
constexpr int NTHR = 512;

constexpr size_t MiB = 1u << 20;
constexpr size_t W_IN = 0, W_UQ = W_IN + (size_t)NPROJ * 1024 * 2, W_UKV = W_UQ + 768 * 256 * 2, W_OUT = W_UKV + 1024 * 128 * 2,
                 W_GU = W_OUT + 1024 * 1024 * 2, W_DN = W_GU + (size_t)NGU * 1024 * 2, W_LAYER = W_DN + (size_t)1024 * DFF * 2;
static_assert(W_LAYER * 4 <= 96 * MiB, "weights");
constexpr size_t OFF_W = 0, OFF_ROPE = 96 * MiB, OFF_XB = 98 * MiB, OFF_Y = 162 * MiB, OFF_R = 226 * MiB;
constexpr size_t OFF_PROJ = OFF_R, OFF_Q = OFF_R + 112 * MiB, OFF_KN = OFF_Q + 48 * MiB, OFF_VT = OFF_KN + 32 * MiB, OFF_KR = OFF_VT + 32 * MiB,
                 OFF_GATES = OFF_KR + 2 * MiB, OFF_STU = OFF_GATES + 2 * MiB, OFF_STN = OFF_STU + 32 * MiB, OFF_STS = OFF_STN + 1 * MiB, OFF_END = OFF_STS + 1 * MiB;
constexpr size_t OFF_HID = OFF_R;
constexpr size_t OFF_CNT = OFF_END;
constexpr size_t OFF_XBAR = OFF_END + 4096;
constexpr size_t OFF_STAT = OFF_XBAR + 16384;
constexpr size_t OFF_ID = OFF_STAT + (size_t)MT * 8;
static_assert(OFF_ID + 8192 <= 512 * MiB, "ws");
static_assert(OFF_HID + (size_t)MT * DFF * 2 <= OFF_END, "hid");

constexpr int LDS_BYTES = 151552;

struct Params {
  const float* in[21];
  float* out;
  unsigned char* ws;
  int ph_lo, ph_hi;
};

__device__ __forceinline__ unsigned pk2(float lo, float hi) { f32x2 v = {lo, hi}; bf16x2_t b = __builtin_convertvector(v, bf16x2_t); return __builtin_bit_cast(unsigned, b); }
__device__ __forceinline__ bf16_t f2bf(float x) { return (bf16_t)(pk2(x, 0.f) & 0xffffu); }
__device__ __forceinline__ float bf2f(bf16_t b) { return __uint_as_float(((unsigned)b) << 16); }
__device__ __forceinline__ float bflo(unsigned w) { return __uint_as_float(w << 16); }
__device__ __forceinline__ float bfhi(unsigned w) { return __uint_as_float(w & 0xffff0000u); }
__device__ __forceinline__ int crow(int r, int hi) { return (r & 3) + 8 * (r >> 2) + 4 * hi; }
__device__ __forceinline__ float wave_sum(float v) {
  v += __shfl_xor(v, 32); v += __shfl_xor(v, 16); v += __shfl_xor(v, 8); v += __shfl_xor(v, 4); v += __shfl_xor(v, 2); v += __shfl_xor(v, 1); return v;
}
__device__ __forceinline__ int otid() { int t = threadIdx.x; asm volatile("" : "+v"(t)); return t; }
#define MFMA32(a, b, c) __builtin_amdgcn_mfma_f32_32x32x16_bf16((a), (b), (c), 0, 0, 0)
#define PK4(P, BASE, OUT) do { unsigned a0_ = pk2(P[BASE + 0], P[BASE + 1]), a1_ = pk2(P[BASE + 2], P[BASE + 3]);   \
    unsigned b0_ = pk2(P[BASE + 4], P[BASE + 5]), b1_ = pk2(P[BASE + 6], P[BASE + 7]);                              \
    auto r0_ = __builtin_amdgcn_permlane32_swap(a0_, b0_, false, false); auto r1_ = __builtin_amdgcn_permlane32_swap(a1_, b1_, false, false); \
    u32x4 w_ = {r0_[0], r1_[0], r0_[1], r1_[1]}; OUT = __builtin_bit_cast(bf16x8, w_); } while (0)

__device__ void prep_tile(const float* srcA, int colA, int limA, const float* srcB, int colB, int limB, int ld, int k0,
                          const float* kscale, float mul, bf16_t* dst, int ldd, int n0, float* tile) {
  const int tid = otid();
#pragma unroll
  for (int i = 0; i < 8; ++i) {
    const int kk = (tid >> 6) + 8 * i, nn = tid & 63;
    float v = 0.f;
    if (nn < 32) { const int c = colA + nn; if (c < limA) v = srcA[(size_t)(k0 + kk) * ld + c]; }
    else { const int c = colB + nn - 32; if (c < limB) v = srcB[(size_t)(k0 + kk) * ld + c]; }
    if (kscale) v *= kscale[k0 + kk];
    tile[kk * 65 + nn] = v * mul;
  }
  __syncthreads();
  { const int nn = tid >> 3, kc = tid & 7; u32x4 w;
#pragma unroll
    for (int j = 0; j < 4; ++j) w[j] = pk2(tile[(kc * 8 + 2 * j) * 65 + nn], tile[(kc * 8 + 2 * j + 1) * 65 + nn]);
    *(u32x4*)(dst + (size_t)(n0 + nn) * ldd + k0 + kc * 8) = w; }
  __syncthreads();
}

__device__ void phase_prep(const Params& p, char* smem) {
  float* tile = (float*)smem;
  const int tid = otid();
  constexpr int N_IN = 28 * 16, N_UQ = 12 * 4, N_UKV = 16 * 2, N_OUT = 16 * 12, N_PF = 4 * 16, N_GU = 88 * 16, N_DN = 16 * 44;
  constexpr int PER_LAYER = N_IN + N_UQ + N_UKV + N_OUT + N_PF + N_GU + N_DN;
  constexpr int N_ROPE = 16384 * 16 / NTHR;
  const int total = PER_LAYER * DEPTH + N_ROPE;
  for (int it = blockIdx.x; it < total; it += gridDim.x) {
    if (it >= PER_LAYER * DEPTH) {
      const int e = (it - PER_LAYER * DEPTH) * NTHR + tid, pos = e >> 4, i = e & 15;
      const float inv = exp2f(-(float)i * (13.287712379549449f / 16.0f));
      const float ang = (float)pos * inv;
      double rev = (double)ang * 0.15915494309189535; rev -= floor(rev);
      const float fr = (float)rev;
      f32x2 cs = {__builtin_amdgcn_cosf(fr), __builtin_amdgcn_sinf(fr)};
      ((f32x2*)(p.ws + OFF_ROPE))[e] = cs;
      continue;
    }
    const int l = it / PER_LAYER; int j = it % PER_LAYER;
    unsigned char* wl = p.ws + OFF_W + (size_t)l * W_LAYER;
    if (j < N_IN) { const int nt = j / 16, kt = j % 16; const float* s = p.in[4] + (size_t)l * 1024 * INW;
      prep_tile(s, nt * 64, INW, s, nt * 64 + 32, INW, INW, kt * 64, nullptr, 1.f, (bf16_t*)(wl + W_IN), 1024, nt * 64, tile); continue; }
    j -= N_IN;
    if (j < N_UQ) { const int nt = j / 4, kt = j % 4; const float* s = p.in[6] + (size_t)l * 256 * 768;
      prep_tile(s, nt * 64, 768, s, nt * 64 + 32, 768, 768, kt * 64, p.in[5] + l * 256, QSCALE, (bf16_t*)(wl + W_UQ), 256, nt * 64, tile); continue; }
    j -= N_UQ;
    if (j < N_UKV) { const int nt = j / 2, kt = j % 2; const float* s = p.in[8] + (size_t)l * 128 * 1024;
      prep_tile(s, nt * 64, 1024, s, nt * 64 + 32, 1024, 1024, kt * 64, p.in[7] + l * 128, 1.f, (bf16_t*)(wl + W_UKV), 128, nt * 64, tile); continue; }
    j -= N_UKV;
    if (j < N_OUT) { const int nt = j / 12; int kt = j % 12; if (kt >= 8) kt += 4; const float* s = p.in[13] + (size_t)l * 1024 * 1024;
      prep_tile(s, nt * 64, 1024, s, nt * 64 + 32, 1024, 1024, kt * 64, nullptr, 1.f, (bf16_t*)(wl + W_OUT), 1024, nt * 64, tile); continue; }
    j -= N_OUT;
    if (j < N_PF) {
      const int g = j / 16, n0 = (j % 16) * 64, nn = tid & 63;
      const float* wo = p.in[13] + (size_t)l * 1024 * 1024 + (size_t)(512 + g * 64) * 1024 + n0 + nn;
      const float* wp = p.in[9] + (size_t)l * 4 * 64 * 64 + (size_t)g * 64 * 64;
      const float* ps = p.in[10] + l * 256 + g * 64;
      bf16_t* dst = (bf16_t*)(wl + W_OUT);
      for (int i = 0; i < 8; ++i) {
        const int c = (tid >> 6) + 8 * i; float s = 0.f;
        for (int d = 0; d < 64; ++d) s += wp[c * 64 + d] * ps[d] * wo[(size_t)d * 1024];
        dst[(size_t)(n0 + nn) * 1024 + 512 + g * 64 + c] = f2bf(s);
      }
      continue; }
    j -= N_PF;
    if (j < N_GU) { const int nt = j / 16, kt = j % 16, T = nt >> 2, sb = nt & 3;
      const float* s = ((sb < 2) ? p.in[16] : p.in[17]) + (size_t)l * 1024 * DFF; const int c0 = 128 * T + 64 * (sb & 1);
      prep_tile(s, c0, DFF, s, c0 + 32, DFF, DFF, kt * 64, nullptr, 1.f, (bf16_t*)(wl + W_GU), 1024, nt * 64, tile); continue; }
    j -= N_GU;
    { const int nt = j / 44, kt = j % 44; const float* s = p.in[18] + (size_t)l * DFF * 1024;
      prep_tile(s, nt * 64, 1024, s, nt * 64 + 32, 1024, 1024, kt * 64, nullptr, 1.f, (bf16_t*)(wl + W_DN), DFF, nt * 64, tile); }
  }
}

__device__ void phase_ln(const float* src, float* dst32, bf16_t* dstb, const float* g, const float* bta, int nrows, f32x2* stats, bool ident) {
  const int tid = otid(); const int lane = tid & 63, wid = tid >> 6;
  f32x4 gv[4], bv[4];
#pragma unroll
  for (int j = 0; j < 4; ++j) { gv[j] = *(const f32x4*)(g + j * 256 + lane * 4); bv[j] = *(const f32x4*)(bta + j * 256 + lane * 4); }
  const int rstride = gridDim.x * 8;
  for (int row0 = blockIdx.x * 8 + wid; row0 < nrows; row0 += 2 * rstride) {
    f32x4 v[2][4];
    const bool two = (row0 + rstride) < nrows;
#pragma unroll
    for (int j = 0; j < 4; ++j) v[0][j] = *(const f32x4*)(src + (size_t)row0 * 1024 + j * 256 + lane * 4);
    if (two) {
#pragma unroll
      for (int j = 0; j < 4; ++j) v[1][j] = *(const f32x4*)(src + (size_t)(row0 + rstride) * 1024 + j * 256 + lane * 4);
    }
#pragma unroll
    for (int u = 0; u < 2; ++u) {
      if (u == 1 && !two) break;
      const int row = row0 + u * rstride;
      float s = 0.f;
#pragma unroll
      for (int j = 0; j < 4; ++j) s += (v[u][j][0] + v[u][j][1]) + (v[u][j][2] + v[u][j][3]);
      const float mean = wave_sum(s) * (1.f / 1024.f);
      float q = 0.f;
#pragma unroll
      for (int j = 0; j < 4; ++j) { f32x4 d = v[u][j] - mean; q += (d[0] * d[0] + d[1] * d[1]) + (d[2] * d[2] + d[3] * d[3]); }
      const float rstd = rsqrtf(wave_sum(q) * (1.f / 1024.f) + LN_EPS);
      if (lane == 0) { f32x2 sv = {ident ? 0.f : mean, ident ? 1.f : rstd}; stats[row] = sv; }
#pragma unroll
      for (int j = 0; j < 4; ++j) {
        f32x4 o = (v[u][j] - mean) * rstd * gv[j] + bv[j];
        if (dst32) *(f32x4*)(dst32 + (size_t)row * 1024 + j * 256 + lane * 4) = o;
        u32x2 w = {pk2(o[0], o[1]), pk2(o[2], o[3])};
        *(u32x2*)(dstb + (size_t)row * 1024 + j * 256 + lane * 4) = w;
      }
    }
  }
}

constexpr int G_BUF = 256 * 64;
constexpr int G_SMEM_BYTES = 4 * G_BUF * 2;
#define LAS3 __attribute__((address_space(3)))

template <class Epi>
__device__ __forceinline__ void gemm_tile(const bf16_t* __restrict__ A, int lda, const bf16_t* __restrict__ Bt, int K, int m0, int n0, char* smem, const Epi& epi) {
  const int tid = otid(), lane = tid & 63, wid = tid >> 6, wm = wid >> 2, wn = wid & 3, r32 = lane & 31, hi = lane >> 5;
  LAS3 unsigned char* lds = (LAS3 unsigned char*)smem;
  const int rowl = wid * 8 + (lane >> 3), gch = (lane & 7) ^ ((rowl >> 1) & 7);
  const bf16_t* pa = A + (size_t)(m0 + rowl) * lda + gch * 8;
  const bf16_t* pb = Bt + (size_t)(n0 + rowl) * K + gch * 8;
  const size_t sa = (size_t)64 * lda, sb = (size_t)64 * K;
  const unsigned wbase = (unsigned)__builtin_amdgcn_readfirstlane(wid * 1024);
#define G_DMA(buf, k0) do { _Pragma("unroll") for (int j_ = 0; j_ < 4; ++j_) { \
    __builtin_amdgcn_global_load_lds((const unsigned*)(pa + j_ * sa + (k0)), (LAS3 unsigned*)(lds + (buf) * 32768 + j_ * 8192 + wbase), 16, 0, 0); \
    __builtin_amdgcn_global_load_lds((const unsigned*)(pb + j_ * sb + (k0)), (LAS3 unsigned*)(lds + 65536 + (buf) * 32768 + j_ * 8192 + wbase), 16, 0, 0); } } while (0)
  f32x16 acc[2][4];
#pragma unroll
  for (int a = 0; a < 2; ++a)
#pragma unroll
    for (int b = 0; b < 4; ++b) acc[a][b] = f32x16{};
  G_DMA(0, 0);
  asm volatile("s_waitcnt vmcnt(0)" ::: "memory");
  __syncthreads();
  const int nk = K >> 6;
  const int swz = (r32 >> 1) & 7;
  int koff[4];
#pragma unroll
  for (int kk = 0; kk < 4; ++kk) koff[kk] = ((kk * 2 + hi) ^ swz) * 16;
  const int aoff = (wm * 128 + r32) * 128, boff = 65536 + (wn * 64 + r32) * 128;
  for (int t = 0; t < nk; ++t) {
    const int buf = t & 1;
    if (t + 1 < nk) G_DMA(buf ^ 1, (t + 1) * 64);
    const LAS3 unsigned char* as = lds + buf * 32768 + aoff; const LAS3 unsigned char* bs = lds + buf * 32768 + boff;
    bf16x8 af[2][4], bfr[2][2];
#define G_LDF(S, KK) do { _Pragma("unroll") for (int mt = 0; mt < 4; ++mt) af[S][mt] = *(const LAS3 bf16x8*)(as + mt * 4096 + koff[KK]); \
      _Pragma("unroll") for (int nt = 0; nt < 2; ++nt) bfr[S][nt] = *(const LAS3 bf16x8*)(bs + nt * 4096 + koff[KK]); } while (0)
    G_LDF(0, 0);
#pragma unroll
    for (int kk = 0; kk < 4; ++kk) {
      if (kk < 3) G_LDF((kk + 1) & 1, kk + 1);
      __builtin_amdgcn_sched_barrier(0);
#pragma unroll
      for (int nt = 0; nt < 2; ++nt)
#pragma unroll
        for (int mt = 0; mt < 4; ++mt) acc[nt][mt] = MFMA32(bfr[kk & 1][nt], af[kk & 1][mt], acc[nt][mt]);
      __builtin_amdgcn_sched_barrier(0);
    }
#undef G_LDF
    asm volatile("s_waitcnt vmcnt(0)" ::: "memory");
    __syncthreads();
  }
#undef G_DMA
  epi(acc, m0, n0, wm, wn, r32, hi);
}

struct EpiInProj {
  bf16_t* proj; float* gates; char* smem;
  __device__ __forceinline__ void operator()(const f32x16 (&acc)[2][4], int m0, int n0, int wm, int wn, int r32, int hi) const {
    const int lane = r32 + 32 * hi, wid = wm * 4 + wn;
    bf16_t* wl = (bf16_t*)smem + wid * (32 * 72);
    const int c = lane & 7, rq = lane >> 3;
#pragma unroll
    for (int mt = 0; mt < 4; ++mt) {
      const int m = m0 + wm * 128 + mt * 32 + r32;
#pragma unroll
      for (int nt = 0; nt < 2; ++nt)
#pragma unroll
        for (int g = 0; g < 4; ++g) {
          const int nb = n0 + wn * 64 + nt * 32 + g * 8 + hi * 4;
          const f32x16& a = acc[nt][mt];
          u32x2 w = {pk2(a[4 * g], a[4 * g + 1]), pk2(a[4 * g + 2], a[4 * g + 3])};
          *(u32x2*)(wl + r32 * 72 + nt * 32 + g * 8 + hi * 4) = w;
          if (nb >= C_G && nb < INW) { f32x4 v = {a[4 * g], a[4 * g + 1], a[4 * g + 2], a[4 * g + 3]}; *(f32x4*)(gates + (size_t)m * 16 + (nb - C_G)) = v; }
        }
      asm volatile("s_waitcnt lgkmcnt(0)" ::: "memory");
#pragma unroll
      for (int i = 0; i < 4; ++i) {
        const int rr = rq + 8 * i;
        const u32x4 v = *(const u32x4*)(wl + rr * 72 + c * 8);
        *(u32x4*)(proj + (size_t)(m0 + wm * 128 + mt * 32 + rr) * NPROJ + n0 + wn * 64 + c * 8) = v;
      }
      asm volatile("s_waitcnt lgkmcnt(0)" ::: "memory");
    }
    __syncthreads();
  }
};

struct EpiQUp {
  bf16_t* Q; const float* rs; const f32x2* rope; int smask; char* smem;
  __device__ __forceinline__ void operator()(const f32x16 (&acc)[2][4], int m0, int n0, int wm, int wn, int r32, int hi) const {
    const int lane = r32 + 32 * hi, wid = wm * 4 + wn;
    bf16_t* wl = (bf16_t*)smem + wid * 2560;
    const int c = lane & 7, rq = lane >> 3;
#pragma unroll
    for (int mt = 0; mt < 4; ++mt) {
      const int ml = wm * 128 + mt * 32 + r32, m = m0 + ml; const float r = rs[ml]; const int pos = m & smask;
#pragma unroll
      for (int nt = 0; nt < 2; ++nt) {
        const int nb0 = n0 + wn * 64 + nt * 32; const int t32 = nb0 >> 5; const bool isrope = (t32 % 3) == 2;
        float v[16];
#pragma unroll
        for (int k = 0; k < 16; ++k) v[k] = acc[nt][mt][k] * r;
        if (isrope) {
#pragma unroll
          for (int g = 0; g < 2; ++g)
#pragma unroll
            for (int i = 0; i < 4; ++i) {
              const int dd = 8 * g + 4 * hi + i; const f32x2 cs = rope[pos * 16 + dd];
              const float x1 = v[4 * g + i], x2 = v[4 * g + i + 8];
              v[4 * g + i] = x1 * cs[0] - x2 * cs[1]; v[4 * g + i + 8] = x2 * cs[0] + x1 * cs[1];
            }
        }
#pragma unroll
        for (int g = 0; g < 4; ++g) { u32x2 w = {pk2(v[4 * g], v[4 * g + 1]), pk2(v[4 * g + 2], v[4 * g + 3])}; *(u32x2*)(wl + r32 * 72 + nt * 32 + g * 8 + hi * 4) = w; }
      }
      asm volatile("s_waitcnt lgkmcnt(0)" ::: "memory");
#pragma unroll
      for (int i = 0; i < 4; ++i) { const int rr = rq + 8 * i; const u32x4 w = *(const u32x4*)(wl + rr * 72 + c * 8);
        *(u32x4*)(Q + (size_t)(m0 + wm * 128 + mt * 32 + rr) * 768 + n0 + wn * 64 + c * 8) = w; }
      asm volatile("s_waitcnt lgkmcnt(0)" ::: "memory");
    }
  }
};

struct EpiKVUp {
  bf16_t* Kn; bf16_t* Vt; const float* rs; int S, slog, smask; char* smem;
  __device__ __forceinline__ void operator()(const f32x16 (&acc)[2][4], int m0, int n0, int wm, int wn, int r32, int hi) const {
    const int lane = r32 + 32 * hi, wid = wm * 4 + wn;
    bf16_t* wl = (bf16_t*)smem + wid * 2560;
    const int nbw = n0 + wn * 64, head = nbw >> 7; const bool isv = (nbw & 64) != 0;
#pragma unroll
    for (int mt = 0; mt < 4; ++mt) {
      const int ml = wm * 128 + mt * 32 + r32; const float r = rs[ml];
      const int mg = m0 + wm * 128 + mt * 32;
      if (!isv) {
#pragma unroll
        for (int nt = 0; nt < 2; ++nt)
#pragma unroll
          for (int g = 0; g < 4; ++g) { const f32x16& a = acc[nt][mt];
            u32x2 w = {pk2(a[4 * g] * r, a[4 * g + 1] * r), pk2(a[4 * g + 2] * r, a[4 * g + 3] * r)};
            *(u32x2*)(wl + r32 * 72 + nt * 32 + g * 8 + hi * 4) = w; }
        asm volatile("s_waitcnt lgkmcnt(0)" ::: "memory");
        const int c = lane & 7, rq = lane >> 3;
#pragma unroll
        for (int i = 0; i < 4; ++i) { const int rr = rq + 8 * i; const u32x4 w = *(const u32x4*)(wl + rr * 72 + c * 8);
          *(u32x4*)(Kn + (size_t)(mg + rr) * 512 + head * 64 + c * 8) = w; }
      } else {
#pragma unroll
        for (int nt = 0; nt < 2; ++nt)
#pragma unroll
          for (int k = 0; k < 16; ++k) { const int dv = nt * 32 + 8 * (k >> 2) + 4 * hi + (k & 3); wl[dv * 40 + r32] = f2bf(acc[nt][mt][k] * r); }
        asm volatile("s_waitcnt lgkmcnt(0)" ::: "memory");
        const int cc = lane & 3, dq = lane >> 2; const int pos0 = mg & smask, bb = mg >> slog;
#pragma unroll
        for (int i = 0; i < 4; ++i) { const int dvr = dq + 16 * i; const u32x4 w = *(const u32x4*)(wl + dvr * 40 + cc * 8);
          *(u32x4*)(Vt + ((size_t)(bb * 8 + head) * 64 + dvr) * S + pos0 + cc * 8) = w; }
      }
      asm volatile("s_waitcnt lgkmcnt(0)" ::: "memory");
    }
  }
};

struct EpiResid {
  float* x; char* smem;
  __device__ __forceinline__ void operator()(const f32x16 (&acc)[2][4], int m0, int n0, int wm, int wn, int r32, int hi) const {
    const int lane = r32 + 32 * hi, wid = wm * 4 + wn;
    float* wl = (float*)smem + wid * (32 * 68);
    const int c = lane & 15, rq = lane >> 4;
    float* xb = x + (size_t)(m0 + wm * 128 + rq) * 1024 + n0 + wn * 64 + c * 4;
    f32x4 xc[8], xn[8];
#pragma unroll
    for (int i = 0; i < 8; ++i) xc[i] = *(const f32x4*)(xb + (size_t)(4 * i) * 1024);
#pragma unroll
    for (int mt = 0; mt < 4; ++mt) {
      if (mt < 3) {
#pragma unroll
        for (int i = 0; i < 8; ++i) xn[i] = *(const f32x4*)(xb + (size_t)((mt + 1) * 32 + 4 * i) * 1024);
      }
#pragma unroll
      for (int nt = 0; nt < 2; ++nt)
#pragma unroll
        for (int g = 0; g < 4; ++g) { const f32x16& a = acc[nt][mt];
          f32x4 v = {a[4 * g], a[4 * g + 1], a[4 * g + 2], a[4 * g + 3]};
          *(f32x4*)(wl + r32 * 68 + nt * 32 + g * 8 + hi * 4) = v; }
      asm volatile("s_waitcnt lgkmcnt(0)" ::: "memory");
      f32x4 ov[8];
#pragma unroll
      for (int i = 0; i < 8; ++i) { const f32x4 a = *(const f32x4*)(wl + (rq + 4 * i) * 68 + c * 4); ov[i] = xc[i] * DN_ALPHA + a; }
#pragma unroll
      for (int i = 0; i < 8; ++i) *(f32x4*)(xb + (size_t)(mt * 32 + 4 * i) * 1024) = ov[i];
      asm volatile("s_waitcnt lgkmcnt(0)" ::: "memory");
#pragma unroll
      for (int i = 0; i < 8; ++i) xc[i] = xn[i];
    }
    __syncthreads();
  }
};

struct EpiGU {
  bf16_t* hid; char* smem;
  __device__ __forceinline__ void operator()(const f32x16 (&acc)[2][4], int m0, int n0, int wm, int wn, int r32, int hi) const {
    const int hb = (n0 + wn * 64) >> 1;
    const int lane = r32 + 32 * hi, wid = wm * 4 + wn;
    bf16_t* wl = (bf16_t*)smem + wid * (32 * 40);
    const int c = lane & 3, rq = lane >> 2;
#pragma unroll
    for (int mt = 0; mt < 4; ++mt) {
#pragma unroll
      for (int g = 0; g < 4; ++g) {
        float o[4];
#pragma unroll
        for (int i = 0; i < 4; ++i) { const float gt = acc[0][mt][4 * g + i], up = acc[1][mt][4 * g + i]; o[i] = gt * up * __builtin_amdgcn_rcpf(1.f + __builtin_amdgcn_exp2f(-1.4426950408889634f * gt)); }
        u32x2 w = {pk2(o[0], o[1]), pk2(o[2], o[3])};
        *(u32x2*)(wl + r32 * 40 + g * 8 + hi * 4) = w;
      }
      asm volatile("s_waitcnt lgkmcnt(0)" ::: "memory");
#pragma unroll
      for (int i = 0; i < 2; ++i) {
        const int rr = rq + 16 * i;
        const u32x4 v = *(const u32x4*)(wl + rr * 40 + c * 8);
        *(u32x4*)(hid + (size_t)(m0 + wm * 128 + mt * 32 + rr) * DFF + hb + c * 8) = v;
      }
      asm volatile("s_waitcnt lgkmcnt(0)" ::: "memory");
    }
    __syncthreads();
  }
};

namespace pg8 {
#define PG8_LAS __attribute__((address_space(3)))
typedef unsigned short bf16_t;
typedef short bf16x8 __attribute__((ext_vector_type(8)));
typedef float f32x4 __attribute__((ext_vector_type(4)));
typedef unsigned u32x4 __attribute__((ext_vector_type(4)));
constexpr int BM = 256, BK = 64, HALF = 128, HTB = HALF * BK * 2  , STAGE_BYTES = 8 * HTB, NXCD = 8, WGM = 8;

__host__ __device__ __forceinline__ int lds_byte(int r, int c) { const int st = (r >> 4) * 2 + (c >> 5), rr = r & 15, cc = c & 31, ob = rr * 64 + cc * 2; return st * 1024 + (ob ^ (((ob >> 9) & 1) << 5)); }
__host__ __device__ __forceinline__ void stage_rc(int b, int& R, int& C) { const int st = b / 1024, sb = b % 1024, swz = sb ^ (((sb >> 9) & 1) << 5); R = (st >> 1) * 16 + swz / 64; C = (st & 1) * 32 + (swz % 64) / 2; }
__host__ __device__ __forceinline__ int perm32(int rho) { const int n = rho >> 4, i = rho & 15; return 8 * (i >> 2) + 4 * n + (i & 3); }

struct Unit { int pm, pn; };
struct Gemm { const bf16_t* A; const bf16_t* Bt; int M, N, K, lda; };

struct StaticOrder {
    int nM, nN, nwg, G, c;
    __host__ __device__ void init(int M, int N, int G_, int c_) { nM = M / BM; nN = N / BM; nwg = nM * nN; G = G_; c = c_; }
    __host__ __device__ bool next(int i, Unit& u) const {
        const long L = (long)i * G + c; if (L >= nwg) return false;
        int wgid = (int)L; { const int q = nwg / NXCD, r = nwg % NXCD, xcd = wgid % NXCD, off = wgid / NXCD; wgid = (xcd < r ? xcd * (q + 1) : r * (q + 1) + (xcd - r) * q) + off; }
        const int nig = WGM * nN, gid = wgid / nig, fm = gid * WGM, gsz = (nM - fm) < WGM ? (nM - fm) : WGM;
        u.pm = fm + ((wgid % nig) % gsz); u.pn = (wgid % nig) / gsz; return true;
    }
    __device__ __forceinline__ void a_ready(const Unit&) const {}
    __device__ __forceinline__ void done(const Unit&) const {}
};


struct EpiInProj2 {
  static constexpr bool PERM = true, AFTER_DRAIN = false;
  bf16_t* proj; float* gates;
  __device__ __forceinline__ void operator()(const f32x4 (&acc)[2][2][4][2], const Unit& u, int wr, int wc, int fr, int fq) const {
#pragma unroll
    for (int ai = 0; ai < 2; ++ai)
#pragma unroll
      for (int m = 0; m < 4; ++m) { const size_t row = (size_t)u.pm * BM + ai * HALF + wr * 64 + m * 16 + fr;
#pragma unroll
        for (int bj = 0; bj < 2; ++bj) { const int col0 = u.pn * BM + bj * HALF + wc * 32 + 8 * fq; const f32x4 v0 = acc[ai][bj][m][0], v1 = acc[ai][bj][m][1];
          u32x4 w; w.x = pk2(v0[0], v0[1]); w.y = pk2(v0[2], v0[3]); w.z = pk2(v1[0], v1[1]); w.w = pk2(v1[2], v1[3]);
          *(u32x4*)(proj + row * NPROJ + col0) = w;
          if (col0 >= C_G && col0 < INW) { *(f32x4*)(gates + row * 16 + (col0 - C_G)) = v0; *(f32x4*)(gates + row * 16 + (col0 - C_G) + 4) = v1; } } }
  }
};
struct EpiResid2 {
  static constexpr bool PERM = false, AFTER_DRAIN = false;
  float* x; const f32x2* stats; const float* g; const float* b;
  __device__ __forceinline__ void operator()(const f32x4 (&acc)[2][2][4][2], const Unit& u, int wr, int wc, int fr, int fq) const {
    const int row0 = u.pm * BM + wr * 64 + fr, col0 = u.pn * BM + wc * 32 + 4 * fq;
    float* rb = x + (size_t)row0 * 1024 + col0;
#pragma unroll
    for (int ai = 0; ai < 2; ++ai)
#pragma unroll
      for (int m = 0; m < 4; ++m) {
        f32x4 xc[2][2]; const f32x2 sv = stats[row0 + ai * HALF + m * 16];
#pragma unroll
        for (int bj = 0; bj < 2; ++bj)
#pragma unroll
          for (int n = 0; n < 2; ++n) xc[bj][n] = *(const f32x4*)(rb + (size_t)(ai * HALF + m * 16) * 1024 + bj * HALF + n * 16);
#pragma unroll
        for (int bj = 0; bj < 2; ++bj)
#pragma unroll
          for (int n = 0; n < 2; ++n) { const f32x4 gv = *(const f32x4*)(g + col0 + bj * HALF + n * 16), bv = *(const f32x4*)(b + col0 + bj * HALF + n * 16);
            const f32x4 xn = (xc[bj][n] - sv[0]) * sv[1] * gv + bv;
            *(f32x4*)(rb + (size_t)(ai * HALF + m * 16) * 1024 + bj * HALF + n * 16) = xn * DN_ALPHA + acc[ai][bj][m][n]; }
        asm volatile("" ::: "memory");
      }
  }
};
struct EpiGU2 {
  static constexpr bool PERM = true, AFTER_DRAIN = false;
  bf16_t* hid;
  __device__ __forceinline__ void operator()(const f32x4 (&acc)[2][2][4][2], const Unit& u, int wr, int wc, int fr, int fq) const {
#pragma unroll
    for (int ai = 0; ai < 2; ++ai)
#pragma unroll
      for (int m = 0; m < 4; ++m) { const size_t row = (size_t)u.pm * BM + ai * HALF + wr * 64 + m * 16 + fr; float o[8];
#pragma unroll
        for (int n = 0; n < 2; ++n)
#pragma unroll
          for (int i = 0; i < 4; ++i) { const float gt = acc[ai][0][m][n][i], up = acc[ai][1][m][n][i]; o[4 * n + i] = gt * up * __builtin_amdgcn_rcpf(1.f + __builtin_amdgcn_exp2f(-1.4426950408889634f * gt)); }
        u32x4 w; w.x = pk2(o[0], o[1]); w.y = pk2(o[2], o[3]); w.z = pk2(o[4], o[5]); w.w = pk2(o[6], o[7]);
        *(u32x4*)(hid + row * DFF + u.pn * HALF + wc * 32 + 8 * fq) = w; }
  }
};
template <class Epi, class Sched, bool ALIGN_EPI = false, bool SP2 = false>
__device__ __forceinline__ void gemm_phase(PG8_LAS unsigned char* lds, const Gemm g, const Sched& S, const Epi& E) {
    const int tid = otid(), wid = __builtin_amdgcn_readfirstlane(tid >> 6), lane = tid & 63, wr = wid >> 2, wc = wid & 3, fr = lane & 15, fq = lane >> 4;
    const int K = g.K, nt = K / BK;
    unsigned voffA[2], voffB[2];
#pragma unroll
    for (int i = 0; i < 2; ++i) { int R, C; stage_rc(tid * 16 + i * 8192, R, C); const int Rb = Epi::PERM ? ((R & ~31) + perm32(R & 31)) : R;
        voffA[i] = (unsigned)(R * g.lda + C) * 2u; voffB[i] = (unsigned)(Rb * K + C) * 2u; }
    const size_t kstep = (size_t)(BK * 2);
    const size_t hstepB = (size_t)HALF * K * 2, hstepA = (size_t)HALF * g.lda * 2;
    const size_t tstepA = 2 * hstepA, tstepB = 2 * hstepB;
    const unsigned ldsw = (unsigned)wid * 1024u;
    const int aoff = lds_byte(wr * 64 + fr, fq * 8), boff = lds_byte(wc * 32 + fr, fq * 8);
#define PG8_SA(b, h) (((b) * 2 + (h)) * HTB)
#define PG8_SB(b, h) ((4 + (b) * 2 + (h)) * HTB)
#define PG8_STAGE(bufoff, gbase, voff) do { _Pragma("unroll") for (int _i = 0; _i < 2; ++_i) \
        __builtin_amdgcn_global_load_lds((const unsigned*)((const char*)(gbase) + (voff)[_i]), (PG8_LAS unsigned*)(lds + (bufoff) + ldsw + _i * 8192), 16, 0, 0); } while (0)
#define PG8_LDA(dst, b, h) do { _Pragma("unroll") for (int m = 0; m < 4; ++m) _Pragma("unroll") for (int k = 0; k < 2; ++k) dst[m][k] = *(const PG8_LAS bf16x8*)(lds + PG8_SA(b, h) + aoff + m * 2048 + k * 1024); } while (0)
#define PG8_LDB(dst, b, h) do { _Pragma("unroll") for (int n = 0; n < 2; ++n) _Pragma("unroll") for (int k = 0; k < 2; ++k) dst[n][k] = *(const PG8_LAS bf16x8*)(lds + PG8_SB(b, h) + boff + n * 2048 + k * 1024); } while (0)
#define PG8_MMA(ai, bj, At, Bt) do { __builtin_amdgcn_s_setprio(1); _Pragma("unroll") for (int m = 0; m < 4; ++m) _Pragma("unroll") for (int n = 0; n < 2; ++n) _Pragma("unroll") for (int k = 0; k < 2; ++k) \
        acc[ai][bj][m][n] = __builtin_amdgcn_mfma_f32_16x16x32_bf16(Bt[n][k], At[m][k], acc[ai][bj][m][n], 0, 0, 0); __builtin_amdgcn_s_setprio(0); } while (0)
#define PG8_WAIT_V(n) asm volatile("s_waitcnt vmcnt(" #n ")" ::: "memory")
#define PG8_WAIT_L(n) asm volatile("s_waitcnt lgkmcnt(" #n ")" ::: "memory")
#define PG8_BAR __builtin_amdgcn_s_barrier()
#define PG8_SCHED __builtin_amdgcn_sched_barrier(0)
    Unit cur, nxt; int ui = 0;
    if (!S.next(0, cur)) return;
    f32x4 acc[2][2][4][2];
#pragma unroll
    for (int a = 0; a < 2; ++a)
#pragma unroll
        for (int b = 0; b < 2; ++b)
#pragma unroll
            for (int m = 0; m < 4; ++m)
#pragma unroll
                for (int n = 0; n < 2; ++n) acc[a][b][m][n] = (f32x4){0.f, 0.f, 0.f, 0.f};
    bf16x8 At[4][2], B0[2][2], B1[2][2];
    const char* cA = (const char*)g.A + (size_t)cur.pm * tstepA; const char* cB = (const char*)g.Bt + (size_t)cur.pn * tstepB;
    S.a_ready(cur);
    if constexpr (SP2) {
        PG8_STAGE(PG8_SB(0, 0), cB, voffB); PG8_STAGE(PG8_SB(0, 1), cB + hstepB, voffB); PG8_STAGE(PG8_SA(0, 0), cA, voffA); PG8_STAGE(PG8_SA(0, 1), cA + hstepA, voffA);
        if (wr == 1) PG8_BAR;
        PG8_WAIT_V(2); PG8_BAR;
        PG8_STAGE(PG8_SB(1, 0), cB + kstep, voffB); PG8_STAGE(PG8_SA(1, 0), cA + kstep, voffA); PG8_STAGE(PG8_SB(1, 1), cB + hstepB + kstep, voffB);
        PG8_WAIT_V(6); PG8_BAR;
    } else {
        PG8_STAGE(PG8_SB(0, 0), cB, voffB); PG8_STAGE(PG8_SA(0, 0), cA, voffA); PG8_STAGE(PG8_SB(0, 1), cB + hstepB, voffB); PG8_STAGE(PG8_SA(0, 1), cA + hstepA, voffA);
        if (wr == 1) PG8_BAR;
        PG8_WAIT_V(4); PG8_BAR;
        PG8_STAGE(PG8_SB(1, 0), cB + kstep, voffB); PG8_STAGE(PG8_SA(1, 0), cA + kstep, voffA); PG8_STAGE(PG8_SB(1, 1), cB + hstepB + kstep, voffB);
        PG8_WAIT_V(6); PG8_BAR;
    }
    for (;;) {
        const bool has_next = S.next(ui + 1, nxt);
        const char* nA = has_next ? (const char*)g.A + (size_t)nxt.pm * tstepA : cA; const char* nB = has_next ? (const char*)g.Bt + (size_t)nxt.pn * tstepB : cB;
        for (int t = 0; t < nt; t += 2) {
            const bool last = (t == nt - 2);
            const char* a1 = cA + (size_t)(t + 1) * kstep;
            const char* a2 = last ? nA : cA + (size_t)(t + 2) * kstep; const char* b2 = last ? nB : cB + (size_t)(t + 2) * kstep;
            const char* a3 = a2 + kstep; const char* b3 = b2 + kstep;
            if (last && has_next) S.a_ready(nxt);
            if constexpr (SP2) {
            PG8_LDB(B0, 0, 0); PG8_LDB(B1, 0, 1); PG8_SCHED; PG8_LDA(At, 0, 0); PG8_STAGE(PG8_SA(1, 1), a1 + hstepA, voffA);
            PG8_WAIT_V(8); PG8_WAIT_L(0); PG8_BAR; PG8_MMA(0, 0, At, B0); PG8_MMA(0, 1, At, B1); PG8_BAR; PG8_SCHED;
            PG8_LDA(At, 0, 1); PG8_STAGE(PG8_SB(0, 0), b2, voffB); PG8_STAGE(PG8_SB(0, 1), b2 + hstepB, voffB); PG8_STAGE(PG8_SA(0, 0), a2, voffA);
            PG8_WAIT_V(8); PG8_WAIT_L(0); PG8_BAR; PG8_MMA(1, 0, At, B0); PG8_MMA(1, 1, At, B1); PG8_BAR; PG8_SCHED;
            PG8_LDB(B0, 1, 0); PG8_LDB(B1, 1, 1); PG8_SCHED; PG8_LDA(At, 1, 0); PG8_STAGE(PG8_SA(0, 1), a2 + hstepA, voffA);
            PG8_WAIT_V(8); PG8_WAIT_L(0); PG8_BAR; PG8_MMA(0, 0, At, B0); PG8_MMA(0, 1, At, B1); PG8_BAR; PG8_SCHED;
            PG8_LDA(At, 1, 1); PG8_STAGE(PG8_SB(1, 0), b3, voffB); PG8_STAGE(PG8_SB(1, 1), b3 + hstepB, voffB); PG8_STAGE(PG8_SA(1, 0), a3, voffA);
            PG8_WAIT_V(8); PG8_WAIT_L(0); PG8_BAR; PG8_MMA(1, 0, At, B0); PG8_MMA(1, 1, At, B1); PG8_BAR; PG8_SCHED;
            } else {
            PG8_LDB(B0, 0, 0); PG8_SCHED; PG8_LDA(At, 0, 0); PG8_STAGE(PG8_SA(1, 1), a1 + hstepA, voffA);
            PG8_WAIT_L(8); PG8_BAR; PG8_WAIT_L(0); PG8_MMA(0, 0, At, B0); PG8_BAR; PG8_SCHED;
            PG8_LDB(B1, 0, 1); PG8_STAGE(PG8_SB(0, 0), b2, voffB);
            PG8_BAR; PG8_WAIT_L(0); PG8_MMA(0, 1, At, B1); PG8_BAR;
            PG8_LDA(At, 0, 1); PG8_STAGE(PG8_SA(0, 0), a2, voffA);
            PG8_BAR; PG8_WAIT_L(0); PG8_MMA(1, 0, At, B0); PG8_BAR; PG8_SCHED;
            PG8_STAGE(PG8_SB(0, 1), b2 + hstepB, voffB);
            PG8_WAIT_V(6); PG8_BAR; PG8_MMA(1, 1, At, B1); PG8_BAR;
            PG8_LDB(B0, 1, 0); PG8_SCHED; PG8_LDA(At, 1, 0); PG8_STAGE(PG8_SA(0, 1), a2 + hstepA, voffA);
            PG8_WAIT_L(8); PG8_BAR; PG8_WAIT_L(0); PG8_MMA(0, 0, At, B0); PG8_BAR; PG8_SCHED;
            PG8_LDB(B1, 1, 1); PG8_STAGE(PG8_SB(1, 0), b3, voffB);
            PG8_BAR; PG8_WAIT_L(0); PG8_MMA(0, 1, At, B1); PG8_BAR;
            PG8_LDA(At, 1, 1); PG8_STAGE(PG8_SA(1, 0), a3, voffA);
            PG8_BAR; PG8_WAIT_L(0); PG8_MMA(1, 0, At, B0); PG8_BAR; PG8_SCHED;
            PG8_STAGE(PG8_SB(1, 1), b3 + hstepB, voffB);
            PG8_WAIT_V(6); PG8_BAR; PG8_MMA(1, 1, At, B1); PG8_BAR;
            }
        }
        if constexpr (ALIGN_EPI) { if (wr == 0) PG8_BAR; }
        if constexpr (!Epi::AFTER_DRAIN) { E(acc, cur, wr, wc, fr, fq); S.done(cur); }
        if (!has_next) break;
#pragma unroll
        for (int a = 0; a < 2; ++a)
#pragma unroll
            for (int b = 0; b < 2; ++b)
#pragma unroll
                for (int m = 0; m < 4; ++m)
#pragma unroll
                    for (int n = 0; n < 2; ++n) acc[a][b][m][n] = (f32x4){0.f, 0.f, 0.f, 0.f};
        cur = nxt; cA = nA; cB = nB; ++ui;
        if constexpr (ALIGN_EPI) { if (wr == 1) PG8_BAR; }
    }
    PG8_WAIT_V(0);
    if constexpr (!ALIGN_EPI) { if (wr == 0) PG8_BAR; }
    PG8_BAR;
    if constexpr (Epi::AFTER_DRAIN) { E.fused(acc, cur, wr, wc, fr, fq, lds, wid, lane); S.done(cur); }
#undef PG8_SA
#undef PG8_SB
#undef PG8_STAGE
#undef PG8_LDA
#undef PG8_LDB
#undef PG8_MMA
#undef PG8_WAIT_V
#undef PG8_WAIT_L
#undef PG8_BAR
#undef PG8_SCHED
}
}


__device__ __forceinline__ void row_rms(const bf16_t* A, int lda, int K, int m0, float* rs) {
  const int tid = otid(), row = tid >> 1, half = tid & 1;
  const bf16_t* p = A + (size_t)(m0 + row) * lda + half * (K >> 1);
  float s = 0.f;
  for (int i = 0; i < (K >> 4); ++i) { const u32x4 w = *(const u32x4*)(p + i * 8);
#pragma unroll
    for (int k = 0; k < 4; ++k) { const float a = bflo(w[k]), b = bfhi(w[k]); s += a * a + b * b; } }
  s += __shfl_xor(s, 1);
  if (half == 0) rs[row] = rsqrtf(s / (float)K + LN_EPS);
  __syncthreads();
}

constexpr int A_KS = 104, A_VS = 72;
constexpr int A_KBUF = 64 * A_KS, A_VBUF = 64 * A_VS;
constexpr float A_THR = 8.f;
__device__ void attn_unit(const bf16_t* __restrict__ Q, const bf16_t* __restrict__ Kn, const bf16_t* __restrict__ Vt, const bf16_t* __restrict__ KR,
                          bf16_t* __restrict__ Y, int S, int b, int h, int qb, char* smem) {
  const int tid = otid(), lane = tid & 63, wid = tid >> 6, r32 = lane & 31, hi = lane >> 5;
  bf16_t* Ks = (bf16_t*)smem; bf16_t* Vs = Ks + 2 * A_KBUF; float* wsf = (float*)(Vs + 2 * A_VBUF) + wid * 64;
  const size_t rowbase = (size_t)b * S;
  const int q0 = qb * 256 + wid * 32;
  bf16x8 qr[6];
  { const bf16_t* qp = Q + (rowbase + q0 + r32) * 768 + h * 96 + hi * 8;
#pragma unroll
    for (int d0 = 0; d0 < 6; ++d0) qr[d0] = *(const bf16x8*)(qp + d0 * 16); }
  const bf16_t* kn_src = Kn + (rowbase + (tid >> 3)) * 512 + h * 64 + (tid & 7) * 8;
  const bf16_t* kr_src = KR + (rowbase + (tid >> 2)) * 32 + (tid & 3) * 8;
  const bf16_t* v_src = Vt + ((size_t)(b * 8 + h) * 64 + (tid >> 3)) * S + (tid & 7) * 8;
  const int kn_dst = (tid >> 3) * A_KS + (tid & 7) * 8, kr_dst = (tid >> 2) * A_KS + 64 + (tid & 3) * 8, v_dst = (tid >> 3) * A_VS + (tid & 7) * 8;
  const bool has_kr = tid < 256;
  u32x4 sk, sr, sv;
#define A_LOAD(k0) do { sk = *(const u32x4*)(kn_src + (size_t)(k0) * 512); if (has_kr) sr = *(const u32x4*)(kr_src + (size_t)(k0) * 32); sv = *(const u32x4*)(v_src + (k0)); } while (0)
#define A_STORE(bf) do { *(u32x4*)(Ks + (bf) * A_KBUF + kn_dst) = sk; if (has_kr) *(u32x4*)(Ks + (bf) * A_KBUF + kr_dst) = sr; *(u32x4*)(Vs + (bf) * A_VBUF + v_dst) = sv; } while (0)
  float m_ref = 0.f, l_reg = 0.f; f32x16 o[2], negm; o[0] = f32x16{}; o[1] = f32x16{}; negm = f32x16{};
  const int NT = S >> 6;
  A_LOAD(0); A_STORE(0); __syncthreads();
  for (int j = 0; j < NT; ++j) {
    const int buf = j & 1;
    if (j + 1 < NT) A_LOAD((j + 1) * 64);
#ifndef A_SKEW
#define A_SKEW 1
#endif
    if (A_SKEW > 0 && wid >= 4) __builtin_amdgcn_s_sleep(A_SKEW);
    f32x16 p0, p1;
    bf16x8 vf[8];
    { const bf16_t* kb = Ks + buf * A_KBUF + r32 * A_KS + hi * 8;
      bf16x8 kf[12];
#pragma unroll
      for (int d0 = 0; d0 < 6; ++d0) { kf[2 * d0] = *(const bf16x8*)(kb + d0 * 16); kf[2 * d0 + 1] = *(const bf16x8*)(kb + 32 * A_KS + d0 * 16); }
      __builtin_amdgcn_sched_barrier(0);
      p0 = MFMA32(kf[0], qr[0], negm); p1 = MFMA32(kf[1], qr[0], negm);
#pragma unroll
      for (int d0 = 1; d0 < 6; ++d0) { p0 = MFMA32(kf[2 * d0], qr[d0], p0); p1 = MFMA32(kf[2 * d0 + 1], qr[d0], p1); }
      __builtin_amdgcn_sched_barrier(0);
      const bf16_t* vb = Vs + buf * A_VBUF + r32 * A_VS + hi * 8;
#pragma unroll
      for (int d0 = 0; d0 < 2; ++d0)
#pragma unroll
        for (int ks = 0; ks < 4; ++ks) vf[d0 * 4 + ks] = *(const bf16x8*)(vb + d0 * 32 * A_VS + ks * 16);
      __builtin_amdgcn_sched_barrier(0);
    }
#define MX3(a, b, c) __builtin_fmaxf(__builtin_fmaxf((a), (b)), (c))
    float pmax;
    { float a = MX3(p0[0], p0[1], p0[2]), b2 = MX3(p0[3], p0[4], p0[5]);
      a = MX3(a, p0[6], p0[7]); b2 = MX3(b2, p0[8], p0[9]); a = MX3(a, p0[10], p0[11]); b2 = MX3(b2, p0[12], p0[13]); a = MX3(a, p0[14], p0[15]);
      b2 = MX3(b2, p1[0], p1[1]); a = MX3(a, p1[2], p1[3]); b2 = MX3(b2, p1[4], p1[5]); a = MX3(a, p1[6], p1[7]); b2 = MX3(b2, p1[8], p1[9]);
      a = MX3(a, p1[10], p1[11]); b2 = MX3(b2, p1[12], p1[13]); a = MX3(a, p1[14], p1[15]); pmax = __builtin_fmaxf(a, b2); }
#undef MX3
    { auto rr = __builtin_amdgcn_permlane32_swap(__float_as_uint(pmax), __float_as_uint(pmax), false, false);
      pmax = fmaxf(__uint_as_float(rr[0]), __uint_as_float(rr[1])); }
    if (j == 0 || __any(pmax > A_THR)) {
      const float delta = (j == 0) ? pmax : fmaxf(pmax, 0.f);
#pragma unroll
      for (int r = 0; r < 16; ++r) { p0[r] -= delta; p1[r] -= delta; }
      m_ref += delta;
#pragma unroll
      for (int r = 0; r < 16; ++r) negm[r] = -m_ref;
      if (j > 0) {
        const float al = __builtin_amdgcn_exp2f(-delta); l_reg *= al;
        if (hi == 0) wsf[r32] = al;
        asm volatile("s_waitcnt lgkmcnt(0)" ::: "memory");
#pragma unroll
        for (int r = 0; r < 16; ++r) { const float f = wsf[crow(r, hi)]; o[0][r] *= f; o[1][r] *= f; }
        asm volatile("s_waitcnt lgkmcnt(0)" ::: "memory");
      }
    }
    float ps = 0.f, ps2 = 0.f;
#pragma unroll
    for (int r = 0; r < 16; ++r) { p0[r] = __builtin_amdgcn_exp2f(p0[r]); ps += p0[r]; }
#pragma unroll
    for (int r = 0; r < 16; ++r) { p1[r] = __builtin_amdgcn_exp2f(p1[r]); ps2 += p1[r]; }
    ps += ps2;
    { auto rr = __builtin_amdgcn_permlane32_swap(__float_as_uint(ps), __float_as_uint(ps), false, false);
      ps = __uint_as_float(rr[0]) + __uint_as_float(rr[1]); }
    l_reg += ps;
    bf16x8 pa0, pa1, pa2, pa3;
    PK4(p0, 0, pa0); PK4(p0, 8, pa1); PK4(p1, 0, pa2); PK4(p1, 8, pa3);
    __builtin_amdgcn_sched_barrier(0);
    o[0] = MFMA32(pa0, vf[0], o[0]); o[1] = MFMA32(pa0, vf[4], o[1]);
    o[0] = MFMA32(pa1, vf[1], o[0]); o[1] = MFMA32(pa1, vf[5], o[1]);
    o[0] = MFMA32(pa2, vf[2], o[0]); o[1] = MFMA32(pa2, vf[6], o[1]);
    o[0] = MFMA32(pa3, vf[3], o[0]); o[1] = MFMA32(pa3, vf[7], o[1]);
    __builtin_amdgcn_sched_barrier(0);
    if (j + 1 < NT) A_STORE(buf ^ 1);
    __syncthreads();
  }
#undef A_LOAD
#undef A_STORE
  if (hi == 0) wsf[32 + r32] = l_reg;
  asm volatile("s_waitcnt lgkmcnt(0)" ::: "memory");
  bf16_t* yp = Y + (rowbase + q0) * 1024 + h * 64 + r32;
#pragma unroll
  for (int r = 0; r < 16; ++r) {
    const int orow = crow(r, hi); const float rl = __builtin_amdgcn_rcpf(wsf[32 + orow]);
    yp[(size_t)orow * 1024] = f2bf(o[0][r] * rl); yp[(size_t)orow * 1024 + 32] = f2bf(o[1][r] * rl);
  }
  __syncthreads();
}

__device__ void phase_pool_rope(const bf16_t* __restrict__ proj, bf16_t* __restrict__ Y, bf16_t* __restrict__ KR, const f32x2* __restrict__ rope, int S) {
  const int smask = S - 1;
  const int gtid = blockIdx.x * NTHR + otid(), gstr = gridDim.x * NTHR;
  for (int idx = gtid; idx < (MT / 8) * 32; idx += gstr) {
    const int tb = idx >> 5, c = idx & 31, g = c >> 3, half = 1 << g, t0 = tb * 8, pos0 = t0 & smask;
    const bf16_t* base = proj + (size_t)(t0 - pos0) * NPROJ + C_POOL + c * 8;
    float sum[8];
#pragma unroll
    for (int k = 0; k < 8; ++k) sum[k] = 0.f;
    { int lo = pos0 - half; if (lo < 0) lo = 0; int hi = pos0 + half; if (hi > S) hi = S;
      for (int t = lo; t < hi; ++t) { const u32x4 v = *(const u32x4*)(base + (size_t)t * NPROJ);
#pragma unroll
        for (int k = 0; k < 4; ++k) { sum[2 * k] += bflo(v[k]); sum[2 * k + 1] += bfhi(v[k]); } } }
#pragma unroll
    for (int q = 0; q < 8; ++q) {
      const int pos = pos0 + q; int lo = pos - half; if (lo < 0) lo = 0; int hi = pos + half; if (hi > S) hi = S;
      const float rc = 1.f / (float)(hi - lo);
      const u32x4 xv = *(const u32x4*)(base + (size_t)pos * NPROJ);
      u32x4 o;
#pragma unroll
      for (int k = 0; k < 4; ++k) o[k] = pk2(sum[2 * k] * rc - bflo(xv[k]), sum[2 * k + 1] * rc - bfhi(xv[k]));
      *(u32x4*)(Y + (size_t)(t0 + q) * 1024 + 512 + c * 8) = o;
      if (q < 7) {
        if (pos + half < S) { const u32x4 v = *(const u32x4*)(base + (size_t)(pos + half) * NPROJ);
#pragma unroll
          for (int k = 0; k < 4; ++k) { sum[2 * k] += bflo(v[k]); sum[2 * k + 1] += bfhi(v[k]); } }
        if (pos - half >= 0) { const u32x4 v = *(const u32x4*)(base + (size_t)(pos - half) * NPROJ);
#pragma unroll
          for (int k = 0; k < 4; ++k) { sum[2 * k] -= bflo(v[k]); sum[2 * k + 1] -= bfhi(v[k]); } }
      }
    }
  }
  for (int idx = gtid; idx < MT * 2; idx += gstr) {
    const int m = idx >> 1, hf = idx & 1, pos = m & smask;
    const bf16_t* pp = proj + (size_t)m * NPROJ + C_KR + hf * 8;
    const u32x4 a = *(const u32x4*)pp, b2 = *(const u32x4*)(pp + 16);
    u32x4 o1, o2;
#pragma unroll
    for (int k = 0; k < 4; ++k) {
      const f32x2 c0 = rope[pos * 16 + hf * 8 + 2 * k], c1 = rope[pos * 16 + hf * 8 + 2 * k + 1];
      const float x1a = bflo(a[k]), x1b = bfhi(a[k]), x2a = bflo(b2[k]), x2b = bfhi(b2[k]);
      o1[k] = pk2(x1a * c0[0] - x2a * c0[1], x1b * c1[0] - x2b * c1[1]);
      o2[k] = pk2(x2a * c0[0] + x1a * c0[1], x2b * c1[0] + x1b * c1[1]);
    }
    *(u32x4*)(KR + (size_t)m * 32 + hf * 8) = o1; *(u32x4*)(KR + (size_t)m * 32 + 16 + hf * 8) = o2;
  }
}

__device__ __forceinline__ float logsigmoidf(float f) { return fminf(f, 0.f) - log1pf(__expf(-fabsf(f))); }
constexpr int ML_T = 136;
constexpr int ML_R = 72;

__device__ void mlstm_pass1(int cgi, int hh, const bf16_t* __restrict__ proj, const float* __restrict__ gates, const float* __restrict__ gbias,
                            float* __restrict__ stU, float* __restrict__ stN, float* __restrict__ stS, char* smem) {
  const int tid = otid(), lane = tid & 63, wid = tid >> 6, r32 = lane & 31, hi = lane >> 5;
  bf16_t* Vt = (bf16_t*)smem; bf16_t* Kw = Vt + 64 * ML_T;
  float* sc = (float*)(Kw + 2 * 64 * ML_T); float* lfs = sc; float* als = sc + 256; float* wss = sc + 512; float* red = sc + 768;
  const int item = cgi * 4 + hh; const size_t m0 = (size_t)cgi * 128;
  float ipre = 0.f;
  if (tid < 256) { const int dir = tid >> 7, s = tid & 127; const float* gp = gates + (m0 + s) * 16;
    ipre = gp[(2 * dir) * 4 + hh] + gbias[(2 * dir) * 4 + hh];
    const float f = gp[(2 * dir + 1) * 4 + hh] + gbias[(2 * dir + 1) * 4 + hh];
    lfs[tid] = logsigmoidf(f); }
  __syncthreads();
  if (tid < 256) { const int dir = tid >> 7, s = tid & 127; float b = 0.f;
#pragma unroll
    for (int t4 = 0; t4 < 32; ++t4) { const f32x4 v = *(const f32x4*)(lfs + dir * 128 + 4 * t4);
#pragma unroll
      for (int k = 0; k < 4; ++k) { const int t = 4 * t4 + k; const bool in = dir ? (t >= s) : (t <= s); b += in ? v[k] : 0.f; } }
    als[tid] = ipre - b;
    if (dir == 0 && s == 127) red[0] = b;
    if (dir == 1 && s == 0) red[1] = b; }
  __syncthreads();
  if (tid < 256) { const int dir = tid >> 7, s = tid & 127; float mx = als[dir * 128];
#pragma unroll
    for (int t4 = 0; t4 < 32; ++t4) { const f32x4 v = *(const f32x4*)(als + dir * 128 + 4 * t4); mx = fmaxf(fmaxf(mx, fmaxf(v[0], v[1])), fmaxf(v[2], v[3])); }
    wss[tid] = __expf(als[tid] - mx);
    if (s == 0) { stS[(size_t)(item * 2 + dir) * 4 + 0] = red[dir]; stS[(size_t)(item * 2 + dir) * 4 + 1] = mx; } }
  __syncthreads();
#pragma unroll
  for (int it = 0; it < 2; ++it) { const int idx = tid + NTHR * it, s = idx & 127, c = idx >> 7;
    const bf16_t* rp = proj + (m0 + s) * NPROJ + hh * 64 + c * 8;
    const u32x4 kc = *(const u32x4*)(rp + C_KM), vc = *(const u32x4*)(rp + C_VM);
    const float w0 = wss[s] * 0.125f, w1 = wss[128 + s] * 0.125f;
#pragma unroll
    for (int k = 0; k < 4; ++k) {
      const float ka = bflo(kc[k]), kb = bfhi(kc[k]);
      Kw[(8 * c + 2 * k) * ML_T + s] = f2bf(ka * w0); Kw[(8 * c + 2 * k + 1) * ML_T + s] = f2bf(kb * w0);
      Kw[64 * ML_T + (8 * c + 2 * k) * ML_T + s] = f2bf(ka * w1); Kw[64 * ML_T + (8 * c + 2 * k + 1) * ML_T + s] = f2bf(kb * w1);
      Vt[(8 * c + 2 * k) * ML_T + s] = (bf16_t)(vc[k] & 0xffffu); Vt[(8 * c + 2 * k + 1) * ML_T + s] = (bf16_t)(vc[k] >> 16);
    } }
  __syncthreads();
  { const int dir = wid >> 2, kb = (wid >> 1) & 1, vb = wid & 1;
    f32x16 acc = f32x16{};
    const bf16_t* ap = Kw + dir * 64 * ML_T + (kb * 32 + r32) * ML_T + hi * 8; const bf16_t* bp = Vt + (vb * 32 + r32) * ML_T + hi * 8;
#pragma unroll
    for (int ks = 0; ks < 8; ++ks) acc = MFMA32(*(const bf16x8*)(ap + ks * 16), *(const bf16x8*)(bp + ks * 16), acc);
    float* up = stU + (size_t)(item * 2 + dir) * 4096 + vb * 32 + r32;
#pragma unroll
    for (int r = 0; r < 16; ++r) up[(kb * 32 + crow(r, hi)) * 64] = acc[r]; }
  if (tid < 128) { const int dir = tid >> 6, kd = tid & 63; const bf16_t* kp = Kw + dir * 64 * ML_T + kd * ML_T; float s = 0.f;
#pragma unroll
    for (int t8 = 0; t8 < 16; ++t8) { const u32x4 v = *(const u32x4*)(kp + t8 * 8);
#pragma unroll
      for (int k = 0; k < 4; ++k) s += bflo(v[k]) + bfhi(v[k]); }
    stN[(size_t)(item * 2 + dir) * 64 + kd] = s; }
  __syncthreads();
}

template <int EPT, int GS>
__device__ void mlstm_pass2(int ch, int part, int NC, float* __restrict__ stU, float* __restrict__ stN, float* __restrict__ stS) {
  const int tid = otid(); const int b = ch >> 3, hh = (ch >> 1) & 3, dir = ch & 1;
  const int e0 = part * (NTHR * EPT) + tid;
  const bool own_n = (part == 0) && (tid < 64);
  float sv[EPT], nv = 0.f, m = 0.f;
#pragma unroll
  for (int i = 0; i < EPT; ++i) sv[i] = 0.f;
  for (int st0 = 0; st0 < NC; st0 += GS) {
    float uu[GS][EPT], un[GS], bs[GS], ml[GS];
#pragma unroll
    for (int q = 0; q < GS; ++q) {
      const int step = st0 + q, c = dir ? (NC - 1 - step) : step;
      const size_t base = (size_t)(((b * NC + c) * 4 + hh) * 2 + dir);
      bs[q] = stS[base * 4 + 0]; ml[q] = stS[base * 4 + 1];
#pragma unroll
      for (int i = 0; i < EPT; ++i) uu[q][i] = stU[base * 4096 + e0 + NTHR * i];
      un[q] = own_n ? stN[base * 64 + tid] : 0.f;
    }
#pragma unroll
    for (int q = 0; q < GS; ++q) {
      const int step = st0 + q, c = dir ? (NC - 1 - step) : step;
      const size_t base = (size_t)(((b * NC + c) * 4 + hh) * 2 + dir);
      const float mnew = bs[q] + fmaxf(m, ml[q]);
      const float decay = __expf(m + bs[q] - mnew), uf = __expf(ml[q] + bs[q] - mnew);
#pragma unroll
      for (int i = 0; i < EPT; ++i) { stU[base * 4096 + e0 + NTHR * i] = sv[i]; sv[i] = decay * sv[i] + uf * uu[q][i]; }
      if (own_n) { stN[base * 64 + tid] = nv; nv = decay * nv + uf * un[q]; }
      if (part == 0 && tid == 0) stS[base * 4 + 2] = m;
      m = mnew;
    }
  }
}

__device__ void mlstm_pass3(int cgi, int hh, const bf16_t* __restrict__ proj, const float* __restrict__ gates, const float* __restrict__ gbias,
                            const float* __restrict__ norm_g, const float* __restrict__ stU, const float* __restrict__ stN, const float* __restrict__ stS,
                            bf16_t* __restrict__ Y, char* smem) {
  const int tid = otid(), lane = tid & 63, wid = tid >> 6, r32 = lane & 31, hi = lane >> 5;
  bf16_t* Kr = (bf16_t*)smem; bf16_t* Qr = Kr + 128 * ML_R; bf16_t* Vt = Qr + 128 * ML_R; bf16_t* Qf = Vt + 64 * ML_T;
  bf16_t* St = Qf + 2 * 128 * ML_R;
  float* H = (float*)(St + 2 * 64 * ML_R);
  float* sc = H + 128 * 64; float* lfs = sc; float* als = sc + 256; float* bbs = sc + 512; float* Mls = sc + 768; float* ffs = sc + 1024; float* dqs = sc + 1280;
  float* nss = sc + 1536;   float* invs = sc + 1664;
  const int item = cgi * 4 + hh; const size_t m0 = (size_t)cgi * 128;
  float ipre = 0.f;
  if (tid < 256) { const int dir = tid >> 7, s = tid & 127; const float* gp = gates + (m0 + s) * 16;
    ipre = gp[(2 * dir) * 4 + hh] + gbias[(2 * dir) * 4 + hh];
    const float f = gp[(2 * dir + 1) * 4 + hh] + gbias[(2 * dir + 1) * 4 + hh];
    lfs[tid] = logsigmoidf(f); }
  __syncthreads();
  if (tid < 256) { const int dir = tid >> 7, s = tid & 127; float b = 0.f;
#pragma unroll
    for (int t4 = 0; t4 < 32; ++t4) { const f32x4 v = *(const f32x4*)(lfs + dir * 128 + 4 * t4);
#pragma unroll
      for (int k = 0; k < 4; ++k) { const int t = 4 * t4 + k; const bool in = dir ? (t >= s) : (t <= s); b += in ? v[k] : 0.f; } }
    als[tid] = ipre - b; bbs[tid] = b; }
  else if (tid < 384) { const int dir = (tid - 256) >> 6, kd = tid & 63; nss[dir * 64 + kd] = stN[(size_t)(item * 2 + dir) * 64 + kd]; }
  __syncthreads();
  if (tid < 256) { const int dir = tid >> 7, s = tid & 127; const float mst = stS[(size_t)(item * 2 + dir) * 4 + 2]; float mx = mst;
#pragma unroll
    for (int t4 = 0; t4 < 32; ++t4) { const f32x4 v = *(const f32x4*)(als + dir * 128 + 4 * t4);
#pragma unroll
      for (int k = 0; k < 4; ++k) { const int t = 4 * t4 + k; const bool in = dir ? (t >= s) : (t <= s); mx = fmaxf(mx, in ? v[k] : -3.0e38f); } }
    Mls[tid] = mx; ffs[tid] = __expf(mst - mx); }
  __syncthreads();
#pragma unroll
  for (int it = 0; it < 2; ++it) {
    { const int idx = tid + NTHR * it, s = idx >> 3, c = idx & 7;
      const bf16_t* rp = proj + (m0 + s) * NPROJ + hh * 64 + c * 8;
      const u32x4 kc = *(const u32x4*)(rp + C_KM), qc = *(const u32x4*)(rp + C_QM);
      *(u32x4*)(Kr + s * ML_R + c * 8) = kc; *(u32x4*)(Qr + s * ML_R + c * 8) = qc;
      const float f0 = ffs[s], f1 = ffs[128 + s]; u32x4 q0, q1;
#pragma unroll
      for (int k = 0; k < 4; ++k) { const float a = bflo(qc[k]), b2 = bfhi(qc[k]); q0[k] = pk2(a * f0, b2 * f0); q1[k] = pk2(a * f1, b2 * f1); }
      *(u32x4*)(Qf + s * ML_R + c * 8) = q0; *(u32x4*)(Qf + 128 * ML_R + s * ML_R + c * 8) = q1; }
    { const int idx = tid + NTHR * it, s = idx & 127, c = idx >> 7;
      const u32x4 vc = *(const u32x4*)(proj + (m0 + s) * NPROJ + C_VM + hh * 64 + c * 8);
#pragma unroll
      for (int k = 0; k < 4; ++k) { Vt[(8 * c + 2 * k) * ML_T + s] = (bf16_t)(vc[k] & 0xffffu); Vt[(8 * c + 2 * k + 1) * ML_T + s] = (bf16_t)(vc[k] >> 16); } }
  }
#pragma unroll
  for (int dir = 0; dir < 2; ++dir) { const float* sp = stU + (size_t)(item * 2 + dir) * 4096;
#pragma unroll
    for (int it = 0; it < 8; ++it) { const int idx = tid + NTHR * it, d = idx >> 6, e = idx & 63; St[dir * 64 * ML_R + e * ML_R + d] = f2bf(sp[idx]); } }
  __syncthreads();
  if (tid < 256) { const int dir = tid >> 7, j = tid & 127; const bf16_t* qp = Qr + j * ML_R; float s = 0.f;
#pragma unroll
    for (int d8 = 0; d8 < 8; ++d8) { const u32x4 qv = *(const u32x4*)(qp + d8 * 8); const f32x4 n0 = *(const f32x4*)(nss + dir * 64 + d8 * 8), n1 = *(const f32x4*)(nss + dir * 64 + d8 * 8 + 4);
      s += bflo(qv[0]) * n0[0] + bfhi(qv[0]) * n0[1] + bflo(qv[1]) * n0[2] + bfhi(qv[1]) * n0[3] + bflo(qv[2]) * n1[0] + bfhi(qv[2]) * n1[1] + bflo(qv[3]) * n1[2] + bfhi(qv[3]) * n1[3]; }
    dqs[tid] = s * ffs[tid]; }
  __syncthreads();
  f32x16 o[2]; o[0] = f32x16{}; o[1] = f32x16{};
  const int dir = wid >> 2, jb = wid & 3;
  {
    const int jrow = 32 * jb + r32; const float Mj = Mls[dir * 128 + jrow]; float den = 0.f;
    const int st_lo = dir ? jb : 0, st_hi = dir ? 3 : jb;
    for (int st = st_lo; st <= st_hi; ++st) {
      f32x16 sc2 = f32x16{};
      const bf16_t* ap = Kr + (32 * st + r32) * ML_R + hi * 8; const bf16_t* bp = Qr + jrow * ML_R + hi * 8;
#pragma unroll
      for (int kk = 0; kk < 4; ++kk) sc2 = MFMA32(*(const bf16x8*)(ap + kk * 16), *(const bf16x8*)(bp + kk * 16), sc2);
      float pv[16];
#pragma unroll
      for (int r = 0; r < 16; ++r) { const int s = 32 * st + crow(r, hi); const bool valid = dir ? (s >= jrow) : (s <= jrow);
        const float x = fminf(als[dir * 128 + s] - Mj, 0.f); const float w = valid ? 0.125f * __expf(x) : 0.f;
        pv[r] = sc2[r] * w; den += pv[r]; }
      bf16x8 pa0, pa1; PK4(pv, 0, pa0); PK4(pv, 8, pa1);
#pragma unroll
      for (int d0 = 0; d0 < 2; ++d0) { const bf16_t* vp = Vt + (32 * d0 + r32) * ML_T + 32 * st + hi * 8;
        o[d0] = MFMA32(pa0, *(const bf16x8*)(vp), o[d0]); o[d0] = MFMA32(pa1, *(const bf16x8*)(vp + 16), o[d0]); }
    }
    { const bf16_t* ap = Qf + dir * 128 * ML_R + jrow * ML_R + hi * 8;
#pragma unroll
      for (int kk = 0; kk < 4; ++kk) { const bf16x8 a = *(const bf16x8*)(ap + kk * 16);
#pragma unroll
        for (int d0 = 0; d0 < 2; ++d0) o[d0] = MFMA32(a, *(const bf16x8*)(St + dir * 64 * ML_R + (32 * d0 + r32) * ML_R + kk * 16 + hi * 8), o[d0]); } }
    den += __shfl_xor(den, 32);
    den += dqs[dir * 128 + jrow];
    const float flo = __expf(-(bbs[dir * 128 + jrow] + Mj));
    const float inv = __builtin_amdgcn_rcpf(fmaxf(fabsf(den), flo));
    if (hi == 0) invs[wid * 32 + r32] = inv;
    asm volatile("s_waitcnt lgkmcnt(0)" ::: "memory");
  }
  if (dir == 0) {
#pragma unroll
    for (int r = 0; r < 16; ++r) { const int jr = crow(r, hi); const float iv = invs[wid * 32 + jr];
      H[(32 * jb + jr) * 64 + r32] = o[0][r] * iv; H[(32 * jb + jr) * 64 + 32 + r32] = o[1][r] * iv; }
  }
  __syncthreads();
  if (dir == 1) {
#pragma unroll
    for (int r = 0; r < 16; ++r) { const int jr = crow(r, hi); const float iv = invs[wid * 32 + jr];
      H[(32 * jb + jr) * 64 + r32] += o[0][r] * iv; H[(32 * jb + jr) * 64 + 32 + r32] += o[1][r] * iv; }
  }
  __syncthreads();
  { const int j = tid >> 2, qd = tid & 3; float hv[16]; float s = 0.f;
#pragma unroll
    for (int e = 0; e < 16; ++e) { hv[e] = H[j * 64 + qd * 16 + e]; s += hv[e]; }
    s += __shfl_xor(s, 1); s += __shfl_xor(s, 2);
    const float mu = s * (1.f / 64.f); float q = 0.f;
#pragma unroll
    for (int e = 0; e < 16; ++e) { const float d = hv[e] - mu; q += d * d; }
    q += __shfl_xor(q, 1); q += __shfl_xor(q, 2);
    const float rstd = rsqrtf(q * (1.f / 64.f) + LN_EPS);
    const bf16_t* op = proj + (m0 + j) * NPROJ + C_OM + hh * 64 + qd * 16;
    const u32x4 oa = *(const u32x4*)op, ob = *(const u32x4*)(op + 8);
    const float* ng = norm_g + hh * 64 + qd * 16;
    float y[16];
#pragma unroll
    for (int k = 0; k < 4; ++k) {
      const float g0 = bflo(oa[k]), g1 = bfhi(oa[k]), g2 = bflo(ob[k]), g3 = bfhi(ob[k]);
      y[2 * k] = (hv[2 * k] - mu) * rstd * ng[2 * k] * __builtin_amdgcn_rcpf(1.f + __builtin_amdgcn_exp2f(-1.4426950408889634f * g0));
      y[2 * k + 1] = (hv[2 * k + 1] - mu) * rstd * ng[2 * k + 1] * __builtin_amdgcn_rcpf(1.f + __builtin_amdgcn_exp2f(-1.4426950408889634f * g1));
      y[8 + 2 * k] = (hv[8 + 2 * k] - mu) * rstd * ng[8 + 2 * k] * __builtin_amdgcn_rcpf(1.f + __builtin_amdgcn_exp2f(-1.4426950408889634f * g2));
      y[8 + 2 * k + 1] = (hv[8 + 2 * k + 1] - mu) * rstd * ng[8 + 2 * k + 1] * __builtin_amdgcn_rcpf(1.f + __builtin_amdgcn_exp2f(-1.4426950408889634f * g3));
    }
    u32x4 w0 = {pk2(y[0], y[1]), pk2(y[2], y[3]), pk2(y[4], y[5]), pk2(y[6], y[7])}, w1 = {pk2(y[8], y[9]), pk2(y[10], y[11]), pk2(y[12], y[13]), pk2(y[14], y[15])};
    bf16_t* yp = Y + (m0 + j) * 1024 + 768 + hh * 64 + qd * 16;
    *(u32x4*)yp = w0; *(u32x4*)(yp + 8) = w1; }
  __syncthreads();
}

__device__ __forceinline__ bool tile_order(int i, int G, int c, int nM, int nN, int& pm, int& pn) {
  const int nwg = nM * nN; const long L = (long)i * G + c; if (L >= nwg) return false;
  int wgid = (int)L; { const int q = nwg / 8, r = nwg % 8, xcd = wgid % 8, off = wgid / 8; wgid = (xcd < r ? xcd * (q + 1) : r * (q + 1) + (xcd - r) * q) + off; }
  const int nig = 8 * nN, gid = wgid / nig, fm = gid * 8, gsz = (nM - fm) < 8 ? (nM - fm) : 8;
  pm = fm + ((wgid % nig) % gsz); pn = (wgid % nig) / gsz; return true;
}

#define XB_TMO      128
#define XB_XCNT(j)  (256  + 64 * (j))
#define XB_XSUB(j)  (1280 + 64 * (j))
#define XB_XGEN(j)  (2304 + 64 * (j))
#define XB_TOP      3328
#define XB_TOPGEN   3392
#define XCD_BAR_WORDS 3456
#define XB_SPIN_CAP (1u << 18)
#define LAS __attribute__((address_space(3)))

__device__ __forceinline__ unsigned xb_ld(unsigned* p)              { return __hip_atomic_load(p, __ATOMIC_RELAXED, __HIP_MEMORY_SCOPE_AGENT); }
__device__ __forceinline__ unsigned xb_add(unsigned* p, unsigned v) { return __hip_atomic_fetch_add(p, v, __ATOMIC_RELAXED, __HIP_MEMORY_SCOPE_AGENT); }
__device__ __forceinline__ unsigned xb_xcc_id() { return (unsigned)__builtin_amdgcn_s_getreg((3 << 11) | 20) & 0xFu; }
#define XB_SPIN(cond, bar) do { unsigned _sp = 0; while (cond) { __builtin_amdgcn_s_sleep(1); \
    if ((++_sp & 255u) == 0u) { if (xb_ld(&(bar)[XB_TMO])) break; if (_sp > XB_SPIN_CAP) { atomicAdd(&(bar)[XB_TMO], 1u); break; } } } } while (0)

struct XcdBarrier {
    unsigned* bar; unsigned x;
    volatile LAS unsigned* st;
};

__device__ __forceinline__ XcdBarrier xcd_barrier_post(unsigned* bar, volatile LAS unsigned* st) {
    XcdBarrier b; b.bar = bar; b.x = xb_xcc_id(); b.st = st;
    if (threadIdx.x == 0) (void)xb_add(&bar[XB_XCNT(b.x)], 1u);
    return b;
}
__device__ __forceinline__ void xcd_barrier_complete(unsigned* bar, unsigned x, unsigned& nloc, unsigned& nx) {
    const unsigned G = gridDim.x * gridDim.y * gridDim.z;
    unsigned sum, cnt, mine, sp = 0u;
    for (;;) {
        sum = 0u; cnt = 0u; mine = 0u;
#pragma unroll
        for (unsigned j = 0; j < 16; ++j) { const unsigned c = xb_ld(&bar[XB_XCNT(j)]); sum += c; cnt += (c > 0u) ? 1u : 0u; mine = (j == x) ? c : mine; }
        if (sum == G) break;
        __builtin_amdgcn_s_sleep(1);
        if ((++sp & 255u) == 0u) { if (xb_ld(&bar[XB_TMO])) break; if (sp > XB_SPIN_CAP) { atomicAdd(&bar[XB_TMO], 1u); break; } }
    }
    nloc = mine > 0u ? mine : 1u; nx = cnt > 0u ? cnt : 1u;
}

__device__ __forceinline__ void xcd_barrier(const XcdBarrier& b) {
    asm volatile("s_waitcnt vmcnt(0)" ::: "memory");
    __syncthreads();
    if (threadIdx.x == 0) {
        unsigned* bar = b.bar;
        __builtin_amdgcn_s_waitcnt(0);
        unsigned nloc = b.st[0], nx = b.st[1];
        if (nloc == 0u) { xcd_barrier_complete(bar, b.x, nloc, nx); b.st[0] = nloc; b.st[1] = nx; }
        const unsigned old = xb_add(&bar[XB_XSUB(b.x)], 1u);
        const unsigned gen = old / nloc;
        if (old + 1u == (gen + 1u) * nloc) {
            __builtin_amdgcn_fence(__ATOMIC_RELEASE, "agent");
            asm volatile("s_waitcnt vmcnt(0)" ::: "memory");
            const unsigned og = xb_add(&bar[XB_TOP], 1u);
            const unsigned tg = og / nx;
            if (og + 1u == (tg + 1u) * nx) xb_add(&bar[XB_TOPGEN], 1u);
            else XB_SPIN(xb_ld(&bar[XB_TOPGEN]) == tg, bar);
            __builtin_amdgcn_fence(__ATOMIC_ACQUIRE, "agent");
            xb_add(&bar[XB_XGEN(b.x)], 1u);
            asm volatile("s_waitcnt vmcnt(0)" ::: "memory");
        } else {
            XB_SPIN(xb_ld(&bar[XB_XGEN(b.x)]) == gen, bar);
            __builtin_amdgcn_fence(__ATOMIC_ACQUIRE, "agent");
            asm volatile("s_waitcnt vmcnt(0)" ::: "memory");
        }
    }
    __syncthreads();
}

constexpr int PH_PER_TRUNK = 1 + 8 * DEPTH, N_PHASES = 1 + 2 * PH_PER_TRUNK;

__device__ void run_phase(const Params& p, int ph, char* smem) {
  if (ph == 0) { if (blockIdx.x == 0) { const int t0 = otid();
      ((unsigned*)(p.ws + OFF_CNT))[t0] = 0u; ((unsigned*)(p.ws + OFF_CNT))[t0 + NTHR] = 0u;
      float* idv = (float*)(p.ws + OFF_ID); idv[t0] = 1.f; idv[t0 + NTHR] = 1.f; idv[1024 + t0] = 0.f; idv[1024 + t0 + NTHR] = 0.f; }
    phase_prep(p, smem); return; }
  const int tr = (ph - 1) / PH_PER_TRUNK, q = (ph - 1) % PH_PER_TRUNK;
  const int S = tr ? 2048 : 16384, slog = tr ? 11 : 14, nseq = tr ? 16 : 2;
  float* x32 = p.out + (size_t)tr * MT * 1024;
  unsigned char* ws = p.ws;
  bf16_t* XB = (bf16_t*)(ws + OFF_XB); bf16_t* Y = (bf16_t*)(ws + OFF_Y); bf16_t* PROJ = (bf16_t*)(ws + OFF_PROJ);
  bf16_t* Qb = (bf16_t*)(ws + OFF_Q); bf16_t* KN = (bf16_t*)(ws + OFF_KN); bf16_t* VT = (bf16_t*)(ws + OFF_VT); bf16_t* KR = (bf16_t*)(ws + OFF_KR);
  float* GATES = (float*)(ws + OFF_GATES); float* STU = (float*)(ws + OFF_STU); float* STN = (float*)(ws + OFF_STN); float* STS = (float*)(ws + OFF_STS);
  bf16_t* HID = (bf16_t*)(ws + OFF_HID); const f32x2* ROPE = (const f32x2*)(ws + OFF_ROPE);
  f32x2* STAT = (f32x2*)(ws + OFF_STAT); const float* IDV = (const float*)(ws + OFF_ID);
  if (q == 0) { phase_ln(p.in[tr], x32, XB, p.in[2], p.in[3], MT, STAT, true); return; }
  const int l = (q - 1) / 8, sub = (q - 1) % 8;
  const unsigned char* wl = ws + OFF_W + (size_t)l * W_LAYER;
  const int G = gridDim.x, B = blockIdx.x;
#ifdef ONLY_SUB
  switch (ONLY_SUB) {
#else
  switch (sub) {
#endif
    case 0: {
      pg8::Gemm g{XB, (const bf16_t*)(wl + W_IN), MT, NPROJ, 1024, 1024}; pg8::StaticOrder So; So.init(MT, NPROJ, G, B);
      pg8::EpiInProj2 E{PROJ, GATES};
      pg8::gemm_phase<pg8::EpiInProj2, pg8::StaticOrder, true, true>((PG8_LAS unsigned char*)smem, g, So, E);
    } break;
    case 1: {
      float* rs = (float*)(smem + G_SMEM_BYTES);
      for (int rep1 = 0; rep1 < REP_P1; ++rep1) {
      for (int i = 0, pm, pn; tile_order(i, G, B, 128, 3, pm, pn); ++i) {
        row_rms(PROJ + C_CQ, NPROJ, 256, pm * 256, rs); EpiQUp E{Qb, rs, ROPE, S - 1, smem};
        gemm_tile(PROJ + C_CQ, NPROJ, (const bf16_t*)(wl + W_UQ), 256, pm * 256, pn * 256, smem, E);
        __syncthreads();
      }
      for (int i = 0, pm, pn; tile_order(i, G, B, 128, 4, pm, pn); ++i) {
        row_rms(PROJ + C_CKV, NPROJ, 128, pm * 256, rs); EpiKVUp E{KN, VT, rs, S, slog, S - 1, smem};
        gemm_tile(PROJ + C_CKV, NPROJ, (const bf16_t*)(wl + W_UKV), 128, pm * 256, pn * 256, smem, E);
        __syncthreads();
      }
      phase_pool_rope(PROJ, Y, KR, ROPE, S);
      for (int t = B; t < 256 * 4; t += G) mlstm_pass1(t >> 2, t & 3, PROJ, GATES, p.in[11] + l * 16, STU, STN, STS, smem);
      }
    } break;
    case 2: {
      unsigned* cnt = (unsigned*)(ws + OFF_CNT) + (tr * DEPTH + l) * 64;
      if (B < 128) {
        if (tr == 0) mlstm_pass2<1, 32>(B >> 3, B & 7, S >> 7, STU, STN, STS); else mlstm_pass2<8, 4>(B, 0, S >> 7, STU, STN, STS);
        __builtin_amdgcn_fence(__ATOMIC_RELEASE, "agent");
        asm volatile("s_waitcnt vmcnt(0)" ::: "memory");
        __syncthreads();
        if (threadIdx.x == 0) __hip_atomic_fetch_add(cnt, 1u, __ATOMIC_RELEASE, __HIP_MEMORY_SCOPE_AGENT);
      }
      const int nqb = S >> 8;
      for (int t0 = B; t0 < 1024; t0 += G) { const int t = (G == 256) ? (t0 & ~255) + (B & 7) * 32 + (B >> 3) : t0; const int qb = t % nqb, bh = t / nqb; attn_unit(Qb, KN, VT, KR, Y, S, bh >> 3, bh & 7, qb, smem); }
      if (threadIdx.x == 0) { while (__hip_atomic_load(cnt, __ATOMIC_ACQUIRE, __HIP_MEMORY_SCOPE_AGENT) < 128u) __builtin_amdgcn_s_sleep(2); }
      __syncthreads();
      __builtin_amdgcn_fence(__ATOMIC_ACQUIRE, "agent");
      asm volatile("s_waitcnt vmcnt(0)" ::: "memory");
      for (int t = B; t < 256 * 4; t += G) mlstm_pass3(t >> 2, t & 3, PROJ, GATES, p.in[11] + l * 16, p.in[12] + l * 256, STU, STN, STS, Y, smem);
    } break;
    case 3: {
      pg8::Gemm g{Y, (const bf16_t*)(wl + W_OUT), MT, 1024, 1024, 1024}; pg8::StaticOrder So; So.init(MT, 1024, G, B);
      pg8::EpiResid2 E{x32, STAT, l ? p.in[19] + (l - 1) * 1024 : IDV, l ? p.in[20] + (l - 1) * 1024 : IDV + 1024};
      pg8::gemm_phase<pg8::EpiResid2, pg8::StaticOrder, true, true>((PG8_LAS unsigned char*)smem, g, So, E);
    } break;
    case 4: phase_ln(x32, nullptr, XB, p.in[14] + l * 1024, p.in[15] + l * 1024, MT, STAT, false); break;
    case 5: {
      pg8::Gemm g{XB, (const bf16_t*)(wl + W_GU), MT, NGU, 1024, 1024}; pg8::StaticOrder So; So.init(MT, NGU, G, B);
      pg8::EpiGU2 E{HID};
      pg8::gemm_phase<pg8::EpiGU2, pg8::StaticOrder, true, true>((PG8_LAS unsigned char*)smem, g, So, E);
    } break;
    case 6: {
      pg8::Gemm g{HID, (const bf16_t*)(wl + W_DN), MT, 1024, DFF, DFF}; pg8::StaticOrder So; So.init(MT, 1024, G, B);
      pg8::EpiResid2 E{x32, STAT, p.in[14] + l * 1024, p.in[15] + l * 1024};
      pg8::gemm_phase<pg8::EpiResid2, pg8::StaticOrder, true, true>((PG8_LAS unsigned char*)smem, g, So, E);
    } break;
    case 7: phase_ln(x32, (l == DEPTH - 1) ? x32 : nullptr, XB, p.in[19] + l * 1024, p.in[20] + l * 1024, MT, STAT, false); break;
  }
}

__global__ void __launch_bounds__(NTHR) fwd_kernel(Params p) {
  extern __shared__ __attribute__((aligned(16))) char smem[];
  cg::grid_group grid = cg::this_grid();
  volatile LAS unsigned* st = (volatile LAS unsigned*)((LAS unsigned char*)smem + (LDS_BYTES - 16));
  if (threadIdx.x < 2) st[threadIdx.x] = 0u;
  __syncthreads();
  XcdBarrier xb = xcd_barrier_post((unsigned*)(p.ws + OFF_XBAR), st);
  for (int ph = p.ph_lo; ph < p.ph_hi; ++ph) {
    run_phase(p, ph, smem);
    if (ph + 1 < p.ph_hi) {
      if (ph == p.ph_lo) grid.sync();
      else xcd_barrier(xb);
    }
  }
}

extern "C" void kernel_launch(void* const* d_in, const int* in_sizes, int n_in, void* d_out, int out_size, void* d_ws, size_t ws_size, hipStream_t stream) {
  static int grid_blocks = 0;
  if (!grid_blocks) {
    int dev = 0, cus = 0, per_cu = 0;
    hipGetDevice(&dev);
    hipDeviceGetAttribute(&cus, hipDeviceAttributeMultiprocessorCount, dev);
    hipFuncSetAttribute((const void*)fwd_kernel, hipFuncAttributeMaxDynamicSharedMemorySize, LDS_BYTES);
    hipOccupancyMaxActiveBlocksPerMultiprocessor(&per_cu, (const void*)fwd_kernel, NTHR, LDS_BYTES);
    if (per_cu < 1) per_cu = 1;
    grid_blocks = cus * per_cu;
    if (ws_size < OFF_END) fprintf(stderr, "kernel_launch: workspace too small (%zu < %zu)\n", ws_size, (size_t)OFF_END);
  }
  Params p{};
  for (int i = 0; i < 21; ++i) p.in[i] = (const float*)d_in[i];
  p.out = (float*)d_out; p.ws = (unsigned char*)d_ws;
#if ONE_LAUNCH
  p.ph_lo = 0; p.ph_hi = N_PHASES;
  (void)hipMemsetAsync((char*)d_ws + OFF_XBAR, 0, XCD_BAR_WORDS * 4, stream);
  void* args[] = {&p};
  hipError_t e = hipLaunchCooperativeKernel((const void*)fwd_kernel, dim3(grid_blocks), dim3(NTHR), args, LDS_BYTES, stream);
  if (e != hipSuccess) fprintf(stderr, "cooperative launch failed: %s (grid %d)\n", hipGetErrorString(e), grid_blocks);
#else
  for (int ph = 0; ph < N_PHASES; ++ph) { p.ph_lo = ph; p.ph_hi = ph + 1; hipLaunchKernelGGL(fwd_kernel, dim3(grid_blocks), dim3(NTHR), LDS_BYTES, stream, p); }
#endif
}
```

```cpp
#include <hip/hip_runtime.h>
#include <hip/hip_cooperative_groups.h>
#include <stdint.h>
#include <stdio.h>
namespace cg = cooperative_groups;

#ifndef REP_P1
#define REP_P1 1
#endif
#ifndef REP_P3
#define REP_P3 1
#endif
#ifndef REP_LN
#define REP_LN 1
#endif
#ifndef ONE_LAUNCH
#define ONE_LAUNCH 1
#endif

typedef unsigned short bf16_t;
typedef short bf16x8 __attribute__((ext_vector_type(8)));
typedef float f32x16 __attribute__((ext_vector_type(16)));
typedef float f32x4 __attribute__((ext_vector_type(4)));
typedef float f32x2 __attribute__((ext_vector_type(2)));
typedef unsigned u32x4 __attribute__((ext_vector_type(4)));
typedef unsigned u32x2 __attribute__((ext_vector_type(2)));
typedef __bf16 bf16x2_t __attribute__((ext_vector_type(2)));

constexpr int DM = 1024, DEPTH = 4, MT = 32768;
constexpr int NPROJ = 1792, INW = 1712, DFF = 2816, NGU = 5632;
constexpr int C_CQ = 0, C_CKV = 256, C_KR = 384, C_POOL = 416, C_QM = 672, C_KM = 928, C_VM = 1184, C_OM = 1440, C_G = 1696;
constexpr float LN_EPS = 1e-5f;
constexpr float DN_ALPHA = 1.6817928305074290f;
constexpr float QSCALE = 0.10206207261596577f * 1.4426950408889634f;
constexpr int NTHR = 512;

constexpr size_t MiB = 1u << 20;
constexpr size_t W_IN = 0, W_UQ = W_IN + (size_t)NPROJ * 1024 * 2, W_UKV = W_UQ + 768 * 256 * 2, W_OUT = W_UKV + 1024 * 128 * 2,
                 W_GU = W_OUT + 1024 * 1024 * 2, W_DN = W_GU + (size_t)NGU * 1024 * 2, W_LAYER = W_DN + (size_t)1024 * DFF * 2;
static_assert(W_LAYER * 4 <= 96 * MiB, "weights");
constexpr size_t OFF_W = 0, OFF_ROPE = 96 * MiB, OFF_XB = 98 * MiB, OFF_Y = 162 * MiB, OFF_R = 226 * MiB;
constexpr size_t OFF_PROJ = OFF_R, OFF_Q = OFF_R + 112 * MiB, OFF_KN = OFF_Q + 48 * MiB, OFF_VT = OFF_KN + 32 * MiB, OFF_KR = OFF_VT + 32 * MiB,
                 OFF_GATES = OFF_KR + 2 * MiB, OFF_STU = OFF_GATES + 2 * MiB, OFF_STN = OFF_STU + 32 * MiB, OFF_STS = OFF_STN + 1 * MiB, OFF_END = OFF_STS + 1 * MiB;
constexpr size_t OFF_HID = OFF_R;
constexpr size_t OFF_CNT = OFF_END;
constexpr size_t OFF_XBAR = OFF_END + 4096;
constexpr size_t OFF_STAT = OFF_XBAR + 16384;
constexpr size_t OFF_ID = OFF_STAT + (size_t)MT * 8;
static_assert(OFF_ID + 8192 <= 512 * MiB, "ws");
static_assert(OFF_HID + (size_t)MT * DFF * 2 <= OFF_END, "hid");

constexpr int LDS_BYTES = 151552;

struct Params {
  const float* in[21];
  float* out;
  unsigned char* ws;
  int ph_lo, ph_hi;
};

__device__ __forceinline__ unsigned pk2(float lo, float hi) { f32x2 v = {lo, hi}; bf16x2_t b = __builtin_convertvector(v, bf16x2_t); return __builtin_bit_cast(unsigned, b); }
__device__ __forceinline__ bf16_t f2bf(float x) { return (bf16_t)(pk2(x, 0.f) & 0xffffu); }
__device__ __forceinline__ float bf2f(bf16_t b) { return __uint_as_float(((unsigned)b) << 16); }
__device__ __forceinline__ float bflo(unsigned w) { return __uint_as_float(w << 16); }
__device__ __forceinline__ float bfhi(unsigned w) { return __uint_as_float(w & 0xffff0000u); }
__device__ __forceinline__ int crow(int r, int hi) { return (r & 3) + 8 * (r >> 2) + 4 * hi; }
__device__ __forceinline__ float wave_sum(float v) {
  v += __shfl_xor(v, 32); v += __shfl_xor(v, 16); v += __shfl_xor(v, 8); v += __shfl_xor(v, 4); v += __shfl_xor(v, 2); v += __shfl_xor(v, 1); return v;
}
__device__ __forceinline__ int otid() { int t = threadIdx.x; asm volatile("" : "+v"(t)); return t; }
#define MFMA32(a, b, c) __builtin_amdgcn_mfma_f32_32x32x16_bf16((a), (b), (c), 0, 0, 0)
#define PK4(P, BASE, OUT) do { unsigned a0_ = pk2(P[BASE + 0], P[BASE + 1]), a1_ = pk2(P[BASE + 2], P[BASE + 3]);   \
    unsigned b0_ = pk2(P[BASE + 4], P[BASE + 5]), b1_ = pk2(P[BASE + 6], P[BASE + 7]);                              \
    auto r0_ = __builtin_amdgcn_permlane32_swap(a0_, b0_, false, false); auto r1_ = __builtin_amdgcn_permlane32_swap(a1_, b1_, false, false); \
    u32x4 w_ = {r0_[0], r1_[0], r0_[1], r1_[1]}; OUT = __builtin_bit_cast(bf16x8, w_); } while (0)

__device__ void prep_tile(const float* srcA, int colA, int limA, const float* srcB, int colB, int limB, int ld, int k0,
                          const float* kscale, float mul, bf16_t* dst, int ldd, int n0, float* tile) {
  const int tid = otid();
#pragma unroll
  for (int i = 0; i < 8; ++i) {
    const int kk = (tid >> 6) + 8 * i, nn = tid & 63;
    float v = 0.f;
    if (nn < 32) { const int c = colA + nn; if (c < limA) v = srcA[(size_t)(k0 + kk) * ld + c]; }
    else { const int c = colB + nn - 32; if (c < limB) v = srcB[(size_t)(k0 + kk) * ld + c]; }
    if (kscale) v *= kscale[k0 + kk];
    tile[kk * 65 + nn] = v * mul;
  }
  __syncthreads();
  { const int nn = tid >> 3, kc = tid & 7; u32x4 w;
#pragma unroll
    for (int j = 0; j < 4; ++j) w[j] = pk2(tile[(kc * 8 + 2 * j) * 65 + nn], tile[(kc * 8 + 2 * j + 1) * 65 + nn]);
    *(u32x4*)(dst + (size_t)(n0 + nn) * ldd + k0 + kc * 8) = w; }
  __syncthreads();
}

__device__ void phase_prep(const Params& p, char* smem) {
  float* tile = (float*)smem;
  const int tid = otid();
  constexpr int N_IN = 28 * 16, N_UQ = 12 * 4, N_UKV = 16 * 2, N_OUT = 16 * 12, N_PF = 4 * 16, N_GU = 88 * 16, N_DN = 16 * 44;
  constexpr int PER_LAYER = N_IN + N_UQ + N_UKV + N_OUT + N_PF + N_GU + N_DN;
  constexpr int N_ROPE = 16384 * 16 / NTHR;
  const int total = PER_LAYER * DEPTH + N_ROPE;
  for (int it = blockIdx.x; it < total; it += gridDim.x) {
    if (it >= PER_LAYER * DEPTH) {
      const int e = (it - PER_LAYER * DEPTH) * NTHR + tid, pos = e >> 4, i = e & 15;
      const float inv = exp2f(-(float)i * (13.287712379549449f / 16.0f));
      const float ang = (float)pos * inv;
      double rev = (double)ang * 0.15915494309189535; rev -= floor(rev);
      const float fr = (float)rev;
      f32x2 cs = {__builtin_amdgcn_cosf(fr), __builtin_amdgcn_sinf(fr)};
      ((f32x2*)(p.ws + OFF_ROPE))[e] = cs;
      continue;
    }
    const int l = it / PER_LAYER; int j = it % PER_LAYER;
    unsigned char* wl = p.ws + OFF_W + (size_t)l * W_LAYER;
    if (j < N_IN) { const int nt = j / 16, kt = j % 16; const float* s = p.in[4] + (size_t)l * 1024 * INW;
      prep_tile(s, nt * 64, INW, s, nt * 64 + 32, INW, INW, kt * 64, nullptr, 1.f, (bf16_t*)(wl + W_IN), 1024, nt * 64, tile); continue; }
    j -= N_IN;
    if (j < N_UQ) { const int nt = j / 4, kt = j % 4; const float* s = p.in[6] + (size_t)l * 256 * 768;
      prep_tile(s, nt * 64, 768, s, nt * 64 + 32, 768, 768, kt * 64, p.in[5] + l * 256, QSCALE, (bf16_t*)(wl + W_UQ), 256, nt * 64, tile); continue; }
    j -= N_UQ;
    if (j < N_UKV) { const int nt = j / 2, kt = j % 2; const float* s = p.in[8] + (size_t)l * 128 * 1024;
      prep_tile(s, nt * 64, 1024, s, nt * 64 + 32, 1024, 1024, kt * 64, p.in[7] + l * 128, 1.f, (bf16_t*)(wl + W_UKV), 128, nt * 64, tile); continue; }
    j -= N_UKV;
    if (j < N_OUT) { const int nt = j / 12; int kt = j % 12; if (kt >= 8) kt += 4; const float* s = p.in[13] + (size_t)l * 1024 * 1024;
      prep_tile(s, nt * 64, 1024, s, nt * 64 + 32, 1024, 1024, kt * 64, nullptr, 1.f, (bf16_t*)(wl + W_OUT), 1024, nt * 64, tile); continue; }
    j -= N_OUT;
    if (j < N_PF) {
      const int g = j / 16, n0 = (j % 16) * 64, nn = tid & 63;
      const float* wo = p.in[13] + (size_t)l * 1024 * 1024 + (size_t)(512 + g * 64) * 1024 + n0 + nn;
      const float* wp = p.in[9] + (size_t)l * 4 * 64 * 64 + (size_t)g * 64 * 64;
      const float* ps = p.in[10] + l * 256 + g * 64;
      bf16_t* dst = (bf16_t*)(wl + W_OUT);
      for (int i = 0; i < 8; ++i) {
        const int c = (tid >> 6) + 8 * i; float s = 0.f;
        for (int d = 0; d < 64; ++d) s += wp[c * 64 + d] * ps[d] * wo[(size_t)d * 1024];
        dst[(size_t)(n0 + nn) * 1024 + 512 + g * 64 + c] = f2bf(s);
      }
      continue; }
    j -= N_PF;
    if (j < N_GU) { const int nt = j / 16, kt = j % 16, T = nt >> 2, sb = nt & 3;
      const float* s = ((sb < 2) ? p.in[16] : p.in[17]) + (size_t)l * 1024 * DFF; const int c0 = 128 * T + 64 * (sb & 1);
      prep_tile(s, c0, DFF, s, c0 + 32, DFF, DFF, kt * 64, nullptr, 1.f, (bf16_t*)(wl + W_GU), 1024, nt * 64, tile); continue; }
    j -= N_GU;
    { const int nt = j / 44, kt = j % 44; const float* s = p.in[18] + (size_t)l * DFF * 1024;
      prep_tile(s, nt * 64, 1024, s, nt * 64 + 32, 1024, 1024, kt * 64, nullptr, 1.f, (bf16_t*)(wl + W_DN), DFF, nt * 64, tile); }
  }
}

__device__ void phase_ln(const float* src, float* dst32, bf16_t* dstb, const float* g, const float* bta, int nrows, f32x2* stats, bool ident) {
  const int tid = otid(); const int lane = tid & 63, wid = tid >> 6;
  f32x4 gv[4], bv[4];
#pragma unroll
  for (int j = 0; j < 4; ++j) { gv[j] = *(const f32x4*)(g + j * 256 + lane * 4); bv[j] = *(const f32x4*)(bta + j * 256 + lane * 4); }
  const int rstride = gridDim.x * 8;
  for (int row0 = blockIdx.x * 8 + wid; row0 < nrows; row0 += 2 * rstride) {
    f32x4 v[2][4];
    const bool two = (row0 + rstride) < nrows;
#pragma unroll
    for (int j = 0; j < 4; ++j) v[0][j] = *(const f32x4*)(src + (size_t)row0 * 1024 + j * 256 + lane * 4);
    if (two) {
#pragma unroll
      for (int j = 0; j < 4; ++j) v[1][j] = *(const f32x4*)(src + (size_t)(row0 + rstride) * 1024 + j * 256 + lane * 4);
    }
#pragma unroll
    for (int u = 0; u < 2; ++u) {
      if (u == 1 && !two) break;
      const int row = row0 + u * rstride;
      float s = 0.f;
#pragma unroll
      for (int j = 0; j < 4; ++j) s += (v[u][j][0] + v[u][j][1]) + (v[u][j][2] + v[u][j][3]);
      const float mean = wave_sum(s) * (1.f / 1024.f);
      float q = 0.f;
#pragma unroll
      for (int j = 0; j < 4; ++j) { f32x4 d = v[u][j] - mean; q += (d[0] * d[0] + d[1] * d[1]) + (d[2] * d[2] + d[3] * d[3]); }
      const float rstd = rsqrtf(wave_sum(q) * (1.f / 1024.f) + LN_EPS);
      if (lane == 0) { f32x2 sv = {ident ? 0.f : mean, ident ? 1.f : rstd}; stats[row] = sv; }
#pragma unroll
      for (int j = 0; j < 4; ++j) {
        f32x4 o = (v[u][j] - mean) * rstd * gv[j] + bv[j];
        if (dst32) *(f32x4*)(dst32 + (size_t)row * 1024 + j * 256 + lane * 4) = o;
        u32x2 w = {pk2(o[0], o[1]), pk2(o[2], o[3])};
        *(u32x2*)(dstb + (size_t)row * 1024 + j * 256 + lane * 4) = w;
      }
    }
  }
}

constexpr int G_BUF = 256 * 64;
constexpr int G_SMEM_BYTES = 4 * G_BUF * 2;
#define LAS3 __attribute__((address_space(3)))

template <class Epi>
__device__ __forceinline__ void gemm_tile(const bf16_t* __restrict__ A, int lda, const bf16_t* __restrict__ Bt, int K, int m0, int n0, char* smem, const Epi& epi) {
  const int tid = otid(), lane = tid & 63, wid = tid >> 6, wm = wid >> 2, wn = wid & 3, r32 = lane & 31, hi = lane >> 5;
  LAS3 unsigned char* lds = (LAS3 unsigned char*)smem;
  const int rowl = wid * 8 + (lane >> 3), gch = (lane & 7) ^ ((rowl >> 1) & 7);
  const bf16_t* pa = A + (size_t)(m0 + rowl) * lda + gch * 8;
  const bf16_t* pb = Bt + (size_t)(n0 + rowl) * K + gch * 8;
  const size_t sa = (size_t)64 * lda, sb = (size_t)64 * K;
  const unsigned wbase = (unsigned)__builtin_amdgcn_readfirstlane(wid * 1024);
#define G_DMA(buf, k0) do { _Pragma("unroll") for (int j_ = 0; j_ < 4; ++j_) { \
    __builtin_amdgcn_global_load_lds((const unsigned*)(pa + j_ * sa + (k0)), (LAS3 unsigned*)(lds + (buf) * 32768 + j_ * 8192 + wbase), 16, 0, 0); \
    __builtin_amdgcn_global_load_lds((const unsigned*)(pb + j_ * sb + (k0)), (LAS3 unsigned*)(lds + 65536 + (buf) * 32768 + j_ * 8192 + wbase), 16, 0, 0); } } while (0)
  f32x16 acc[2][4];
#pragma unroll
  for (int a = 0; a < 2; ++a)
#pragma unroll
    for (int b = 0; b < 4; ++b) acc[a][b] = f32x16{};
  G_DMA(0, 0);
  asm volatile("s_waitcnt vmcnt(0)" ::: "memory");
  __syncthreads();
  const int nk = K >> 6;
  const int swz = (r32 >> 1) & 7;
  int koff[4];
#pragma unroll
  for (int kk = 0; kk < 4; ++kk) koff[kk] = ((kk * 2 + hi) ^ swz) * 16;
  const int aoff = (wm * 128 + r32) * 128, boff = 65536 + (wn * 64 + r32) * 128;
  for (int t = 0; t < nk; ++t) {
    const int buf = t & 1;
    if (t + 1 < nk) G_DMA(buf ^ 1, (t + 1) * 64);
    const LAS3 unsigned char* as = lds + buf * 32768 + aoff; const LAS3 unsigned char* bs = lds + buf * 32768 + boff;
    bf16x8 af[2][4], bfr[2][2];
#define G_LDF(S, KK) do { _Pragma("unroll") for (int mt = 0; mt < 4; ++mt) af[S][mt] = *(const LAS3 bf16x8*)(as + mt * 4096 + koff[KK]); \
      _Pragma("unroll") for (int nt = 0; nt < 2; ++nt) bfr[S][nt] = *(const LAS3 bf16x8*)(bs + nt * 4096 + koff[KK]); } while (0)
    G_LDF(0, 0);
#pragma unroll
    for (int kk = 0; kk < 4; ++kk) {
      if (kk < 3) G_LDF((kk + 1) & 1, kk + 1);
      __builtin_amdgcn_sched_barrier(0);
#pragma unroll
      for (int nt = 0; nt < 2; ++nt)
#pragma unroll
        for (int mt = 0; mt < 4; ++mt) acc[nt][mt] = MFMA32(bfr[kk & 1][nt], af[kk & 1][mt], acc[nt][mt]);
      __builtin_amdgcn_sched_barrier(0);
    }
#undef G_LDF
    asm volatile("s_waitcnt vmcnt(0)" ::: "memory");
    __syncthreads();
  }
#undef G_DMA
  epi(acc, m0, n0, wm, wn, r32, hi);
}

struct EpiInProj {
  bf16_t* proj; float* gates; char* smem;
  __device__ __forceinline__ void operator()(const f32x16 (&acc)[2][4], int m0, int n0, int wm, int wn, int r32, int hi) const {
    const int lane = r32 + 32 * hi, wid = wm * 4 + wn;
    bf16_t* wl = (bf16_t*)smem + wid * (32 * 72);
    const int c = lane & 7, rq = lane >> 3;
#pragma unroll
    for (int mt = 0; mt < 4; ++mt) {
      const int m = m0 + wm * 128 + mt * 32 + r32;
#pragma unroll
      for (int nt = 0; nt < 2; ++nt)
#pragma unroll
        for (int g = 0; g < 4; ++g) {
          const int nb = n0 + wn * 64 + nt * 32 + g * 8 + hi * 4;
          const f32x16& a = acc[nt][mt];
          u32x2 w = {pk2(a[4 * g], a[4 * g + 1]), pk2(a[4 * g + 2], a[4 * g + 3])};
          *(u32x2*)(wl + r32 * 72 + nt * 32 + g * 8 + hi * 4) = w;
          if (nb >= C_G && nb < INW) { f32x4 v = {a[4 * g], a[4 * g + 1], a[4 * g + 2], a[4 * g + 3]}; *(f32x4*)(gates + (size_t)m * 16 + (nb - C_G)) = v; }
        }
      asm volatile("s_waitcnt lgkmcnt(0)" ::: "memory");
#pragma unroll
      for (int i = 0; i < 4; ++i) {
        const int rr = rq + 8 * i;
        const u32x4 v = *(const u32x4*)(wl + rr * 72 + c * 8);
        *(u32x4*)(proj + (size_t)(m0 + wm * 128 + mt * 32 + rr) * NPROJ + n0 + wn * 64 + c * 8) = v;
      }
      asm volatile("s_waitcnt lgkmcnt(0)" ::: "memory");
    }
    __syncthreads();
  }
};

struct EpiQUp {
  bf16_t* Q; const float* rs; const f32x2* rope; int smask; char* smem;
  __device__ __forceinline__ void operator()(const f32x16 (&acc)[2][4], int m0, int n0, int wm, int wn, int r32, int hi) const {
    const int lane = r32 + 32 * hi, wid = wm * 4 + wn;
    bf16_t* wl = (bf16_t*)smem + wid * 2560;
    const int c = lane & 7, rq = lane >> 3;
#pragma unroll
    for (int mt = 0; mt < 4; ++mt) {
      const int ml = wm * 128 + mt * 32 + r32, m = m0 + ml; const float r = rs[ml]; const int pos = m & smask;
#pragma unroll
      for (int nt = 0; nt < 2; ++nt) {
        const int nb0 = n0 + wn * 64 + nt * 32; const int t32 = nb0 >> 5; const bool isrope = (t32 % 3) == 2;
        float v[16];
#pragma unroll
        for (int k = 0; k < 16; ++k) v[k] = acc[nt][mt][k] * r;
        if (isrope) {
#pragma unroll
          for (int g = 0; g < 2; ++g)
#pragma unroll
            for (int i = 0; i < 4; ++i) {
              const int dd = 8 * g + 4 * hi + i; const f32x2 cs = rope[pos * 16 + dd];
              const float x1 = v[4 * g + i], x2 = v[4 * g + i + 8];
              v[4 * g + i] = x1 * cs[0] - x2 * cs[1]; v[4 * g + i + 8] = x2 * cs[0] + x1 * cs[1];
            }
        }
#pragma unroll
        for (int g = 0; g < 4; ++g) { u32x2 w = {pk2(v[4 * g], v[4 * g + 1]), pk2(v[4 * g + 2], v[4 * g + 3])}; *(u32x2*)(wl + r32 * 72 + nt * 32 + g * 8 + hi * 4) = w; }
      }
      asm volatile("s_waitcnt lgkmcnt(0)" ::: "memory");
#pragma unroll
      for (int i = 0; i < 4; ++i) { const int rr = rq + 8 * i; const u32x4 w = *(const u32x4*)(wl + rr * 72 + c * 8);
        *(u32x4*)(Q + (size_t)(m0 + wm * 128 + mt * 32 + rr) * 768 + n0 + wn * 64 + c * 8) = w; }
      asm volatile("s_waitcnt lgkmcnt(0)" ::: "memory");
    }
  }
};

struct EpiKVUp {
  bf16_t* Kn; bf16_t* Vt; const float* rs; int S, slog, smask; char* smem;
  __device__ __forceinline__ void operator()(const f32x16 (&acc)[2][4], int m0, int n0, int wm, int wn, int r32, int hi) const {
    const int lane = r32 + 32 * hi, wid = wm * 4 + wn;
    bf16_t* wl = (bf16_t*)smem + wid * 2560;
    const int nbw = n0 + wn * 64, head = nbw >> 7; const bool isv = (nbw & 64) != 0;
#pragma unroll
    for (int mt = 0; mt < 4; ++mt) {
      const int ml = wm * 128 + mt * 32 + r32; const float r = rs[ml];
      const int mg = m0 + wm * 128 + mt * 32;
      if (!isv) {
#pragma unroll
        for (int nt = 0; nt < 2; ++nt)
#pragma unroll
          for (int g = 0; g < 4; ++g) { const f32x16& a = acc[nt][mt];
            u32x2 w = {pk2(a[4 * g] * r, a[4 * g + 1] * r), pk2(a[4 * g + 2] * r, a[4 * g + 3] * r)};
            *(u32x2*)(wl + r32 * 72 + nt * 32 + g * 8 + hi * 4) = w; }
        asm volatile("s_waitcnt lgkmcnt(0)" ::: "memory");
        const int c = lane & 7, rq = lane >> 3;
#pragma unroll
        for (int i = 0; i < 4; ++i) { const int rr = rq + 8 * i; const u32x4 w = *(const u32x4*)(wl + rr * 72 + c * 8);
          *(u32x4*)(Kn + (size_t)(mg + rr) * 512 + head * 64 + c * 8) = w; }
      } else {
#pragma unroll
        for (int nt = 0; nt < 2; ++nt)
#pragma unroll
          for (int k = 0; k < 16; ++k) { const int dv = nt * 32 + 8 * (k >> 2) + 4 * hi + (k & 3); wl[dv * 40 + r32] = f2bf(acc[nt][mt][k] * r); }
        asm volatile("s_waitcnt lgkmcnt(0)" ::: "memory");
        const int cc = lane & 3, dq = lane >> 2; const int pos0 = mg & smask, bb = mg >> slog;
#pragma unroll
        for (int i = 0; i < 4; ++i) { const int dvr = dq + 16 * i; const u32x4 w = *(const u32x4*)(wl + dvr * 40 + cc * 8);
          *(u32x4*)(Vt + ((size_t)(bb * 8 + head) * 64 + dvr) * S + pos0 + cc * 8) = w; }
      }
      asm volatile("s_waitcnt lgkmcnt(0)" ::: "memory");
    }
  }
};

struct EpiResid {
  float* x; char* smem;
  __device__ __forceinline__ void operator()(const f32x16 (&acc)[2][4], int m0, int n0, int wm, int wn, int r32, int hi) const {
    const int lane = r32 + 32 * hi, wid = wm * 4 + wn;
    float* wl = (float*)smem + wid * (32 * 68);
    const int c = lane & 15, rq = lane >> 4;
    float* xb = x + (size_t)(m0 + wm * 128 + rq) * 1024 + n0 + wn * 64 + c * 4;
    f32x4 xc[8], xn[8];
#pragma unroll
    for (int i = 0; i < 8; ++i) xc[i] = *(const f32x4*)(xb + (size_t)(4 * i) * 1024);
#pragma unroll
    for (int mt = 0; mt < 4; ++mt) {
      if (mt < 3) {
#pragma unroll
        for (int i = 0; i < 8; ++i) xn[i] = *(const f32x4*)(xb + (size_t)((mt + 1) * 32 + 4 * i) * 1024);
      }
#pragma unroll
      for (int nt = 0; nt < 2; ++nt)
#pragma unroll
        for (int g = 0; g < 4; ++g) { const f32x16& a = acc[nt][mt];
          f32x4 v = {a[4 * g], a[4 * g + 1], a[4 * g + 2], a[4 * g + 3]};
          *(f32x4*)(wl + r32 * 68 + nt * 32 + g * 8 + hi * 4) = v; }
      asm volatile("s_waitcnt lgkmcnt(0)" ::: "memory");
      f32x4 ov[8];
#pragma unroll
      for (int i = 0; i < 8; ++i) { const f32x4 a = *(const f32x4*)(wl + (rq + 4 * i) * 68 + c * 4); ov[i] = xc[i] * DN_ALPHA + a; }
#pragma unroll
      for (int i = 0; i < 8; ++i) *(f32x4*)(xb + (size_t)(mt * 32 + 4 * i) * 1024) = ov[i];
      asm volatile("s_waitcnt lgkmcnt(0)" ::: "memory");
#pragma unroll
      for (int i = 0; i < 8; ++i) xc[i] = xn[i];
    }
    __syncthreads();
  }
};

struct EpiGU {
  bf16_t* hid; char* smem;
  __device__ __forceinline__ void operator()(const f32x16 (&acc)[2][4], int m0, int n0, int wm, int wn, int r32, int hi) const {
    const int hb = (n0 + wn * 64) >> 1;
    const int lane = r32 + 32 * hi, wid = wm * 4 + wn;
    bf16_t* wl = (bf16_t*)smem + wid * (32 * 40);
    const int c = lane & 3, rq = lane >> 2;
#pragma unroll
    for (int mt = 0; mt < 4; ++mt) {
#pragma unroll
      for (int g = 0; g < 4; ++g) {
        float o[4];
#pragma unroll
        for (int i = 0; i < 4; ++i) { const float gt = acc[0][mt][4 * g + i], up = acc[1][mt][4 * g + i]; o[i] = gt * up * __builtin_amdgcn_rcpf(1.f + __builtin_amdgcn_exp2f(-1.4426950408889634f * gt)); }
        u32x2 w = {pk2(o[0], o[1]), pk2(o[2], o[3])};
        *(u32x2*)(wl + r32 * 40 + g * 8 + hi * 4) = w;
      }
      asm volatile("s_waitcnt lgkmcnt(0)" ::: "memory");
#pragma unroll
      for (int i = 0; i < 2; ++i) {
        const int rr = rq + 16 * i;
        const u32x4 v = *(const u32x4*)(wl + rr * 40 + c * 8);
        *(u32x4*)(hid + (size_t)(m0 + wm * 128 + mt * 32 + rr) * DFF + hb + c * 8) = v;
      }
      asm volatile("s_waitcnt lgkmcnt(0)" ::: "memory");
    }
    __syncthreads();
  }
};

namespace pg8 {
#define PG8_LAS __attribute__((address_space(3)))
typedef unsigned short bf16_t;
typedef short bf16x8 __attribute__((ext_vector_type(8)));
typedef float f32x4 __attribute__((ext_vector_type(4)));
typedef unsigned u32x4 __attribute__((ext_vector_type(4)));
constexpr int BM = 256, BK = 64, HALF = 128, HTB = HALF * BK * 2  , STAGE_BYTES = 8 * HTB, NXCD = 8, WGM = 8;

__host__ __device__ __forceinline__ int lds_byte(int r, int c) { const int st = (r >> 4) * 2 + (c >> 5), rr = r & 15, cc = c & 31, ob = rr * 64 + cc * 2; return st * 1024 + (ob ^ (((ob >> 9) & 1) << 5)); }
__host__ __device__ __forceinline__ void stage_rc(int b, int& R, int& C) { const int st = b / 1024, sb = b % 1024, swz = sb ^ (((sb >> 9) & 1) << 5); R = (st >> 1) * 16 + swz / 64; C = (st & 1) * 32 + (swz % 64) / 2; }
__host__ __device__ __forceinline__ int perm32(int rho) { const int n = rho >> 4, i = rho & 15; return 8 * (i >> 2) + 4 * n + (i & 3); }

struct Unit { int pm, pn; };
struct Gemm { const bf16_t* A; const bf16_t* Bt; int M, N, K, lda; };

struct StaticOrder {
    int nM, nN, nwg, G, c;
    __host__ __device__ void init(int M, int N, int G_, int c_) { nM = M / BM; nN = N / BM; nwg = nM * nN; G = G_; c = c_; }
    __host__ __device__ bool next(int i, Unit& u) const {
        const long L = (long)i * G + c; if (L >= nwg) return false;
        int wgid = (int)L; { const int q = nwg / NXCD, r = nwg % NXCD, xcd = wgid % NXCD, off = wgid / NXCD; wgid = (xcd < r ? xcd * (q + 1) : r * (q + 1) + (xcd - r) * q) + off; }
        const int nig = WGM * nN, gid = wgid / nig, fm = gid * WGM, gsz = (nM - fm) < WGM ? (nM - fm) : WGM;
        u.pm = fm + ((wgid % nig) % gsz); u.pn = (wgid % nig) / gsz; return true;
    }
    __device__ __forceinline__ void a_ready(const Unit&) const {}
    __device__ __forceinline__ void done(const Unit&) const {}
};


struct EpiInProj2 {
  static constexpr bool PERM = true, AFTER_DRAIN = false;
  bf16_t* proj; float* gates;
  __device__ __forceinline__ void operator()(const f32x4 (&acc)[2][2][4][2], const Unit& u, int wr, int wc, int fr, int fq) const {
#pragma unroll
    for (int ai = 0; ai < 2; ++ai)
#pragma unroll
      for (int m = 0; m < 4; ++m) { const size_t row = (size_t)u.pm * BM + ai * HALF + wr * 64 + m * 16 + fr;
#pragma unroll
        for (int bj = 0; bj < 2; ++bj) { const int col0 = u.pn * BM + bj * HALF + wc * 32 + 8 * fq; const f32x4 v0 = acc[ai][bj][m][0], v1 = acc[ai][bj][m][1];
          u32x4 w; w.x = pk2(v0[0], v0[1]); w.y = pk2(v0[2], v0[3]); w.z = pk2(v1[0], v1[1]); w.w = pk2(v1[2], v1[3]);
          __builtin_nontemporal_store(w, (u32x4*)(proj + row * NPROJ + col0));
          if (col0 >= C_G && col0 < INW) { *(f32x4*)(gates + row * 16 + (col0 - C_G)) = v0; *(f32x4*)(gates + row * 16 + (col0 - C_G) + 4) = v1; } } }
  }
};
struct EpiResid2 {
  static constexpr bool PERM = false, AFTER_DRAIN = false;
  float* x; const f32x2* stats; const float* g; const float* b;
  __device__ __forceinline__ void operator()(const f32x4 (&acc)[2][2][4][2], const Unit& u, int wr, int wc, int fr, int fq) const {
    const int row0 = u.pm * BM + wr * 64 + fr, col0 = u.pn * BM + wc * 32 + 4 * fq;
    float* rb = x + (size_t)row0 * 1024 + col0;
#pragma unroll
    for (int ai = 0; ai < 2; ++ai)
#pragma unroll
      for (int m = 0; m < 4; ++m) {
        f32x4 xc[2][2]; const f32x2 sv = stats[row0 + ai * HALF + m * 16];
#pragma unroll
        for (int bj = 0; bj < 2; ++bj)
#pragma unroll
          for (int n = 0; n < 2; ++n) xc[bj][n] = *(const f32x4*)(rb + (size_t)(ai * HALF + m * 16) * 1024 + bj * HALF + n * 16);
#pragma unroll
        for (int bj = 0; bj < 2; ++bj)
#pragma unroll
          for (int n = 0; n < 2; ++n) { const f32x4 gv = *(const f32x4*)(g + col0 + bj * HALF + n * 16), bv = *(const f32x4*)(b + col0 + bj * HALF + n * 16);
            const f32x4 xn = (xc[bj][n] - sv[0]) * sv[1] * gv + bv;
            *(f32x4*)(rb + (size_t)(ai * HALF + m * 16) * 1024 + bj * HALF + n * 16) = xn * DN_ALPHA + acc[ai][bj][m][n]; }
        asm volatile("" ::: "memory");
      }
  }
};
struct EpiGU2 {
  static constexpr bool PERM = true, AFTER_DRAIN = false;
  bf16_t* hid;
  __device__ __forceinline__ void operator()(const f32x4 (&acc)[2][2][4][2], const Unit& u, int wr, int wc, int fr, int fq) const {
#pragma unroll
    for (int ai = 0; ai < 2; ++ai)
#pragma unroll
      for (int m = 0; m < 4; ++m) { const size_t row = (size_t)u.pm * BM + ai * HALF + wr * 64 + m * 16 + fr; float o[8];
#pragma unroll
        for (int n = 0; n < 2; ++n)
#pragma unroll
          for (int i = 0; i < 4; ++i) { const float gt = acc[ai][0][m][n][i], up = acc[ai][1][m][n][i]; o[4 * n + i] = gt * up * __builtin_amdgcn_rcpf(1.f + __builtin_amdgcn_exp2f(-1.4426950408889634f * gt)); }
        u32x4 w; w.x = pk2(o[0], o[1]); w.y = pk2(o[2], o[3]); w.z = pk2(o[4], o[5]); w.w = pk2(o[6], o[7]);
        __builtin_nontemporal_store(w, (u32x4*)(hid + row * DFF + u.pn * HALF + wc * 32 + 8 * fq)); }
  }
};
template <class Epi, class Sched, bool ALIGN_EPI = false, bool SP2 = false>
__device__ __forceinline__ void gemm_phase(PG8_LAS unsigned char* lds, const Gemm g, const Sched& S, const Epi& E) {
    const int tid = otid(), wid = __builtin_amdgcn_readfirstlane(tid >> 6), lane = tid & 63, wr = wid >> 2, wc = wid & 3, fr = lane & 15, fq = lane >> 4;
    const int K = g.K, nt = K / BK;
    unsigned voffA[2], voffB[2];
#pragma unroll
    for (int i = 0; i < 2; ++i) { int R, C; stage_rc(tid * 16 + i * 8192, R, C); const int Rb = Epi::PERM ? ((R & ~31) + perm32(R & 31)) : R;
        voffA[i] = (unsigned)(R * g.lda + C) * 2u; voffB[i] = (unsigned)(Rb * K + C) * 2u; }
    const size_t kstep = (size_t)(BK * 2);
    const size_t hstepB = (size_t)HALF * K * 2, hstepA = (size_t)HALF * g.lda * 2;
    const size_t tstepA = 2 * hstepA, tstepB = 2 * hstepB;
    const unsigned ldsw = (unsigned)wid * 1024u;
    const int aoff = lds_byte(wr * 64 + fr, fq * 8), boff = lds_byte(wc * 32 + fr, fq * 8);
#define PG8_SA(b, h) (((b) * 2 + (h)) * HTB)
#define PG8_SB(b, h) ((4 + (b) * 2 + (h)) * HTB)
#define PG8_STAGE(bufoff, gbase, voff) do { _Pragma("unroll") for (int _i = 0; _i < 2; ++_i) \
        __builtin_amdgcn_global_load_lds((const unsigned*)((const char*)(gbase) + (voff)[_i]), (PG8_LAS unsigned*)(lds + (bufoff) + ldsw + _i * 8192), 16, 0, 0); } while (0)
#define PG8_LDA(dst, b, h) do { _Pragma("unroll") for (int m = 0; m < 4; ++m) _Pragma("unroll") for (int k = 0; k < 2; ++k) dst[m][k] = *(const PG8_LAS bf16x8*)(lds + PG8_SA(b, h) + aoff + m * 2048 + k * 1024); } while (0)
#define PG8_LDB(dst, b, h) do { _Pragma("unroll") for (int n = 0; n < 2; ++n) _Pragma("unroll") for (int k = 0; k < 2; ++k) dst[n][k] = *(const PG8_LAS bf16x8*)(lds + PG8_SB(b, h) + boff + n * 2048 + k * 1024); } while (0)
#define PG8_MMA(ai, bj, At, Bt) do { __builtin_amdgcn_s_setprio(1); _Pragma("unroll") for (int m = 0; m < 4; ++m) _Pragma("unroll") for (int n = 0; n < 2; ++n) _Pragma("unroll") for (int k = 0; k < 2; ++k) \
        acc[ai][bj][m][n] = __builtin_amdgcn_mfma_f32_16x16x32_bf16(Bt[n][k], At[m][k], acc[ai][bj][m][n], 0, 0, 0); __builtin_amdgcn_s_setprio(0); } while (0)
#define PG8_WAIT_V(n) asm volatile("s_waitcnt vmcnt(" #n ")" ::: "memory")
#define PG8_WAIT_L(n) asm volatile("s_waitcnt lgkmcnt(" #n ")" ::: "memory")
#define PG8_BAR __builtin_amdgcn_s_barrier()
#define PG8_SCHED __builtin_amdgcn_sched_barrier(0)
    Unit cur, nxt; int ui = 0;
    if (!S.next(0, cur)) return;
    f32x4 acc[2][2][4][2];
#pragma unroll
    for (int a = 0; a < 2; ++a)
#pragma unroll
        for (int b = 0; b < 2; ++b)
#pragma unroll
            for (int m = 0; m < 4; ++m)
#pragma unroll
                for (int n = 0; n < 2; ++n) acc[a][b][m][n] = (f32x4){0.f, 0.f, 0.f, 0.f};
    bf16x8 At[4][2], B0[2][2], B1[2][2];
    const char* cA = (const char*)g.A + (size_t)cur.pm * tstepA; const char* cB = (const char*)g.Bt + (size_t)cur.pn * tstepB;
    S.a_ready(cur);
    if constexpr (SP2) {
        PG8_STAGE(PG8_SB(0, 0), cB, voffB); PG8_STAGE(PG8_SB(0, 1), cB + hstepB, voffB); PG8_STAGE(PG8_SA(0, 0), cA, voffA); PG8_STAGE(PG8_SA(0, 1), cA + hstepA, voffA);
        if (wr == 1) PG8_BAR;
        PG8_WAIT_V(2); PG8_BAR;
        PG8_STAGE(PG8_SB(1, 0), cB + kstep, voffB); PG8_STAGE(PG8_SA(1, 0), cA + kstep, voffA); PG8_STAGE(PG8_SB(1, 1), cB + hstepB + kstep, voffB);
        PG8_WAIT_V(6); PG8_BAR;
    } else {
        PG8_STAGE(PG8_SB(0, 0), cB, voffB); PG8_STAGE(PG8_SA(0, 0), cA, voffA); PG8_STAGE(PG8_SB(0, 1), cB + hstepB, voffB); PG8_STAGE(PG8_SA(0, 1), cA + hstepA, voffA);
        if (wr == 1) PG8_BAR;
        PG8_WAIT_V(4); PG8_BAR;
        PG8_STAGE(PG8_SB(1, 0), cB + kstep, voffB); PG8_STAGE(PG8_SA(1, 0), cA + kstep, voffA); PG8_STAGE(PG8_SB(1, 1), cB + hstepB + kstep, voffB);
        PG8_WAIT_V(6); PG8_BAR;
    }
    for (;;) {
        const bool has_next = S.next(ui + 1, nxt);
        const char* nA = has_next ? (const char*)g.A + (size_t)nxt.pm * tstepA : cA; const char* nB = has_next ? (const char*)g.Bt + (size_t)nxt.pn * tstepB : cB;
        for (int t = 0; t < nt; t += 2) {
            const bool last = (t == nt - 2);
            const char* a1 = cA + (size_t)(t + 1) * kstep;
            const char* a2 = last ? nA : cA + (size_t)(t + 2) * kstep; const char* b2 = last ? nB : cB + (size_t)(t + 2) * kstep;
            const char* a3 = a2 + kstep; const char* b3 = b2 + kstep;
            if (last && has_next) S.a_ready(nxt);
            if constexpr (SP2) {
            PG8_LDB(B0, 0, 0); PG8_LDB(B1, 0, 1); PG8_SCHED; PG8_LDA(At, 0, 0); PG8_STAGE(PG8_SA(1, 1), a1 + hstepA, voffA);
            PG8_WAIT_V(8); PG8_WAIT_L(0); PG8_BAR; PG8_MMA(0, 0, At, B0); PG8_MMA(0, 1, At, B1); PG8_BAR; PG8_SCHED;
            PG8_LDA(At, 0, 1); PG8_STAGE(PG8_SB(0, 0), b2, voffB); PG8_STAGE(PG8_SB(0, 1), b2 + hstepB, voffB); PG8_STAGE(PG8_SA(0, 0), a2, voffA);
            PG8_WAIT_V(8); PG8_WAIT_L(0); PG8_BAR; PG8_MMA(1, 0, At, B0); PG8_MMA(1, 1, At, B1); PG8_BAR; PG8_SCHED;
            PG8_LDB(B0, 1, 0); PG8_LDB(B1, 1, 1); PG8_SCHED; PG8_LDA(At, 1, 0); PG8_STAGE(PG8_SA(0, 1), a2 + hstepA, voffA);
            PG8_WAIT_V(8); PG8_WAIT_L(0); PG8_BAR; PG8_MMA(0, 0, At, B0); PG8_MMA(0, 1, At, B1); PG8_BAR; PG8_SCHED;
            PG8_LDA(At, 1, 1); PG8_STAGE(PG8_SB(1, 0), b3, voffB); PG8_STAGE(PG8_SB(1, 1), b3 + hstepB, voffB); PG8_STAGE(PG8_SA(1, 0), a3, voffA);
            PG8_WAIT_V(8); PG8_WAIT_L(0); PG8_BAR; PG8_MMA(1, 0, At, B0); PG8_MMA(1, 1, At, B1); PG8_BAR; PG8_SCHED;
            } else {
            PG8_LDB(B0, 0, 0); PG8_SCHED; PG8_LDA(At, 0, 0); PG8_STAGE(PG8_SA(1, 1), a1 + hstepA, voffA);
            PG8_WAIT_L(8); PG8_BAR; PG8_WAIT_L(0); PG8_MMA(0, 0, At, B0); PG8_BAR; PG8_SCHED;
            PG8_LDB(B1, 0, 1); PG8_STAGE(PG8_SB(0, 0), b2, voffB);
            PG8_BAR; PG8_WAIT_L(0); PG8_MMA(0, 1, At, B1); PG8_BAR;
            PG8_LDA(At, 0, 1); PG8_STAGE(PG8_SA(0, 0), a2, voffA);
            PG8_BAR; PG8_WAIT_L(0); PG8_MMA(1, 0, At, B0); PG8_BAR; PG8_SCHED;
            PG8_STAGE(PG8_SB(0, 1), b2 + hstepB, voffB);
            PG8_WAIT_V(6); PG8_BAR; PG8_MMA(1, 1, At, B1); PG8_BAR;
            PG8_LDB(B0, 1, 0); PG8_SCHED; PG8_LDA(At, 1, 0); PG8_STAGE(PG8_SA(0, 1), a2 + hstepA, voffA);
            PG8_WAIT_L(8); PG8_BAR; PG8_WAIT_L(0); PG8_MMA(0, 0, At, B0); PG8_BAR; PG8_SCHED;
            PG8_LDB(B1, 1, 1); PG8_STAGE(PG8_SB(1, 0), b3, voffB);
            PG8_BAR; PG8_WAIT_L(0); PG8_MMA(0, 1, At, B1); PG8_BAR;
            PG8_LDA(At, 1, 1); PG8_STAGE(PG8_SA(1, 0), a3, voffA);
            PG8_BAR; PG8_WAIT_L(0); PG8_MMA(1, 0, At, B0); PG8_BAR; PG8_SCHED;
            PG8_STAGE(PG8_SB(1, 1), b3 + hstepB, voffB);
            PG8_WAIT_V(6); PG8_BAR; PG8_MMA(1, 1, At, B1); PG8_BAR;
            }
        }
        if constexpr (ALIGN_EPI) { if (wr == 0) PG8_BAR; }
        if constexpr (!Epi::AFTER_DRAIN) { E(acc, cur, wr, wc, fr, fq); S.done(cur); }
        if (!has_next) break;
#pragma unroll
        for (int a = 0; a < 2; ++a)
#pragma unroll
            for (int b = 0; b < 2; ++b)
#pragma unroll
                for (int m = 0; m < 4; ++m)
#pragma unroll
                    for (int n = 0; n < 2; ++n) acc[a][b][m][n] = (f32x4){0.f, 0.f, 0.f, 0.f};
        cur = nxt; cA = nA; cB = nB; ++ui;
        if constexpr (ALIGN_EPI) { if (wr == 1) PG8_BAR; }
    }
    PG8_WAIT_V(0);
    if constexpr (!ALIGN_EPI) { if (wr == 0) PG8_BAR; }
    PG8_BAR;
    if constexpr (Epi::AFTER_DRAIN) { E.fused(acc, cur, wr, wc, fr, fq, lds, wid, lane); S.done(cur); }
#undef PG8_SA
#undef PG8_SB
#undef PG8_STAGE
#undef PG8_LDA
#undef PG8_LDB
#undef PG8_MMA
#undef PG8_WAIT_V
#undef PG8_WAIT_L
#undef PG8_BAR
#undef PG8_SCHED
}
}


__device__ __forceinline__ void row_rms(const bf16_t* A, int lda, int K, int m0, float* rs) {
  const int tid = otid(), row = tid >> 1, half = tid & 1;
  const bf16_t* p = A + (size_t)(m0 + row) * lda + half * (K >> 1);
  float s = 0.f;
  for (int i = 0; i < (K >> 4); ++i) { const u32x4 w = *(const u32x4*)(p + i * 8);
#pragma unroll
    for (int k = 0; k < 4; ++k) { const float a = bflo(w[k]), b = bfhi(w[k]); s += a * a + b * b; } }
  s += __shfl_xor(s, 1);
  if (half == 0) rs[row] = rsqrtf(s / (float)K + LN_EPS);
  __syncthreads();
}

constexpr int A_KS = 104, A_VS = 72;
constexpr int A_KBUF = 64 * A_KS, A_VBUF = 64 * A_VS;
constexpr float A_THR = 8.f;
__device__ void attn_unit(const bf16_t* __restrict__ Q, const bf16_t* __restrict__ Kn, const bf16_t* __restrict__ Vt, const bf16_t* __restrict__ KR,
                          bf16_t* __restrict__ Y, int S, int b, int h, int qb, char* smem) {
  const int tid = otid(), lane = tid & 63, wid = tid >> 6, r32 = lane & 31, hi = lane >> 5;
  bf16_t* Ks = (bf16_t*)smem; bf16_t* Vs = Ks + 2 * A_KBUF; float* wsf = (float*)(Vs + 2 * A_VBUF) + wid * 64;
  const size_t rowbase = (size_t)b * S;
  const int q0 = qb * 256 + wid * 32;
  bf16x8 qr[6];
  { const bf16_t* qp = Q + (rowbase + q0 + r32) * 768 + h * 96 + hi * 8;
#pragma unroll
    for (int d0 = 0; d0 < 6; ++d0) qr[d0] = *(const bf16x8*)(qp + d0 * 16); }
  const bf16_t* kn_src = Kn + (rowbase + (tid >> 3)) * 512 + h * 64 + (tid & 7) * 8;
  const bf16_t* kr_src = KR + (rowbase + (tid >> 2)) * 32 + (tid & 3) * 8;
  const bf16_t* v_src = Vt + ((size_t)(b * 8 + h) * 64 + (tid >> 3)) * S + (tid & 7) * 8;
  const int kn_dst = (tid >> 3) * A_KS + (tid & 7) * 8, kr_dst = (tid >> 2) * A_KS + 64 + (tid & 3) * 8, v_dst = (tid >> 3) * A_VS + (tid & 7) * 8;
  const bool has_kr = tid < 256;
  u32x4 sk, sr, sv;
#define A_LOAD(k0) do { sk = *(const u32x4*)(kn_src + (size_t)(k0) * 512); if (has_kr) sr = *(const u32x4*)(kr_src + (size_t)(k0) * 32); sv = *(const u32x4*)(v_src + (k0)); } while (0)
#define A_STORE(bf) do { *(u32x4*)(Ks + (bf) * A_KBUF + kn_dst) = sk; if (has_kr) *(u32x4*)(Ks + (bf) * A_KBUF + kr_dst) = sr; *(u32x4*)(Vs + (bf) * A_VBUF + v_dst) = sv; } while (0)
  float m_ref = 0.f, l_reg = 0.f; f32x16 o[2], negm; o[0] = f32x16{}; o[1] = f32x16{}; negm = f32x16{};
  const int NT = S >> 6;
  A_LOAD(0); A_STORE(0); __syncthreads();
  for (int j = 0; j < NT; ++j) {
    const int buf = j & 1;
    if (j + 1 < NT) A_LOAD((j + 1) * 64);
#ifndef A_SKEW
#define A_SKEW 1
#endif
    if (A_SKEW > 0 && wid >= 4) __builtin_amdgcn_s_sleep(A_SKEW);
    f32x16 p0, p1;
    bf16x8 vf[8];
    { const bf16_t* kb = Ks + buf * A_KBUF + r32 * A_KS + hi * 8;
      bf16x8 kf[12];
#pragma unroll
      for (int d0 = 0; d0 < 6; ++d0) { kf[2 * d0] = *(const bf16x8*)(kb + d0 * 16); kf[2 * d0 + 1] = *(const bf16x8*)(kb + 32 * A_KS + d0 * 16); }
      __builtin_amdgcn_sched_barrier(0);
      p0 = MFMA32(kf[0], qr[0], negm); p1 = MFMA32(kf[1], qr[0], negm);
#pragma unroll
      for (int d0 = 1; d0 < 6; ++d0) { p0 = MFMA32(kf[2 * d0], qr[d0], p0); p1 = MFMA32(kf[2 * d0 + 1], qr[d0], p1); }
      __builtin_amdgcn_sched_barrier(0);
      const bf16_t* vb = Vs + buf * A_VBUF + r32 * A_VS + hi * 8;
#pragma unroll
      for (int d0 = 0; d0 < 2; ++d0)
#pragma unroll
        for (int ks = 0; ks < 4; ++ks) vf[d0 * 4 + ks] = *(const bf16x8*)(vb + d0 * 32 * A_VS + ks * 16);
      __builtin_amdgcn_sched_barrier(0);
    }
#define MX3(a, b, c) __builtin_fmaxf(__builtin_fmaxf((a), (b)), (c))
    float pmax;
    { float a = MX3(p0[0], p0[1], p0[2]), b2 = MX3(p0[3], p0[4], p0[5]);
      a = MX3(a, p0[6], p0[7]); b2 = MX3(b2, p0[8], p0[9]); a = MX3(a, p0[10], p0[11]); b2 = MX3(b2, p0[12], p0[13]); a = MX3(a, p0[14], p0[15]);
      b2 = MX3(b2, p1[0], p1[1]); a = MX3(a, p1[2], p1[3]); b2 = MX3(b2, p1[4], p1[5]); a = MX3(a, p1[6], p1[7]); b2 = MX3(b2, p1[8], p1[9]);
      a = MX3(a, p1[10], p1[11]); b2 = MX3(b2, p1[12], p1[13]); a = MX3(a, p1[14], p1[15]); pmax = __builtin_fmaxf(a, b2); }
#undef MX3
    { auto rr = __builtin_amdgcn_permlane32_swap(__float_as_uint(pmax), __float_as_uint(pmax), false, false);
      pmax = fmaxf(__uint_as_float(rr[0]), __uint_as_float(rr[1])); }
    if (j == 0 || __any(pmax > A_THR)) {
      const float delta = (j == 0) ? pmax : fmaxf(pmax, 0.f);
#pragma unroll
      for (int r = 0; r < 16; ++r) { p0[r] -= delta; p1[r] -= delta; }
      m_ref += delta;
#pragma unroll
      for (int r = 0; r < 16; ++r) negm[r] = -m_ref;
      if (j > 0) {
        const float al = __builtin_amdgcn_exp2f(-delta); l_reg *= al;
        if (hi == 0) wsf[r32] = al;
        asm volatile("s_waitcnt lgkmcnt(0)" ::: "memory");
#pragma unroll
        for (int r = 0; r < 16; ++r) { const float f = wsf[crow(r, hi)]; o[0][r] *= f; o[1][r] *= f; }
        asm volatile("s_waitcnt lgkmcnt(0)" ::: "memory");
      }
    }
    float ps = 0.f, ps2 = 0.f;
#pragma unroll
    for (int r = 0; r < 16; ++r) { p0[r] = __builtin_amdgcn_exp2f(p0[r]); ps += p0[r]; }
#pragma unroll
    for (int r = 0; r < 16; ++r) { p1[r] = __builtin_amdgcn_exp2f(p1[r]); ps2 += p1[r]; }
    ps += ps2;
    { auto rr = __builtin_amdgcn_permlane32_swap(__float_as_uint(ps), __float_as_uint(ps), false, false);
      ps = __uint_as_float(rr[0]) + __uint_as_float(rr[1]); }
    l_reg += ps;
    bf16x8 pa0, pa1, pa2, pa3;
    PK4(p0, 0, pa0); PK4(p0, 8, pa1); PK4(p1, 0, pa2); PK4(p1, 8, pa3);
    __builtin_amdgcn_sched_barrier(0);
    o[0] = MFMA32(pa0, vf[0], o[0]); o[1] = MFMA32(pa0, vf[4], o[1]);
    o[0] = MFMA32(pa1, vf[1], o[0]); o[1] = MFMA32(pa1, vf[5], o[1]);
    o[0] = MFMA32(pa2, vf[2], o[0]); o[1] = MFMA32(pa2, vf[6], o[1]);
    o[0] = MFMA32(pa3, vf[3], o[0]); o[1] = MFMA32(pa3, vf[7], o[1]);
    __builtin_amdgcn_sched_barrier(0);
    if (j + 1 < NT) A_STORE(buf ^ 1);
    __syncthreads();
  }
#undef A_LOAD
#undef A_STORE
  if (hi == 0) wsf[32 + r32] = l_reg;
  asm volatile("s_waitcnt lgkmcnt(0)" ::: "memory");
  bf16_t* yp = Y + (rowbase + q0) * 1024 + h * 64 + r32;
#pragma unroll
  for (int r = 0; r < 16; ++r) {
    const int orow = crow(r, hi); const float rl = __builtin_amdgcn_rcpf(wsf[32 + orow]);
    yp[(size_t)orow * 1024] = f2bf(o[0][r] * rl); yp[(size_t)orow * 1024 + 32] = f2bf(o[1][r] * rl);
  }
  __syncthreads();
}

__device__ void phase_pool_rope(const bf16_t* __restrict__ proj, bf16_t* __restrict__ Y, bf16_t* __restrict__ KR, const f32x2* __restrict__ rope, int S) {
  const int smask = S - 1;
  const int gtid = blockIdx.x * NTHR + otid(), gstr = gridDim.x * NTHR;
  for (int idx = gtid; idx < (MT / 8) * 32; idx += gstr) {
    const int tb = idx >> 5, c = idx & 31, g = c >> 3, half = 1 << g, t0 = tb * 8, pos0 = t0 & smask;
    const bf16_t* base = proj + (size_t)(t0 - pos0) * NPROJ + C_POOL + c * 8;
    float sum[8];
#pragma unroll
    for (int k = 0; k < 8; ++k) sum[k] = 0.f;
    { int lo = pos0 - half; if (lo < 0) lo = 0; int hi = pos0 + half; if (hi > S) hi = S;
      for (int t = lo; t < hi; ++t) { const u32x4 v = *(const u32x4*)(base + (size_t)t * NPROJ);
#pragma unroll
        for (int k = 0; k < 4; ++k) { sum[2 * k] += bflo(v[k]); sum[2 * k + 1] += bfhi(v[k]); } } }
#pragma unroll
    for (int q = 0; q < 8; ++q) {
      const int pos = pos0 + q; int lo = pos - half; if (lo < 0) lo = 0; int hi = pos + half; if (hi > S) hi = S;
      const float rc = 1.f / (float)(hi - lo);
      const u32x4 xv = *(const u32x4*)(base + (size_t)pos * NPROJ);
      u32x4 o;
#pragma unroll
      for (int k = 0; k < 4; ++k) o[k] = pk2(sum[2 * k] * rc - bflo(xv[k]), sum[2 * k + 1] * rc - bfhi(xv[k]));
      *(u32x4*)(Y + (size_t)(t0 + q) * 1024 + 512 + c * 8) = o;
      if (q < 7) {
        if (pos + half < S) { const u32x4 v = *(const u32x4*)(base + (size_t)(pos + half) * NPROJ);
#pragma unroll
          for (int k = 0; k < 4; ++k) { sum[2 * k] += bflo(v[k]); sum[2 * k + 1] += bfhi(v[k]); } }
        if (pos - half >= 0) { const u32x4 v = *(const u32x4*)(base + (size_t)(pos - half) * NPROJ);
#pragma unroll
          for (int k = 0; k < 4; ++k) { sum[2 * k] -= bflo(v[k]); sum[2 * k + 1] -= bfhi(v[k]); } }
      }
    }
  }
  for (int idx = gtid; idx < MT * 2; idx += gstr) {
    const int m = idx >> 1, hf = idx & 1, pos = m & smask;
    const bf16_t* pp = proj + (size_t)m * NPROJ + C_KR + hf * 8;
    const u32x4 a = *(const u32x4*)pp, b2 = *(const u32x4*)(pp + 16);
    u32x4 o1, o2;
#pragma unroll
    for (int k = 0; k < 4; ++k) {
      const f32x2 c0 = rope[pos * 16 + hf * 8 + 2 * k], c1 = rope[pos * 16 + hf * 8 + 2 * k + 1];
      const float x1a = bflo(a[k]), x1b = bfhi(a[k]), x2a = bflo(b2[k]), x2b = bfhi(b2[k]);
      o1[k] = pk2(x1a * c0[0] - x2a * c0[1], x1b * c1[0] - x2b * c1[1]);
      o2[k] = pk2(x2a * c0[0] + x1a * c0[1], x2b * c1[0] + x1b * c1[1]);
    }
    *(u32x4*)(KR + (size_t)m * 32 + hf * 8) = o1; *(u32x4*)(KR + (size_t)m * 32 + 16 + hf * 8) = o2;
  }
}

__device__ __forceinline__ float logsigmoidf(float f) { return fminf(f, 0.f) - log1pf(__expf(-fabsf(f))); }
constexpr int ML_T = 136;
constexpr int ML_R = 72;

__device__ void mlstm_pass1(int cgi, int hh, const bf16_t* __restrict__ proj, const float* __restrict__ gates, const float* __restrict__ gbias,
                            float* __restrict__ stU, float* __restrict__ stN, float* __restrict__ stS, char* smem) {
  const int tid = otid(), lane = tid & 63, wid = tid >> 6, r32 = lane & 31, hi = lane >> 5;
  bf16_t* Vt = (bf16_t*)smem; bf16_t* Kw = Vt + 64 * ML_T;
  float* sc = (float*)(Kw + 2 * 64 * ML_T); float* lfs = sc; float* als = sc + 256; float* wss = sc + 512; float* red = sc + 768;
  const int item = cgi * 4 + hh; const size_t m0 = (size_t)cgi * 128;
  float ipre = 0.f;
  if (tid < 256) { const int dir = tid >> 7, s = tid & 127; const float* gp = gates + (m0 + s) * 16;
    ipre = gp[(2 * dir) * 4 + hh] + gbias[(2 * dir) * 4 + hh];
    const float f = gp[(2 * dir + 1) * 4 + hh] + gbias[(2 * dir + 1) * 4 + hh];
    lfs[tid] = logsigmoidf(f); }
  __syncthreads();
  if (tid < 256) { const int dir = tid >> 7, s = tid & 127; float b = 0.f;
#pragma unroll
    for (int t4 = 0; t4 < 32; ++t4) { const f32x4 v = *(const f32x4*)(lfs + dir * 128 + 4 * t4);
#pragma unroll
      for (int k = 0; k < 4; ++k) { const int t = 4 * t4 + k; const bool in = dir ? (t >= s) : (t <= s); b += in ? v[k] : 0.f; } }
    als[tid] = ipre - b;
    if (dir == 0 && s == 127) red[0] = b;
    if (dir == 1 && s == 0) red[1] = b; }
  __syncthreads();
  if (tid < 256) { const int dir = tid >> 7, s = tid & 127; float mx = als[dir * 128];
#pragma unroll
    for (int t4 = 0; t4 < 32; ++t4) { const f32x4 v = *(const f32x4*)(als + dir * 128 + 4 * t4); mx = fmaxf(fmaxf(mx, fmaxf(v[0], v[1])), fmaxf(v[2], v[3])); }
    wss[tid] = __expf(als[tid] - mx);
    if (s == 0) { stS[(size_t)(item * 2 + dir) * 4 + 0] = red[dir]; stS[(size_t)(item * 2 + dir) * 4 + 1] = mx; } }
  __syncthreads();
#pragma unroll
  for (int it = 0; it < 2; ++it) { const int idx = tid + NTHR * it, s = idx & 127, c = idx >> 7;
    const bf16_t* rp = proj + (m0 + s) * NPROJ + hh * 64 + c * 8;
    const u32x4 kc = *(const u32x4*)(rp + C_KM), vc = *(const u32x4*)(rp + C_VM);
    const float w0 = wss[s] * 0.125f, w1 = wss[128 + s] * 0.125f;
#pragma unroll
    for (int k = 0; k < 4; ++k) {
      const float ka = bflo(kc[k]), kb = bfhi(kc[k]);
      Kw[(8 * c + 2 * k) * ML_T + s] = f2bf(ka * w0); Kw[(8 * c + 2 * k + 1) * ML_T + s] = f2bf(kb * w0);
      Kw[64 * ML_T + (8 * c + 2 * k) * ML_T + s] = f2bf(ka * w1); Kw[64 * ML_T + (8 * c + 2 * k + 1) * ML_T + s] = f2bf(kb * w1);
      Vt[(8 * c + 2 * k) * ML_T + s] = (bf16_t)(vc[k] & 0xffffu); Vt[(8 * c + 2 * k + 1) * ML_T + s] = (bf16_t)(vc[k] >> 16);
    } }
  __syncthreads();
  { const int dir = wid >> 2, kb = (wid >> 1) & 1, vb = wid & 1;
    f32x16 acc = f32x16{};
    const bf16_t* ap = Kw + dir * 64 * ML_T + (kb * 32 + r32) * ML_T + hi * 8; const bf16_t* bp = Vt + (vb * 32 + r32) * ML_T + hi * 8;
#pragma unroll
    for (int ks = 0; ks < 8; ++ks) acc = MFMA32(*(const bf16x8*)(ap + ks * 16), *(const bf16x8*)(bp + ks * 16), acc);
    float* up = stU + (size_t)(item * 2 + dir) * 4096 + vb * 32 + r32;
#pragma unroll
    for (int r = 0; r < 16; ++r) up[(kb * 32 + crow(r, hi)) * 64] = acc[r]; }
  if (tid < 128) { const int dir = tid >> 6, kd = tid & 63; const bf16_t* kp = Kw + dir * 64 * ML_T + kd * ML_T; float s = 0.f;
#pragma unroll
    for (int t8 = 0; t8 < 16; ++t8) { const u32x4 v = *(const u32x4*)(kp + t8 * 8);
#pragma unroll
      for (int k = 0; k < 4; ++k) s += bflo(v[k]) + bfhi(v[k]); }
    stN[(size_t)(item * 2 + dir) * 64 + kd] = s; }
  __syncthreads();
}

template <int EPT, int GS>
__device__ void mlstm_pass2(int ch, int part, int NC, float* __restrict__ stU, float* __restrict__ stN, float* __restrict__ stS) {
  const int tid = otid(); const int b = ch >> 3, hh = (ch >> 1) & 3, dir = ch & 1;
  const int e0 = part * (NTHR * EPT) + tid;
  const bool own_n = (part == 0) && (tid < 64);
  float sv[EPT], nv = 0.f, m = 0.f;
#pragma unroll
  for (int i = 0; i < EPT; ++i) sv[i] = 0.f;
  for (int st0 = 0; st0 < NC; st0 += GS) {
    float uu[GS][EPT], un[GS], bs[GS], ml[GS];
#pragma unroll
    for (int q = 0; q < GS; ++q) {
      const int step = st0 + q, c = dir ? (NC - 1 - step) : step;
      const size_t base = (size_t)(((b * NC + c) * 4 + hh) * 2 + dir);
      bs[q] = stS[base * 4 + 0]; ml[q] = stS[base * 4 + 1];
#pragma unroll
      for (int i = 0; i < EPT; ++i) uu[q][i] = stU[base * 4096 + e0 + NTHR * i];
      un[q] = own_n ? stN[base * 64 + tid] : 0.f;
    }
#pragma unroll
    for (int q = 0; q < GS; ++q) {
      const int step = st0 + q, c = dir ? (NC - 1 - step) : step;
      const size_t base = (size_t)(((b * NC + c) * 4 + hh) * 2 + dir);
      const float mnew = bs[q] + fmaxf(m, ml[q]);
      const float decay = __expf(m + bs[q] - mnew), uf = __expf(ml[q] + bs[q] - mnew);
#pragma unroll
      for (int i = 0; i < EPT; ++i) { stU[base * 4096 + e0 + NTHR * i] = sv[i]; sv[i] = decay * sv[i] + uf * uu[q][i]; }
      if (own_n) { stN[base * 64 + tid] = nv; nv = decay * nv + uf * un[q]; }
      if (part == 0 && tid == 0) stS[base * 4 + 2] = m;
      m = mnew;
    }
  }
}

__device__ void mlstm_pass3(int cgi, int hh, const bf16_t* __restrict__ proj, const float* __restrict__ gates, const float* __restrict__ gbias,
                            const float* __restrict__ norm_g, const float* __restrict__ stU, const float* __restrict__ stN, const float* __restrict__ stS,
                            bf16_t* __restrict__ Y, char* smem) {
  const int tid = otid(), lane = tid & 63, wid = tid >> 6, r32 = lane & 31, hi = lane >> 5;
  bf16_t* Kr = (bf16_t*)smem; bf16_t* Qr = Kr + 128 * ML_R; bf16_t* Vt = Qr + 128 * ML_R; bf16_t* Qf = Vt + 64 * ML_T;
  bf16_t* St = Qf + 2 * 128 * ML_R;
  float* H = (float*)(St + 2 * 64 * ML_R);
  float* sc = H + 128 * 64; float* lfs = sc; float* als = sc + 256; float* bbs = sc + 512; float* Mls = sc + 768; float* ffs = sc + 1024; float* dqs = sc + 1280;
  float* nss = sc + 1536;   float* invs = sc + 1664;
  const int item = cgi * 4 + hh; const size_t m0 = (size_t)cgi * 128;
  float ipre = 0.f;
  if (tid < 256) { const int dir = tid >> 7, s = tid & 127; const float* gp = gates + (m0 + s) * 16;
    ipre = gp[(2 * dir) * 4 + hh] + gbias[(2 * dir) * 4 + hh];
    const float f = gp[(2 * dir + 1) * 4 + hh] + gbias[(2 * dir + 1) * 4 + hh];
    lfs[tid] = logsigmoidf(f); }
  __syncthreads();
  if (tid < 256) { const int dir = tid >> 7, s = tid & 127; float b = 0.f;
#pragma unroll
    for (int t4 = 0; t4 < 32; ++t4) { const f32x4 v = *(const f32x4*)(lfs + dir * 128 + 4 * t4);
#pragma unroll
      for (int k = 0; k < 4; ++k) { const int t = 4 * t4 + k; const bool in = dir ? (t >= s) : (t <= s); b += in ? v[k] : 0.f; } }
    als[tid] = ipre - b; bbs[tid] = b; }
  else if (tid < 384) { const int dir = (tid - 256) >> 6, kd = tid & 63; nss[dir * 64 + kd] = stN[(size_t)(item * 2 + dir) * 64 + kd]; }
  __syncthreads();
  if (tid < 256) { const int dir = tid >> 7, s = tid & 127; const float mst = stS[(size_t)(item * 2 + dir) * 4 + 2]; float mx = mst;
#pragma unroll
    for (int t4 = 0; t4 < 32; ++t4) { const f32x4 v = *(const f32x4*)(als + dir * 128 + 4 * t4);
#pragma unroll
      for (int k = 0; k < 4; ++k) { const int t = 4 * t4 + k; const bool in = dir ? (t >= s) : (t <= s); mx = fmaxf(mx, in ? v[k] : -3.0e38f); } }
    Mls[tid] = mx; ffs[tid] = __expf(mst - mx); }
  __syncthreads();
#pragma unroll
  for (int it = 0; it < 2; ++it) {
    { const int idx = tid + NTHR * it, s = idx >> 3, c = idx & 7;
      const bf16_t* rp = proj + (m0 + s) * NPROJ + hh * 64 + c * 8;
      const u32x4 kc = *(const u32x4*)(rp + C_KM), qc = *(const u32x4*)(rp + C_QM);
      *(u32x4*)(Kr + s * ML_R + c * 8) = kc; *(u32x4*)(Qr + s * ML_R + c * 8) = qc;
      const float f0 = ffs[s], f1 = ffs[128 + s]; u32x4 q0, q1;
#pragma unroll
      for (int k = 0; k < 4; ++k) { const float a = bflo(qc[k]), b2 = bfhi(qc[k]); q0[k] = pk2(a * f0, b2 * f0); q1[k] = pk2(a * f1, b2 * f1); }
      *(u32x4*)(Qf + s * ML_R + c * 8) = q0; *(u32x4*)(Qf + 128 * ML_R + s * ML_R + c * 8) = q1; }
    { const int idx = tid + NTHR * it, s = idx & 127, c = idx >> 7;
      const u32x4 vc = *(const u32x4*)(proj + (m0 + s) * NPROJ + C_VM + hh * 64 + c * 8);
#pragma unroll
      for (int k = 0; k < 4; ++k) { Vt[(8 * c + 2 * k) * ML_T + s] = (bf16_t)(vc[k] & 0xffffu); Vt[(8 * c + 2 * k + 1) * ML_T + s] = (bf16_t)(vc[k] >> 16); } }
  }
#pragma unroll
  for (int dir = 0; dir < 2; ++dir) { const float* sp = stU + (size_t)(item * 2 + dir) * 4096;
#pragma unroll
    for (int it = 0; it < 8; ++it) { const int idx = tid + NTHR * it, d = idx >> 6, e = idx & 63; St[dir * 64 * ML_R + e * ML_R + d] = f2bf(sp[idx]); } }
  __syncthreads();
  if (tid < 256) { const int dir = tid >> 7, j = tid & 127; const bf16_t* qp = Qr + j * ML_R; float s = 0.f;
#pragma unroll
    for (int d8 = 0; d8 < 8; ++d8) { const u32x4 qv = *(const u32x4*)(qp + d8 * 8); const f32x4 n0 = *(const f32x4*)(nss + dir * 64 + d8 * 8), n1 = *(const f32x4*)(nss + dir * 64 + d8 * 8 + 4);
      s += bflo(qv[0]) * n0[0] + bfhi(qv[0]) * n0[1] + bflo(qv[1]) * n0[2] + bfhi(qv[1]) * n0[3] + bflo(qv[2]) * n1[0] + bfhi(qv[2]) * n1[1] + bflo(qv[3]) * n1[2] + bfhi(qv[3]) * n1[3]; }
    dqs[tid] = s * ffs[tid]; }
  __syncthreads();
  f32x16 o[2]; o[0] = f32x16{}; o[1] = f32x16{};
  const int dir = wid >> 2, jb = wid & 3;
  {
    const int jrow = 32 * jb + r32; const float Mj = Mls[dir * 128 + jrow]; float den = 0.f;
    const int st_lo = dir ? jb : 0, st_hi = dir ? 3 : jb;
    for (int st = st_lo; st <= st_hi; ++st) {
      f32x16 sc2 = f32x16{};
      const bf16_t* ap = Kr + (32 * st + r32) * ML_R + hi * 8; const bf16_t* bp = Qr + jrow * ML_R + hi * 8;
#pragma unroll
      for (int kk = 0; kk < 4; ++kk) sc2 = MFMA32(*(const bf16x8*)(ap + kk * 16), *(const bf16x8*)(bp + kk * 16), sc2);
      float pv[16];
#pragma unroll
      for (int r = 0; r < 16; ++r) { const int s = 32 * st + crow(r, hi); const bool valid = dir ? (s >= jrow) : (s <= jrow);
        const float x = fminf(als[dir * 128 + s] - Mj, 0.f); const float w = valid ? 0.125f * __expf(x) : 0.f;
        pv[r] = sc2[r] * w; den += pv[r]; }
      bf16x8 pa0, pa1; PK4(pv, 0, pa0); PK4(pv, 8, pa1);
#pragma unroll
      for (int d0 = 0; d0 < 2; ++d0) { const bf16_t* vp = Vt + (32 * d0 + r32) * ML_T + 32 * st + hi * 8;
        o[d0] = MFMA32(pa0, *(const bf16x8*)(vp), o[d0]); o[d0] = MFMA32(pa1, *(const bf16x8*)(vp + 16), o[d0]); }
    }
    { const bf16_t* ap = Qf + dir * 128 * ML_R + jrow * ML_R + hi * 8;
#pragma unroll
      for (int kk = 0; kk < 4; ++kk) { const bf16x8 a = *(const bf16x8*)(ap + kk * 16);
#pragma unroll
        for (int d0 = 0; d0 < 2; ++d0) o[d0] = MFMA32(a, *(const bf16x8*)(St + dir * 64 * ML_R + (32 * d0 + r32) * ML_R + kk * 16 + hi * 8), o[d0]); } }
    den += __shfl_xor(den, 32);
    den += dqs[dir * 128 + jrow];
    const float flo = __expf(-(bbs[dir * 128 + jrow] + Mj));
    const float inv = __builtin_amdgcn_rcpf(fmaxf(fabsf(den), flo));
    if (hi == 0) invs[wid * 32 + r32] = inv;
    asm volatile("s_waitcnt lgkmcnt(0)" ::: "memory");
  }
  if (dir == 0) {
#pragma unroll
    for (int r = 0; r < 16; ++r) { const int jr = crow(r, hi); const float iv = invs[wid * 32 + jr];
      H[(32 * jb + jr) * 64 + r32] = o[0][r] * iv; H[(32 * jb + jr) * 64 + 32 + r32] = o[1][r] * iv; }
  }
  __syncthreads();
  if (dir == 1) {
#pragma unroll
    for (int r = 0; r < 16; ++r) { const int jr = crow(r, hi); const float iv = invs[wid * 32 + jr];
      H[(32 * jb + jr) * 64 + r32] += o[0][r] * iv; H[(32 * jb + jr) * 64 + 32 + r32] += o[1][r] * iv; }
  }
  __syncthreads();
  { const int j = tid >> 2, qd = tid & 3; float hv[16]; float s = 0.f;
#pragma unroll
    for (int e = 0; e < 16; ++e) { hv[e] = H[j * 64 + qd * 16 + e]; s += hv[e]; }
    s += __shfl_xor(s, 1); s += __shfl_xor(s, 2);
    const float mu = s * (1.f / 64.f); float q = 0.f;
#pragma unroll
    for (int e = 0; e < 16; ++e) { const float d = hv[e] - mu; q += d * d; }
    q += __shfl_xor(q, 1); q += __shfl_xor(q, 2);
    const float rstd = rsqrtf(q * (1.f / 64.f) + LN_EPS);
    const bf16_t* op = proj + (m0 + j) * NPROJ + C_OM + hh * 64 + qd * 16;
    const u32x4 oa = *(const u32x4*)op, ob = *(const u32x4*)(op + 8);
    const float* ng = norm_g + hh * 64 + qd * 16;
    float y[16];
#pragma unroll
    for (int k = 0; k < 4; ++k) {
      const float g0 = bflo(oa[k]), g1 = bfhi(oa[k]), g2 = bflo(ob[k]), g3 = bfhi(ob[k]);
      y[2 * k] = (hv[2 * k] - mu) * rstd * ng[2 * k] * __builtin_amdgcn_rcpf(1.f + __builtin_amdgcn_exp2f(-1.4426950408889634f * g0));
      y[2 * k + 1] = (hv[2 * k + 1] - mu) * rstd * ng[2 * k + 1] * __builtin_amdgcn_rcpf(1.f + __builtin_amdgcn_exp2f(-1.4426950408889634f * g1));
      y[8 + 2 * k] = (hv[8 + 2 * k] - mu) * rstd * ng[8 + 2 * k] * __builtin_amdgcn_rcpf(1.f + __builtin_amdgcn_exp2f(-1.4426950408889634f * g2));
      y[8 + 2 * k + 1] = (hv[8 + 2 * k + 1] - mu) * rstd * ng[8 + 2 * k + 1] * __builtin_amdgcn_rcpf(1.f + __builtin_amdgcn_exp2f(-1.4426950408889634f * g3));
    }
    u32x4 w0 = {pk2(y[0], y[1]), pk2(y[2], y[3]), pk2(y[4], y[5]), pk2(y[6], y[7])}, w1 = {pk2(y[8], y[9]), pk2(y[10], y[11]), pk2(y[12], y[13]), pk2(y[14], y[15])};
    bf16_t* yp = Y + (m0 + j) * 1024 + 768 + hh * 64 + qd * 16;
    *(u32x4*)yp = w0; *(u32x4*)(yp + 8) = w1; }
  __syncthreads();
}

__device__ __forceinline__ bool tile_order(int i, int G, int c, int nM, int nN, int& pm, int& pn) {
  const int nwg = nM * nN; const long L = (long)i * G + c; if (L >= nwg) return false;
  int wgid = (int)L; { const int q = nwg / 8, r = nwg % 8, xcd = wgid % 8, off = wgid / 8; wgid = (xcd < r ? xcd * (q + 1) : r * (q + 1) + (xcd - r) * q) + off; }
  const int nig = 8 * nN, gid = wgid / nig, fm = gid * 8, gsz = (nM - fm) < 8 ? (nM - fm) : 8;
  pm = fm + ((wgid % nig) % gsz); pn = (wgid % nig) / gsz; return true;
}

#define XB_TMO      128
#define XB_XCNT(j)  (256  + 64 * (j))
#define XB_XSUB(j)  (1280 + 64 * (j))
#define XB_XGEN(j)  (2304 + 64 * (j))
#define XB_TOP      3328
#define XB_TOPGEN   3392
#define XCD_BAR_WORDS 3456
#define XB_SPIN_CAP (1u << 18)
#define LAS __attribute__((address_space(3)))

__device__ __forceinline__ unsigned xb_ld(unsigned* p)              { return __hip_atomic_load(p, __ATOMIC_RELAXED, __HIP_MEMORY_SCOPE_AGENT); }
__device__ __forceinline__ unsigned xb_add(unsigned* p, unsigned v) { return __hip_atomic_fetch_add(p, v, __ATOMIC_RELAXED, __HIP_MEMORY_SCOPE_AGENT); }
__device__ __forceinline__ unsigned xb_xcc_id() { return (unsigned)__builtin_amdgcn_s_getreg((3 << 11) | 20) & 0xFu; }
#define XB_SPIN(cond, bar) do { unsigned _sp = 0; while (cond) { __builtin_amdgcn_s_sleep(1); \
    if ((++_sp & 255u) == 0u) { if (xb_ld(&(bar)[XB_TMO])) break; if (_sp > XB_SPIN_CAP) { atomicAdd(&(bar)[XB_TMO], 1u); break; } } } } while (0)

struct XcdBarrier {
    unsigned* bar; unsigned x;
    volatile LAS unsigned* st;
};

__device__ __forceinline__ XcdBarrier xcd_barrier_post(unsigned* bar, volatile LAS unsigned* st) {
    XcdBarrier b; b.bar = bar; b.x = xb_xcc_id(); b.st = st;
    if (threadIdx.x == 0) (void)xb_add(&bar[XB_XCNT(b.x)], 1u);
    return b;
}
__device__ __forceinline__ void xcd_barrier_complete(unsigned* bar, unsigned x, unsigned& nloc, unsigned& nx) {
    const unsigned G = gridDim.x * gridDim.y * gridDim.z;
    unsigned sum, cnt, mine, sp = 0u;
    for (;;) {
        sum = 0u; cnt = 0u; mine = 0u;
#pragma unroll
        for (unsigned j = 0; j < 16; ++j) { const unsigned c = xb_ld(&bar[XB_XCNT(j)]); sum += c; cnt += (c > 0u) ? 1u : 0u; mine = (j == x) ? c : mine; }
        if (sum == G) break;
        __builtin_amdgcn_s_sleep(1);
        if ((++sp & 255u) == 0u) { if (xb_ld(&bar[XB_TMO])) break; if (sp > XB_SPIN_CAP) { atomicAdd(&bar[XB_TMO], 1u); break; } }
    }
    nloc = mine > 0u ? mine : 1u; nx = cnt > 0u ? cnt : 1u;
}

__device__ __forceinline__ void xcd_barrier(const XcdBarrier& b) {
    asm volatile("s_waitcnt vmcnt(0)" ::: "memory");
    __syncthreads();
    if (threadIdx.x == 0) {
        unsigned* bar = b.bar;
        __builtin_amdgcn_s_waitcnt(0);
        unsigned nloc = b.st[0], nx = b.st[1];
        if (nloc == 0u) { xcd_barrier_complete(bar, b.x, nloc, nx); b.st[0] = nloc; b.st[1] = nx; }
        const unsigned old = xb_add(&bar[XB_XSUB(b.x)], 1u);
        const unsigned gen = old / nloc;
        if (old + 1u == (gen + 1u) * nloc) {
            __builtin_amdgcn_fence(__ATOMIC_RELEASE, "agent");
            asm volatile("s_waitcnt vmcnt(0)" ::: "memory");
            const unsigned og = xb_add(&bar[XB_TOP], 1u);
            const unsigned tg = og / nx;
            if (og + 1u == (tg + 1u) * nx) xb_add(&bar[XB_TOPGEN], 1u);
            else XB_SPIN(xb_ld(&bar[XB_TOPGEN]) == tg, bar);
            __builtin_amdgcn_fence(__ATOMIC_ACQUIRE, "agent");
            xb_add(&bar[XB_XGEN(b.x)], 1u);
            asm volatile("s_waitcnt vmcnt(0)" ::: "memory");
        } else {
            XB_SPIN(xb_ld(&bar[XB_XGEN(b.x)]) == gen, bar);
            __builtin_amdgcn_fence(__ATOMIC_ACQUIRE, "agent");
            asm volatile("s_waitcnt vmcnt(0)" ::: "memory");
        }
    }
    __syncthreads();
}

constexpr int PH_PER_TRUNK = 1 + 8 * DEPTH, N_PHASES = 1 + 2 * PH_PER_TRUNK;

__device__ void run_phase(const Params& p, int ph, char* smem) {
  if (ph == 0) { if (blockIdx.x == 0) { const int t0 = otid();
      ((unsigned*)(p.ws + OFF_CNT))[t0] = 0u; ((unsigned*)(p.ws + OFF_CNT))[t0 + NTHR] = 0u;
      float* idv = (float*)(p.ws + OFF_ID); idv[t0] = 1.f; idv[t0 + NTHR] = 1.f; idv[1024 + t0] = 0.f; idv[1024 + t0 + NTHR] = 0.f; }
    phase_prep(p, smem); return; }
  const int tr = (ph - 1) / PH_PER_TRUNK, q = (ph - 1) % PH_PER_TRUNK;
  const int S = tr ? 2048 : 16384, slog = tr ? 11 : 14, nseq = tr ? 16 : 2;
  float* x32 = p.out + (size_t)tr * MT * 1024;
  unsigned char* ws = p.ws;
  bf16_t* XB = (bf16_t*)(ws + OFF_XB); bf16_t* Y = (bf16_t*)(ws + OFF_Y); bf16_t* PROJ = (bf16_t*)(ws + OFF_PROJ);
  bf16_t* Qb = (bf16_t*)(ws + OFF_Q); bf16_t* KN = (bf16_t*)(ws + OFF_KN); bf16_t* VT = (bf16_t*)(ws + OFF_VT); bf16_t* KR = (bf16_t*)(ws + OFF_KR);
  float* GATES = (float*)(ws + OFF_GATES); float* STU = (float*)(ws + OFF_STU); float* STN = (float*)(ws + OFF_STN); float* STS = (float*)(ws + OFF_STS);
  bf16_t* HID = (bf16_t*)(ws + OFF_HID); const f32x2* ROPE = (const f32x2*)(ws + OFF_ROPE);
  f32x2* STAT = (f32x2*)(ws + OFF_STAT); const float* IDV = (const float*)(ws + OFF_ID);
  if (q == 0) { phase_ln(p.in[tr], x32, XB, p.in[2], p.in[3], MT, STAT, true); return; }
  const int l = (q - 1) / 8, sub = (q - 1) % 8;
  const unsigned char* wl = ws + OFF_W + (size_t)l * W_LAYER;
  const int G = gridDim.x, B = blockIdx.x;
#ifdef ONLY_SUB
  switch (ONLY_SUB) {
#else
  switch (sub) {
#endif
    case 0: {
      pg8::Gemm g{XB, (const bf16_t*)(wl + W_IN), MT, NPROJ, 1024, 1024}; pg8::StaticOrder So; So.init(MT, NPROJ, G, B);
      pg8::EpiInProj2 E{PROJ, GATES};
      pg8::gemm_phase<pg8::EpiInProj2, pg8::StaticOrder, true, true>((PG8_LAS unsigned char*)smem, g, So, E);
    } break;
    case 1: {
      float* rs = (float*)(smem + G_SMEM_BYTES);
      for (int rep1 = 0; rep1 < REP_P1; ++rep1) {
      for (int i = 0, pm, pn; tile_order(i, G, B, 128, 3, pm, pn); ++i) {
        row_rms(PROJ + C_CQ, NPROJ, 256, pm * 256, rs); EpiQUp E{Qb, rs, ROPE, S - 1, smem};
        gemm_tile(PROJ + C_CQ, NPROJ, (const bf16_t*)(wl + W_UQ), 256, pm * 256, pn * 256, smem, E);
        __syncthreads();
      }
      for (int i = 0, pm, pn; tile_order(i, G, B, 128, 4, pm, pn); ++i) {
        row_rms(PROJ + C_CKV, NPROJ, 128, pm * 256, rs); EpiKVUp E{KN, VT, rs, S, slog, S - 1, smem};
        gemm_tile(PROJ + C_CKV, NPROJ, (const bf16_t*)(wl + W_UKV), 128, pm * 256, pn * 256, smem, E);
        __syncthreads();
      }
      phase_pool_rope(PROJ, Y, KR, ROPE, S);
      for (int t = B; t < 256 * 4; t += G) mlstm_pass1(t >> 2, t & 3, PROJ, GATES, p.in[11] + l * 16, STU, STN, STS, smem);
      }
    } break;
    case 2: {
      unsigned* cnt = (unsigned*)(ws + OFF_CNT) + (tr * DEPTH + l) * 64;
      if (B < 128) {
        if (tr == 0) mlstm_pass2<1, 32>(B >> 3, B & 7, S >> 7, STU, STN, STS); else mlstm_pass2<8, 4>(B, 0, S >> 7, STU, STN, STS);
        __builtin_amdgcn_fence(__ATOMIC_RELEASE, "agent");
        asm volatile("s_waitcnt vmcnt(0)" ::: "memory");
        __syncthreads();
        if (threadIdx.x == 0) __hip_atomic_fetch_add(cnt, 1u, __ATOMIC_RELEASE, __HIP_MEMORY_SCOPE_AGENT);
      }
      const int nqb = S >> 8;
      for (int t0 = B; t0 < 1024; t0 += G) { const int t = (G == 256) ? (t0 & ~255) + (B & 7) * 32 + (B >> 3) : t0; const int qb = t % nqb, bh = t / nqb; attn_unit(Qb, KN, VT, KR, Y, S, bh >> 3, bh & 7, qb, smem); }
      if (threadIdx.x == 0) { while (__hip_atomic_load(cnt, __ATOMIC_ACQUIRE, __HIP_MEMORY_SCOPE_AGENT) < 128u) __builtin_amdgcn_s_sleep(2); }
      __syncthreads();
      __builtin_amdgcn_fence(__ATOMIC_ACQUIRE, "agent");
      asm volatile("s_waitcnt vmcnt(0)" ::: "memory");
      for (int t = B; t < 256 * 4; t += G) mlstm_pass3(t >> 2, t & 3, PROJ, GATES, p.in[11] + l * 16, p.in[12] + l * 256, STU, STN, STS, Y, smem);
    } break;
    case 3: {
      pg8::Gemm g{Y, (const bf16_t*)(wl + W_OUT), MT, 1024, 1024, 1024}; pg8::StaticOrder So; So.init(MT, 1024, G, B);
      pg8::EpiResid2 E{x32, STAT, l ? p.in[19] + (l - 1) * 1024 : IDV, l ? p.in[20] + (l - 1) * 1024 : IDV + 1024};
      pg8::gemm_phase<pg8::EpiResid2, pg8::StaticOrder, true, true>((PG8_LAS unsigned char*)smem, g, So, E);
    } break;
    case 4: phase_ln(x32, nullptr, XB, p.in[14] + l * 1024, p.in[15] + l * 1024, MT, STAT, false); break;
    case 5: {
      pg8::Gemm g{XB, (const bf16_t*)(wl + W_GU), MT, NGU, 1024, 1024}; pg8::StaticOrder So; So.init(MT, NGU, G, B);
      pg8::EpiGU2 E{HID};
      pg8::gemm_phase<pg8::EpiGU2, pg8::StaticOrder, true, true>((PG8_LAS unsigned char*)smem, g, So, E);
    } break;
    case 6: {
      pg8::Gemm g{HID, (const bf16_t*)(wl + W_DN), MT, 1024, DFF, DFF}; pg8::StaticOrder So; So.init(MT, 1024, G, B);
      pg8::EpiResid2 E{x32, STAT, p.in[14] + l * 1024, p.in[15] + l * 1024};
      pg8::gemm_phase<pg8::EpiResid2, pg8::StaticOrder, true, true>((PG8_LAS unsigned char*)smem, g, So, E);
    } break;
    case 7: phase_ln(x32, (l == DEPTH - 1) ? x32 : nullptr, XB, p.in[19] + l * 1024, p.in[20] + l * 1024, MT, STAT, false); break;
  }
}

__global__ void __launch_bounds__(NTHR) fwd_kernel(Params p) {
  extern __shared__ __attribute__((aligned(16))) char smem[];
  cg::grid_group grid = cg::this_grid();
  volatile LAS unsigned* st = (volatile LAS unsigned*)((LAS unsigned char*)smem + (LDS_BYTES - 16));
  if (threadIdx.x < 2) st[threadIdx.x] = 0u;
  __syncthreads();
  XcdBarrier xb = xcd_barrier_post((unsigned*)(p.ws + OFF_XBAR), st);
  for (int ph = p.ph_lo; ph < p.ph_hi; ++ph) {
    run_phase(p, ph, smem);
    if (ph + 1 < p.ph_hi) {
      if (ph == p.ph_lo) grid.sync();
      else xcd_barrier(xb);
    }
  }
}

extern "C" void kernel_launch(void* const* d_in, const int* in_sizes, int n_in, void* d_out, int out_size, void* d_ws, size_t ws_size, hipStream_t stream) {
  static int grid_blocks = 0;
  if (!grid_blocks) {
    int dev = 0, cus = 0, per_cu = 0;
    hipGetDevice(&dev);
    hipDeviceGetAttribute(&cus, hipDeviceAttributeMultiprocessorCount, dev);
    hipFuncSetAttribute((const void*)fwd_kernel, hipFuncAttributeMaxDynamicSharedMemorySize, LDS_BYTES);
    hipOccupancyMaxActiveBlocksPerMultiprocessor(&per_cu, (const void*)fwd_kernel, NTHR, LDS_BYTES);
    if (per_cu < 1) per_cu = 1;
    grid_blocks = cus * per_cu;
    if (ws_size < OFF_END) fprintf(stderr, "kernel_launch: workspace too small (%zu < %zu)\n", ws_size, (size_t)OFF_END);
  }
  Params p{};
  for (int i = 0; i < 21; ++i) p.in[i] = (const float*)d_in[i];
  p.out = (float*)d_out; p.ws = (unsigned char*)d_ws;
#if ONE_LAUNCH
  p.ph_lo = 0; p.ph_hi = N_PHASES;
  (void)hipMemsetAsync((char*)d_ws + OFF_XBAR, 0, XCD_BAR_WORDS * 4, stream);
  void* args[] = {&p};
  hipError_t e = hipLaunchCooperativeKernel((const void*)fwd_kernel, dim3(grid_blocks), dim3(NTHR), args, LDS_BYTES, stream);
  if (e != hipSuccess) fprintf(stderr, "cooperative launch failed: %s (grid %d)\n", hipGetErrorString(e), grid_blocks);
#else
  for (int ph = 0; ph < N_PHASES; ++ph) { p.ph_lo = ph; p.ph_hi = ph + 1; hipLaunchKernelGGL(fwd_kernel, dim3(grid_blocks), dim3(NTHR), LDS_BYTES, stream, p); }
#endif
}
```

```cpp
#include <hip/hip_runtime.h>
#include <hip/hip_cooperative_groups.h>
#include <stdint.h>
#include <stdio.h>
namespace cg = cooperative_groups;

#ifndef REP_P1
#define REP_P1 1
#endif
#ifndef REP_P3
#define REP_P3 1
#endif
#ifndef REP_LN
#define REP_LN 1
#endif
#ifndef ONE_LAUNCH
#define ONE_LAUNCH 1
#endif

typedef unsigned short bf16_t;
typedef short bf16x8 __attribute__((ext_vector_type(8)));
typedef float f32x16 __attribute__((ext_vector_type(16)));
typedef float f32x4 __attribute__((ext_vector_type(4)));
typedef float f32x2 __attribute__((ext_vector_type(2)));
typedef unsigned u32x4 __attribute__((ext_vector_type(4)));
typedef unsigned u32x2 __attribute__((ext_vector_type(2)));
typedef __bf16 bf16x2_t __attribute__((ext_vector_type(2)));

constexpr int DM = 1024, DEPTH = 4, MT = 32768;
constexpr int NPROJ = 1792, INW = 1712, DFF = 2816, NGU = 5632;
constexpr int C_CQ = 0, C_CKV = 256, C_KR = 384, C_POOL = 416, C_QM = 672, C_KM = 928, C_VM = 1184, C_OM = 1440, C_G = 1696;
constexpr float LN_EPS = 1e-5f;
constexpr float DN_ALPHA = 1.6817928305074290f;
constexpr float QSCALE = 0.10206207261596577f * 1.4426950408889634f;
constexpr int NTHR = 512;

constexpr size_t MiB = 1u << 20;
constexpr size_t W_IN = 0, W_UQ = W_IN + (size_t)NPROJ * 1024 * 2, W_UKV = W_UQ + 768 * 256 * 2, W_OUT = W_UKV + 1024 * 128 * 2,
                 W_GU = W_OUT + 1024 * 1024 * 2, W_DN = W_GU + (size_t)NGU * 1024 * 2, W_LAYER = W_DN + (size_t)1024 * DFF * 2;
static_assert(W_LAYER * 4 <= 96 * MiB, "weights");
constexpr size_t OFF_W = 0, OFF_ROPE = 96 * MiB, OFF_XB = 98 * MiB, OFF_Y = 162 * MiB, OFF_R = 226 * MiB;
constexpr size_t OFF_PROJ = OFF_R, OFF_Q = OFF_R + 112 * MiB, OFF_KN = OFF_Q + 48 * MiB, OFF_VT = OFF_KN + 32 * MiB, OFF_KR = OFF_VT + 32 * MiB,
                 OFF_GATES = OFF_KR + 2 * MiB, OFF_STU = OFF_GATES + 2 * MiB, OFF_STN = OFF_STU + 32 * MiB, OFF_STS = OFF_STN + 1 * MiB, OFF_END = OFF_STS + 1 * MiB;
constexpr size_t OFF_HID = OFF_R;
constexpr size_t OFF_CNT = OFF_END;
constexpr size_t OFF_XBAR = OFF_END + 4096;
constexpr size_t OFF_STAT = OFF_XBAR + 16384;
constexpr size_t OFF_ID = OFF_STAT + (size_t)MT * 8;
static_assert(OFF_ID + 8192 <= 512 * MiB, "ws");
static_assert(OFF_HID + (size_t)MT * DFF * 2 <= OFF_END, "hid");

constexpr int LDS_BYTES = 151552;

struct Params {
  const float* in[21];
  float* out;
  unsigned char* ws;
  int ph_lo, ph_hi;
};

__device__ __forceinline__ unsigned pk2(float lo, float hi) { f32x2 v = {lo, hi}; bf16x2_t b = __builtin_convertvector(v, bf16x2_t); return __builtin_bit_cast(unsigned, b); }
__device__ __forceinline__ bf16_t f2bf(float x) { return (bf16_t)(pk2(x, 0.f) & 0xffffu); }
__device__ __forceinline__ float bf2f(bf16_t b) { return __uint_as_float(((unsigned)b) << 16); }
__device__ __forceinline__ float bflo(unsigned w) { return __uint_as_float(w << 16); }
__device__ __forceinline__ float bfhi(unsigned w) { return __uint_as_float(w & 0xffff0000u); }
__device__ __forceinline__ int crow(int r, int hi) { return (r & 3) + 8 * (r >> 2) + 4 * hi; }
__device__ __forceinline__ float wave_sum(float v) {
  v += __shfl_xor(v, 32); v += __shfl_xor(v, 16); v += __shfl_xor(v, 8); v += __shfl_xor(v, 4); v += __shfl_xor(v, 2); v += __shfl_xor(v, 1); return v;
}
__device__ __forceinline__ int otid() { int t = threadIdx.x; asm volatile("" : "+v"(t)); return t; }
#define MFMA32(a, b, c) __builtin_amdgcn_mfma_f32_32x32x16_bf16((a), (b), (c), 0, 0, 0)
#define PK4(P, BASE, OUT) do { unsigned a0_ = pk2(P[BASE + 0], P[BASE + 1]), a1_ = pk2(P[BASE + 2], P[BASE + 3]);   \
    unsigned b0_ = pk2(P[BASE + 4], P[BASE + 5]), b1_ = pk2(P[BASE + 6], P[BASE + 7]);                              \
    auto r0_ = __builtin_amdgcn_permlane32_swap(a0_, b0_, false, false); auto r1_ = __builtin_amdgcn_permlane32_swap(a1_, b1_, false, false); \
    u32x4 w_ = {r0_[0], r1_[0], r0_[1], r1_[1]}; OUT = __builtin_bit_cast(bf16x8, w_); } while (0)

__device__ void prep_tile(const float* srcA, int colA, int limA, const float* srcB, int colB, int limB, int ld, int k0,
                          const float* kscale, float mul, bf16_t* dst, int ldd, int n0, float* tile) {
  const int tid = otid();
#pragma unroll
  for (int i = 0; i < 8; ++i) {
    const int kk = (tid >> 6) + 8 * i, nn = tid & 63;
    float v = 0.f;
    if (nn < 32) { const int c = colA + nn; if (c < limA) v = srcA[(size_t)(k0 + kk) * ld + c]; }
    else { const int c = colB + nn - 32; if (c < limB) v = srcB[(size_t)(k0 + kk) * ld + c]; }
    if (kscale) v *= kscale[k0 + kk];
    tile[kk * 65 + nn] = v * mul;
  }
  __syncthreads();
  { const int nn = tid >> 3, kc = tid & 7; u32x4 w;
#pragma unroll
    for (int j = 0; j < 4; ++j) w[j] = pk2(tile[(kc * 8 + 2 * j) * 65 + nn], tile[(kc * 8 + 2 * j + 1) * 65 + nn]);
    *(u32x4*)(dst + (size_t)(n0 + nn) * ldd + k0 + kc * 8) = w; }
  __syncthreads();
}

__device__ void phase_prep(const Params& p, char* smem) {
  float* tile = (float*)smem;
  const int tid = otid();
  constexpr int N_IN = 28 * 16, N_UQ = 12 * 4, N_UKV = 16 * 2, N_OUT = 16 * 12, N_PF = 4 * 16, N_GU = 88 * 16, N_DN = 16 * 44;
  constexpr int PER_LAYER = N_IN + N_UQ + N_UKV + N_OUT + N_PF + N_GU + N_DN;
  constexpr int N_ROPE = 16384 * 16 / NTHR;
  const int total = PER_LAYER * DEPTH + N_ROPE;
  for (int it = blockIdx.x; it < total; it += gridDim.x) {
    if (it >= PER_LAYER * DEPTH) {
      const int e = (it - PER_LAYER * DEPTH) * NTHR + tid, pos = e >> 4, i = e & 15;
      const float inv = exp2f(-(float)i * (13.287712379549449f / 16.0f));
      const float ang = (float)pos * inv;
      double rev = (double)ang * 0.15915494309189535; rev -= floor(rev);
      const float fr = (float)rev;
      f32x2 cs = {__builtin_amdgcn_cosf(fr), __builtin_amdgcn_sinf(fr)};
      ((f32x2*)(p.ws + OFF_ROPE))[e] = cs;
      continue;
    }
    const int l = it / PER_LAYER; int j = it % PER_LAYER;
    unsigned char* wl = p.ws + OFF_W + (size_t)l * W_LAYER;
    if (j < N_IN) { const int nt = j / 16, kt = j % 16; const float* s = p.in[4] + (size_t)l * 1024 * INW;
      prep_tile(s, nt * 64, INW, s, nt * 64 + 32, INW, INW, kt * 64, nullptr, 1.f, (bf16_t*)(wl + W_IN), 1024, nt * 64, tile); continue; }
    j -= N_IN;
    if (j < N_UQ) { const int nt = j / 4, kt = j % 4; const float* s = p.in[6] + (size_t)l * 256 * 768;
      prep_tile(s, nt * 64, 768, s, nt * 64 + 32, 768, 768, kt * 64, p.in[5] + l * 256, QSCALE, (bf16_t*)(wl + W_UQ), 256, nt * 64, tile); continue; }
    j -= N_UQ;
    if (j < N_UKV) { const int nt = j / 2, kt = j % 2; const float* s = p.in[8] + (size_t)l * 128 * 1024;
      prep_tile(s, nt * 64, 1024, s, nt * 64 + 32, 1024, 1024, kt * 64, p.in[7] + l * 128, 1.f, (bf16_t*)(wl + W_UKV), 128, nt * 64, tile); continue; }
    j -= N_UKV;
    if (j < N_OUT) { const int nt = j / 12; int kt = j % 12; if (kt >= 8) kt += 4; const float* s = p.in[13] + (size_t)l * 1024 * 1024;
      prep_tile(s, nt * 64, 1024, s, nt * 64 + 32, 1024, 1024, kt * 64, nullptr, 1.f, (bf16_t*)(wl + W_OUT), 1024, nt * 64, tile); continue; }
    j -= N_OUT;
    if (j < N_PF) {
      const int g = j / 16, n0 = (j % 16) * 64, nn = tid & 63;
      const float* wo = p.in[13] + (size_t)l * 1024 * 1024 + (size_t)(512 + g * 64) * 1024 + n0 + nn;
      const float* wp = p.in[9] + (size_t)l * 4 * 64 * 64 + (size_t)g * 64 * 64;
      const float* ps = p.in[10] + l * 256 + g * 64;
      bf16_t* dst = (bf16_t*)(wl + W_OUT);
      for (int i = 0; i < 8; ++i) {
        const int c = (tid >> 6) + 8 * i; float s = 0.f;
        for (int d = 0; d < 64; ++d) s += wp[c * 64 + d] * ps[d] * wo[(size_t)d * 1024];
        dst[(size_t)(n0 + nn) * 1024 + 512 + g * 64 + c] = f2bf(s);
      }
      continue; }
    j -= N_PF;
    if (j < N_GU) { const int nt = j / 16, kt = j % 16, T = nt >> 2, sb = nt & 3;
      const float* s = ((sb < 2) ? p.in[16] : p.in[17]) + (size_t)l * 1024 * DFF; const int c0 = 128 * T + 64 * (sb & 1);
      prep_tile(s, c0, DFF, s, c0 + 32, DFF, DFF, kt * 64, nullptr, 1.f, (bf16_t*)(wl + W_GU), 1024, nt * 64, tile); continue; }
    j -= N_GU;
    { const int nt = j / 44, kt = j % 44; const float* s = p.in[18] + (size_t)l * DFF * 1024;
      prep_tile(s, nt * 64, 1024, s, nt * 64 + 32, 1024, 1024, kt * 64, nullptr, 1.f, (bf16_t*)(wl + W_DN), DFF, nt * 64, tile); }
  }
}

__device__ void phase_ln(const float* src, float* dst32, bf16_t* dstb, const float* g, const float* bta, int nrows, f32x2* stats, bool ident) {
  const int tid = otid(); const int lane = tid & 63, wid = tid >> 6;
  f32x4 gv[4], bv[4];
#pragma unroll
  for (int j = 0; j < 4; ++j) { gv[j] = *(const f32x4*)(g + j * 256 + lane * 4); bv[j] = *(const f32x4*)(bta + j * 256 + lane * 4); }
  const int rstride = gridDim.x * 8;
  for (int row0 = blockIdx.x * 8 + wid; row0 < nrows; row0 += 2 * rstride) {
    f32x4 v[2][4];
    const bool two = (row0 + rstride) < nrows;
#pragma unroll
    for (int j = 0; j < 4; ++j) v[0][j] = *(const f32x4*)(src + (size_t)row0 * 1024 + j * 256 + lane * 4);
    if (two) {
#pragma unroll
      for (int j = 0; j < 4; ++j) v[1][j] = *(const f32x4*)(src + (size_t)(row0 + rstride) * 1024 + j * 256 + lane * 4);
    }
#pragma unroll
    for (int u = 0; u < 2; ++u) {
      if (u == 1 && !two) break;
      const int row = row0 + u * rstride;
      float s = 0.f;
#pragma unroll
      for (int j = 0; j < 4; ++j) s += (v[u][j][0] + v[u][j][1]) + (v[u][j][2] + v[u][j][3]);
      const float mean = wave_sum(s) * (1.f / 1024.f);
      float q = 0.f;
#pragma unroll
      for (int j = 0; j < 4; ++j) { f32x4 d = v[u][j] - mean; q += (d[0] * d[0] + d[1] * d[1]) + (d[2] * d[2] + d[3] * d[3]); }
      const float rstd = rsqrtf(wave_sum(q) * (1.f / 1024.f) + LN_EPS);
      if (lane == 0) { f32x2 sv = {ident ? 0.f : mean, ident ? 1.f : rstd}; stats[row] = sv; }
#pragma unroll
      for (int j = 0; j < 4; ++j) {
        f32x4 o = (v[u][j] - mean) * rstd * gv[j] + bv[j];
        if (dst32) *(f32x4*)(dst32 + (size_t)row * 1024 + j * 256 + lane * 4) = o;
        u32x2 w = {pk2(o[0], o[1]), pk2(o[2], o[3])};
        *(u32x2*)(dstb + (size_t)row * 1024 + j * 256 + lane * 4) = w;
      }
    }
  }
}

constexpr int G_BUF = 256 * 64;
constexpr int G_SMEM_BYTES = 4 * G_BUF * 2;
#define LAS3 __attribute__((address_space(3)))

template <class Epi>
__device__ __forceinline__ void gemm_tile(const bf16_t* __restrict__ A, int lda, const bf16_t* __restrict__ Bt, int K, int m0, int n0, char* smem, const Epi& epi) {
  const int tid = otid(), lane = tid & 63, wid = tid >> 6, wm = wid >> 2, wn = wid & 3, r32 = lane & 31, hi = lane >> 5;
  LAS3 unsigned char* lds = (LAS3 unsigned char*)smem;
  const int rowl = wid * 8 + (lane >> 3), gch = (lane & 7) ^ ((rowl >> 1) & 7);
  const bf16_t* pa = A + (size_t)(m0 + rowl) * lda + gch * 8;
  const bf16_t* pb = Bt + (size_t)(n0 + rowl) * K + gch * 8;
  const size_t sa = (size_t)64 * lda, sb = (size_t)64 * K;
  const unsigned wbase = (unsigned)__builtin_amdgcn_readfirstlane(wid * 1024);
#define G_DMA(buf, k0) do { _Pragma("unroll") for (int j_ = 0; j_ < 4; ++j_) { \
    __builtin_amdgcn_global_load_lds((const unsigned*)(pa + j_ * sa + (k0)), (LAS3 unsigned*)(lds + (buf) * 32768 + j_ * 8192 + wbase), 16, 0, 0); \
    __builtin_amdgcn_global_load_lds((const unsigned*)(pb + j_ * sb + (k0)), (LAS3 unsigned*)(lds + 65536 + (buf) * 32768 + j_ * 8192 + wbase), 16, 0, 0); } } while (0)
  f32x16 acc[2][4];
#pragma unroll
  for (int a = 0; a < 2; ++a)
#pragma unroll
    for (int b = 0; b < 4; ++b) acc[a][b] = f32x16{};
  G_DMA(0, 0);
  asm volatile("s_waitcnt vmcnt(0)" ::: "memory");
  __syncthreads();
  const int nk = K >> 6;
  const int swz = (r32 >> 1) & 7;
  int koff[4];
#pragma unroll
  for (int kk = 0; kk < 4; ++kk) koff[kk] = ((kk * 2 + hi) ^ swz) * 16;
  const int aoff = (wm * 128 + r32) * 128, boff = 65536 + (wn * 64 + r32) * 128;
  for (int t = 0; t < nk; ++t) {
    const int buf = t & 1;
    if (t + 1 < nk) G_DMA(buf ^ 1, (t + 1) * 64);
    const LAS3 unsigned char* as = lds + buf * 32768 + aoff; const LAS3 unsigned char* bs = lds + buf * 32768 + boff;
    bf16x8 af[2][4], bfr[2][2];
#define G_LDF(S, KK) do { _Pragma("unroll") for (int mt = 0; mt < 4; ++mt) af[S][mt] = *(const LAS3 bf16x8*)(as + mt * 4096 + koff[KK]); \
      _Pragma("unroll") for (int nt = 0; nt < 2; ++nt) bfr[S][nt] = *(const LAS3 bf16x8*)(bs + nt * 4096 + koff[KK]); } while (0)
    G_LDF(0, 0);
#pragma unroll
    for (int kk = 0; kk < 4; ++kk) {
      if (kk < 3) G_LDF((kk + 1) & 1, kk + 1);
      __builtin_amdgcn_sched_barrier(0);
#pragma unroll
      for (int nt = 0; nt < 2; ++nt)
#pragma unroll
        for (int mt = 0; mt < 4; ++mt) acc[nt][mt] = MFMA32(bfr[kk & 1][nt], af[kk & 1][mt], acc[nt][mt]);
      __builtin_amdgcn_sched_barrier(0);
    }
#undef G_LDF
    asm volatile("s_waitcnt vmcnt(0)" ::: "memory");
    __syncthreads();
  }
#undef G_DMA
  epi(acc, m0, n0, wm, wn, r32, hi);
}

struct EpiInProj {
  bf16_t* proj; float* gates; char* smem;
  __device__ __forceinline__ void operator()(const f32x16 (&acc)[2][4], int m0, int n0, int wm, int wn, int r32, int hi) const {
    const int lane = r32 + 32 * hi, wid = wm * 4 + wn;
    bf16_t* wl = (bf16_t*)smem + wid * (32 * 72);
    const int c = lane & 7, rq = lane >> 3;
#pragma unroll
    for (int mt = 0; mt < 4; ++mt) {
      const int m = m0 + wm * 128 + mt * 32 + r32;
#pragma unroll
      for (int nt = 0; nt < 2; ++nt)
#pragma unroll
        for (int g = 0; g < 4; ++g) {
          const int nb = n0 + wn * 64 + nt * 32 + g * 8 + hi * 4;
          const f32x16& a = acc[nt][mt];
          u32x2 w = {pk2(a[4 * g], a[4 * g + 1]), pk2(a[4 * g + 2], a[4 * g + 3])};
          *(u32x2*)(wl + r32 * 72 + nt * 32 + g * 8 + hi * 4) = w;
          if (nb >= C_G && nb < INW) { f32x4 v = {a[4 * g], a[4 * g + 1], a[4 * g + 2], a[4 * g + 3]}; *(f32x4*)(gates + (size_t)m * 16 + (nb - C_G)) = v; }
        }
      asm volatile("s_waitcnt lgkmcnt(0)" ::: "memory");
#pragma unroll
      for (int i = 0; i < 4; ++i) {
        const int rr = rq + 8 * i;
        const u32x4 v = *(const u32x4*)(wl + rr * 72 + c * 8);
        *(u32x4*)(proj + (size_t)(m0 + wm * 128 + mt * 32 + rr) * NPROJ + n0 + wn * 64 + c * 8) = v;
      }
      asm volatile("s_waitcnt lgkmcnt(0)" ::: "memory");
    }
    __syncthreads();
  }
};

struct EpiQUp {
  bf16_t* Q; const float* rs; const f32x2* rope; int smask; char* smem;
  __device__ __forceinline__ void operator()(const f32x16 (&acc)[2][4], int m0, int n0, int wm, int wn, int r32, int hi) const {
    const int lane = r32 + 32 * hi, wid = wm * 4 + wn;
    bf16_t* wl = (bf16_t*)smem + wid * 2560;
    const int c = lane & 7, rq = lane >> 3;
#pragma unroll
    for (int mt = 0; mt < 4; ++mt) {
      const int ml = wm * 128 + mt * 32 + r32, m = m0 + ml; const float r = rs[ml]; const int pos = m & smask;
#pragma unroll
      for (int nt = 0; nt < 2; ++nt) {
        const int nb0 = n0 + wn * 64 + nt * 32; const int t32 = nb0 >> 5; const bool isrope = (t32 % 3) == 2;
        float v[16];
#pragma unroll
        for (int k = 0; k < 16; ++k) v[k] = acc[nt][mt][k] * r;
        if (isrope) {
#pragma unroll
          for (int g = 0; g < 2; ++g)
#pragma unroll
            for (int i = 0; i < 4; ++i) {
              const int dd = 8 * g + 4 * hi + i; const f32x2 cs = rope[pos * 16 + dd];
              const float x1 = v[4 * g + i], x2 = v[4 * g + i + 8];
              v[4 * g + i] = x1 * cs[0] - x2 * cs[1]; v[4 * g + i + 8] = x2 * cs[0] + x1 * cs[1];
            }
        }
#pragma unroll
        for (int g = 0; g < 4; ++g) { u32x2 w = {pk2(v[4 * g], v[4 * g + 1]), pk2(v[4 * g + 2], v[4 * g + 3])}; *(u32x2*)(wl + r32 * 72 + nt * 32 + g * 8 + hi * 4) = w; }
      }
      asm volatile("s_waitcnt lgkmcnt(0)" ::: "memory");
#pragma unroll
      for (int i = 0; i < 4; ++i) { const int rr = rq + 8 * i; const u32x4 w = *(const u32x4*)(wl + rr * 72 + c * 8);
        *(u32x4*)(Q + (size_t)(m0 + wm * 128 + mt * 32 + rr) * 768 + n0 + wn * 64 + c * 8) = w; }
      asm volatile("s_waitcnt lgkmcnt(0)" ::: "memory");
    }
  }
};

struct EpiKVUp {
  bf16_t* Kn; bf16_t* Vt; const float* rs; int S, slog, smask; char* smem;
  __device__ __forceinline__ void operator()(const f32x16 (&acc)[2][4], int m0, int n0, int wm, int wn, int r32, int hi) const {
    const int lane = r32 + 32 * hi, wid = wm * 4 + wn;
    bf16_t* wl = (bf16_t*)smem + wid * 2560;
    const int nbw = n0 + wn * 64, head = nbw >> 7; const bool isv = (nbw & 64) != 0;
#pragma unroll
    for (int mt = 0; mt < 4; ++mt) {
      const int ml = wm * 128 + mt * 32 + r32; const float r = rs[ml];
      const int mg = m0 + wm * 128 + mt * 32;
      if (!isv) {
#pragma unroll
        for (int nt = 0; nt < 2; ++nt)
#pragma unroll
          for (int g = 0; g < 4; ++g) { const f32x16& a = acc[nt][mt];
            u32x2 w = {pk2(a[4 * g] * r, a[4 * g + 1] * r), pk2(a[4 * g + 2] * r, a[4 * g + 3] * r)};
            *(u32x2*)(wl + r32 * 72 + nt * 32 + g * 8 + hi * 4) = w; }
        asm volatile("s_waitcnt lgkmcnt(0)" ::: "memory");
        const int c = lane & 7, rq = lane >> 3;
#pragma unroll
        for (int i = 0; i < 4; ++i) { const int rr = rq + 8 * i; const u32x4 w = *(const u32x4*)(wl + rr * 72 + c * 8);
          *(u32x4*)(Kn + (size_t)(mg + rr) * 512 + head * 64 + c * 8) = w; }
      } else {
#pragma unroll
        for (int nt = 0; nt < 2; ++nt)
#pragma unroll
          for (int k = 0; k < 16; ++k) { const int dv = nt * 32 + 8 * (k >> 2) + 4 * hi + (k & 3); wl[dv * 40 + r32] = f2bf(acc[nt][mt][k] * r); }
        asm volatile("s_waitcnt lgkmcnt(0)" ::: "memory");
        const int cc = lane & 3, dq = lane >> 2; const int pos0 = mg & smask, bb = mg >> slog;
#pragma unroll
        for (int i = 0; i < 4; ++i) { const int dvr = dq + 16 * i; const u32x4 w = *(const u32x4*)(wl + dvr * 40 + cc * 8);
          *(u32x4*)(Vt + ((size_t)(bb * 8 + head) * 64 + dvr) * S + pos0 + cc * 8) = w; }
      }
      asm volatile("s_waitcnt lgkmcnt(0)" ::: "memory");
    }
  }
};

struct EpiResid {
  float* x; char* smem;
  __device__ __forceinline__ void operator()(const f32x16 (&acc)[2][4], int m0, int n0, int wm, int wn, int r32, int hi) const {
    const int lane = r32 + 32 * hi, wid = wm * 4 + wn;
    float* wl = (float*)smem + wid * (32 * 68);
    const int c = lane & 15, rq = lane >> 4;
    float* xb = x + (size_t)(m0 + wm * 128 + rq) * 1024 + n0 + wn * 64 + c * 4;
    f32x4 xc[8], xn[8];
#pragma unroll
    for (int i = 0; i < 8; ++i) xc[i] = *(const f32x4*)(xb + (size_t)(4 * i) * 1024);
#pragma unroll
    for (int mt = 0; mt < 4; ++mt) {
      if (mt < 3) {
#pragma unroll
        for (int i = 0; i < 8; ++i) xn[i] = *(const f32x4*)(xb + (size_t)((mt + 1) * 32 + 4 * i) * 1024);
      }
#pragma unroll
      for (int nt = 0; nt < 2; ++nt)
#pragma unroll
        for (int g = 0; g < 4; ++g) { const f32x16& a = acc[nt][mt];
          f32x4 v = {a[4 * g], a[4 * g + 1], a[4 * g + 2], a[4 * g + 3]};
          *(f32x4*)(wl + r32 * 68 + nt * 32 + g * 8 + hi * 4) = v; }
      asm volatile("s_waitcnt lgkmcnt(0)" ::: "memory");
      f32x4 ov[8];
#pragma unroll
      for (int i = 0; i < 8; ++i) { const f32x4 a = *(const f32x4*)(wl + (rq + 4 * i) * 68 + c * 4); ov[i] = xc[i] * DN_ALPHA + a; }
#pragma unroll
      for (int i = 0; i < 8; ++i) *(f32x4*)(xb + (size_t)(mt * 32 + 4 * i) * 1024) = ov[i];
      asm volatile("s_waitcnt lgkmcnt(0)" ::: "memory");
#pragma unroll
      for (int i = 0; i < 8; ++i) xc[i] = xn[i];
    }
    __syncthreads();
  }
};

struct EpiGU {
  bf16_t* hid; char* smem;
  __device__ __forceinline__ void operator()(const f32x16 (&acc)[2][4], int m0, int n0, int wm, int wn, int r32, int hi) const {
    const int hb = (n0 + wn * 64) >> 1;
    const int lane = r32 + 32 * hi, wid = wm * 4 + wn;
    bf16_t* wl = (bf16_t*)smem + wid * (32 * 40);
    const int c = lane & 3, rq = lane >> 2;
#pragma unroll
    for (int mt = 0; mt < 4; ++mt) {
#pragma unroll
      for (int g = 0; g < 4; ++g) {
        float o[4];
#pragma unroll
        for (int i = 0; i < 4; ++i) { const float gt = acc[0][mt][4 * g + i], up = acc[1][mt][4 * g + i]; o[i] = gt * up * __builtin_amdgcn_rcpf(1.f + __builtin_amdgcn_exp2f(-1.4426950408889634f * gt)); }
        u32x2 w = {pk2(o[0], o[1]), pk2(o[2], o[3])};
        *(u32x2*)(wl + r32 * 40 + g * 8 + hi * 4) = w;
      }
      asm volatile("s_waitcnt lgkmcnt(0)" ::: "memory");
#pragma unroll
      for (int i = 0; i < 2; ++i) {
        const int rr = rq + 16 * i;
        const u32x4 v = *(const u32x4*)(wl + rr * 40 + c * 8);
        *(u32x4*)(hid + (size_t)(m0 + wm * 128 + mt * 32 + rr) * DFF + hb + c * 8) = v;
      }
      asm volatile("s_waitcnt lgkmcnt(0)" ::: "memory");
    }
    __syncthreads();
  }
};

namespace pg8 {
#define PG8_LAS __attribute__((address_space(3)))
typedef unsigned short bf16_t;
typedef short bf16x8 __attribute__((ext_vector_type(8)));
typedef float f32x4 __attribute__((ext_vector_type(4)));
typedef unsigned u32x4 __attribute__((ext_vector_type(4)));
constexpr int BM = 256, BK = 64, HALF = 128, HTB = HALF * BK * 2  , STAGE_BYTES = 8 * HTB, NXCD = 8, WGM = 8;

__host__ __device__ __forceinline__ int lds_byte(int r, int c) { const int st = (r >> 4) * 2 + (c >> 5), rr = r & 15, cc = c & 31, ob = rr * 64 + cc * 2; return st * 1024 + (ob ^ (((ob >> 9) & 1) << 5)); }
__host__ __device__ __forceinline__ void stage_rc(int b, int& R, int& C) { const int st = b / 1024, sb = b % 1024, swz = sb ^ (((sb >> 9) & 1) << 5); R = (st >> 1) * 16 + swz / 64; C = (st & 1) * 32 + (swz % 64) / 2; }
__host__ __device__ __forceinline__ int perm32(int rho) { const int n = rho >> 4, i = rho & 15; return 8 * (i >> 2) + 4 * n + (i & 3); }

struct Unit { int pm, pn; };
struct Gemm { const bf16_t* A; const bf16_t* Bt; int M, N, K, lda; };

struct StaticOrder {
    int nM, nN, nwg, G, c;
    __host__ __device__ void init(int M, int N, int G_, int c_) { nM = M / BM; nN = N / BM; nwg = nM * nN; G = G_; c = c_; }
    __host__ __device__ bool next(int i, Unit& u) const {
        const long L = (long)i * G + c; if (L >= nwg) return false;
        int wgid = (int)L; { const int q = nwg / NXCD, r = nwg % NXCD, xcd = wgid % NXCD, off = wgid / NXCD; wgid = (xcd < r ? xcd * (q + 1) : r * (q + 1) + (xcd - r) * q) + off; }
        const int nig = WGM * nN, gid = wgid / nig, fm = gid * WGM, gsz = (nM - fm) < WGM ? (nM - fm) : WGM;
        u.pm = fm + ((wgid % nig) % gsz); u.pn = (wgid % nig) / gsz; return true;
    }
    __device__ __forceinline__ void a_ready(const Unit&) const {}
    __device__ __forceinline__ void done(const Unit&) const {}
};


struct EpiInProj2 {
  static constexpr bool PERM = true, AFTER_DRAIN = false;
  bf16_t* proj; float* gates;
  __device__ __forceinline__ void operator()(const f32x4 (&acc)[2][2][4][2], const Unit& u, int wr, int wc, int fr, int fq) const {
#pragma unroll
    for (int ai = 0; ai < 2; ++ai)
#pragma unroll
      for (int m = 0; m < 4; ++m) { const size_t row = (size_t)u.pm * BM + ai * HALF + wr * 64 + m * 16 + fr;
#pragma unroll
        for (int bj = 0; bj < 2; ++bj) { const int col0 = u.pn * BM + bj * HALF + wc * 32 + 8 * fq; const f32x4 v0 = acc[ai][bj][m][0], v1 = acc[ai][bj][m][1];
          u32x4 w; w.x = pk2(v0[0], v0[1]); w.y = pk2(v0[2], v0[3]); w.z = pk2(v1[0], v1[1]); w.w = pk2(v1[2], v1[3]);
          __builtin_nontemporal_store(w, (u32x4*)(proj + row * NPROJ + col0));
          if (col0 >= C_G && col0 < INW) { *(f32x4*)(gates + row * 16 + (col0 - C_G)) = v0; *(f32x4*)(gates + row * 16 + (col0 - C_G) + 4) = v1; } } }
  }
};
struct EpiResid2 {
  static constexpr bool PERM = false, AFTER_DRAIN = false;
  float* x; const f32x2* stats; const float* g; const float* b;
  __device__ __forceinline__ void operator()(const f32x4 (&acc)[2][2][4][2], const Unit& u, int wr, int wc, int fr, int fq) const {
    const int row0 = u.pm * BM + wr * 64 + fr, col0 = u.pn * BM + wc * 32 + 4 * fq;
    float* rb = x + (size_t)row0 * 1024 + col0;
#pragma unroll
    for (int ai = 0; ai < 2; ++ai)
#pragma unroll
      for (int m = 0; m < 4; ++m) {
        f32x4 xc[2][2]; const f32x2 sv = stats[row0 + ai * HALF + m * 16];
#pragma unroll
        for (int bj = 0; bj < 2; ++bj)
#pragma unroll
          for (int n = 0; n < 2; ++n) xc[bj][n] = *(const f32x4*)(rb + (size_t)(ai * HALF + m * 16) * 1024 + bj * HALF + n * 16);
#pragma unroll
        for (int bj = 0; bj < 2; ++bj)
#pragma unroll
          for (int n = 0; n < 2; ++n) { const f32x4 gv = *(const f32x4*)(g + col0 + bj * HALF + n * 16), bv = *(const f32x4*)(b + col0 + bj * HALF + n * 16);
            const f32x4 xn = (xc[bj][n] - sv[0]) * sv[1] * gv + bv;
            *(f32x4*)(rb + (size_t)(ai * HALF + m * 16) * 1024 + bj * HALF + n * 16) = xn * DN_ALPHA + acc[ai][bj][m][n]; }
        asm volatile("" ::: "memory");
      }
  }
};
struct EpiGU2 {
  static constexpr bool PERM = true, AFTER_DRAIN = false;
  bf16_t* hid;
  __device__ __forceinline__ void operator()(const f32x4 (&acc)[2][2][4][2], const Unit& u, int wr, int wc, int fr, int fq) const {
#pragma unroll
    for (int ai = 0; ai < 2; ++ai)
#pragma unroll
      for (int m = 0; m < 4; ++m) { const size_t row = (size_t)u.pm * BM + ai * HALF + wr * 64 + m * 16 + fr; float o[8];
#pragma unroll
        for (int n = 0; n < 2; ++n)
#pragma unroll
          for (int i = 0; i < 4; ++i) { const float gt = acc[ai][0][m][n][i], up = acc[ai][1][m][n][i]; o[4 * n + i] = gt * up * __builtin_amdgcn_rcpf(1.f + __builtin_amdgcn_exp2f(-1.4426950408889634f * gt)); }
        u32x4 w; w.x = pk2(o[0], o[1]); w.y = pk2(o[2], o[3]); w.z = pk2(o[4], o[5]); w.w = pk2(o[6], o[7]);
        __builtin_nontemporal_store(w, (u32x4*)(hid + row * DFF + u.pn * HALF + wc * 32 + 8 * fq)); }
  }
};
template <class Epi, class Sched, bool ALIGN_EPI = false, bool SP2 = false>
__device__ __forceinline__ void gemm_phase(PG8_LAS unsigned char* lds, const Gemm g, const Sched& S, const Epi& E) {
    const int tid = otid(), wid = __builtin_amdgcn_readfirstlane(tid >> 6), lane = tid & 63, wr = wid >> 2, wc = wid & 3, fr = lane & 15, fq = lane >> 4;
    const int K = g.K, nt = K / BK;
    unsigned voffA[2], voffB[2];
#pragma unroll
    for (int i = 0; i < 2; ++i) { int R, C; stage_rc(tid * 16 + i * 8192, R, C); const int Rb = Epi::PERM ? ((R & ~31) + perm32(R & 31)) : R;
        voffA[i] = (unsigned)(R * g.lda + C) * 2u; voffB[i] = (unsigned)(Rb * K + C) * 2u; }
    const size_t kstep = (size_t)(BK * 2);
    const size_t hstepB = (size_t)HALF * K * 2, hstepA = (size_t)HALF * g.lda * 2;
    const size_t tstepA = 2 * hstepA, tstepB = 2 * hstepB;
    const unsigned ldsw = (unsigned)wid * 1024u;
    const int aoff = lds_byte(wr * 64 + fr, fq * 8), boff = lds_byte(wc * 32 + fr, fq * 8);
#define PG8_SA(b, h) (((b) * 2 + (h)) * HTB)
#define PG8_SB(b, h) ((4 + (b) * 2 + (h)) * HTB)
#define PG8_STAGE(bufoff, gbase, voff) do { _Pragma("unroll") for (int _i = 0; _i < 2; ++_i) \
        __builtin_amdgcn_global_load_lds((const unsigned*)((const char*)(gbase) + (voff)[_i]), (PG8_LAS unsigned*)(lds + (bufoff) + ldsw + _i * 8192), 16, 0, 0); } while (0)
#define PG8_LDA(dst, b, h) do { _Pragma("unroll") for (int m = 0; m < 4; ++m) _Pragma("unroll") for (int k = 0; k < 2; ++k) dst[m][k] = *(const PG8_LAS bf16x8*)(lds + PG8_SA(b, h) + aoff + m * 2048 + k * 1024); } while (0)
#define PG8_LDB(dst, b, h) do { _Pragma("unroll") for (int n = 0; n < 2; ++n) _Pragma("unroll") for (int k = 0; k < 2; ++k) dst[n][k] = *(const PG8_LAS bf16x8*)(lds + PG8_SB(b, h) + boff + n * 2048 + k * 1024); } while (0)
#define PG8_MMA(ai, bj, At, Bt) do { __builtin_amdgcn_s_setprio(1); _Pragma("unroll") for (int m = 0; m < 4; ++m) _Pragma("unroll") for (int n = 0; n < 2; ++n) _Pragma("unroll") for (int k = 0; k < 2; ++k) \
        acc[ai][bj][m][n] = __builtin_amdgcn_mfma_f32_16x16x32_bf16(Bt[n][k], At[m][k], acc[ai][bj][m][n], 0, 0, 0); __builtin_amdgcn_s_setprio(0); } while (0)
#define PG8_WAIT_V(n) asm volatile("s_waitcnt vmcnt(" #n ")" ::: "memory")
#define PG8_WAIT_L(n) asm volatile("s_waitcnt lgkmcnt(" #n ")" ::: "memory")
#define PG8_BAR __builtin_amdgcn_s_barrier()
#define PG8_SCHED __builtin_amdgcn_sched_barrier(0)
    Unit cur, nxt; int ui = 0;
    if (!S.next(0, cur)) return;
    f32x4 acc[2][2][4][2];
#pragma unroll
    for (int a = 0; a < 2; ++a)
#pragma unroll
        for (int b = 0; b < 2; ++b)
#pragma unroll
            for (int m = 0; m < 4; ++m)
#pragma unroll
                for (int n = 0; n < 2; ++n) acc[a][b][m][n] = (f32x4){0.f, 0.f, 0.f, 0.f};
    bf16x8 At[4][2], B0[2][2], B1[2][2];
    const char* cA = (const char*)g.A + (size_t)cur.pm * tstepA; const char* cB = (const char*)g.Bt + (size_t)cur.pn * tstepB;
    S.a_ready(cur);
    if constexpr (SP2) {
        PG8_STAGE(PG8_SB(0, 0), cB, voffB); PG8_STAGE(PG8_SB(0, 1), cB + hstepB, voffB); PG8_STAGE(PG8_SA(0, 0), cA, voffA); PG8_STAGE(PG8_SA(0, 1), cA + hstepA, voffA);
        if (wr == 1) PG8_BAR;
        PG8_WAIT_V(2); PG8_BAR;
        PG8_STAGE(PG8_SB(1, 0), cB + kstep, voffB); PG8_STAGE(PG8_SA(1, 0), cA + kstep, voffA); PG8_STAGE(PG8_SB(1, 1), cB + hstepB + kstep, voffB);
        PG8_WAIT_V(6); PG8_BAR;
    } else {
        PG8_STAGE(PG8_SB(0, 0), cB, voffB); PG8_STAGE(PG8_SA(0, 0), cA, voffA); PG8_STAGE(PG8_SB(0, 1), cB + hstepB, voffB); PG8_STAGE(PG8_SA(0, 1), cA + hstepA, voffA);
        if (wr == 1) PG8_BAR;
        PG8_WAIT_V(4); PG8_BAR;
        PG8_STAGE(PG8_SB(1, 0), cB + kstep, voffB); PG8_STAGE(PG8_SA(1, 0), cA + kstep, voffA); PG8_STAGE(PG8_SB(1, 1), cB + hstepB + kstep, voffB);
        PG8_WAIT_V(6); PG8_BAR;
    }
    for (;;) {
        const bool has_next = S.next(ui + 1, nxt);
        const char* nA = has_next ? (const char*)g.A + (size_t)nxt.pm * tstepA : cA; const char* nB = has_next ? (const char*)g.Bt + (size_t)nxt.pn * tstepB : cB;
        for (int t = 0; t < nt; t += 2) {
            const bool last = (t == nt - 2);
            const char* a1 = cA + (size_t)(t + 1) * kstep;
            const char* a2 = last ? nA : cA + (size_t)(t + 2) * kstep; const char* b2 = last ? nB : cB + (size_t)(t + 2) * kstep;
            const char* a3 = a2 + kstep; const char* b3 = b2 + kstep;
            if (last && has_next) S.a_ready(nxt);
            if constexpr (SP2) {
            PG8_LDB(B0, 0, 0); PG8_LDB(B1, 0, 1); PG8_SCHED; PG8_LDA(At, 0, 0); PG8_STAGE(PG8_SA(1, 1), a1 + hstepA, voffA);
            PG8_WAIT_V(8); PG8_WAIT_L(0); PG8_BAR; PG8_MMA(0, 0, At, B0); PG8_MMA(0, 1, At, B1); PG8_BAR; PG8_SCHED;
            PG8_LDA(At, 0, 1); PG8_STAGE(PG8_SB(0, 0), b2, voffB); PG8_STAGE(PG8_SB(0, 1), b2 + hstepB, voffB); PG8_STAGE(PG8_SA(0, 0), a2, voffA);
            PG8_WAIT_V(8); PG8_WAIT_L(0); PG8_BAR; PG8_MMA(1, 0, At, B0); PG8_MMA(1, 1, At, B1); PG8_BAR; PG8_SCHED;
            PG8_LDB(B0, 1, 0); PG8_LDB(B1, 1, 1); PG8_SCHED; PG8_LDA(At, 1, 0); PG8_STAGE(PG8_SA(0, 1), a2 + hstepA, voffA);
            PG8_WAIT_V(8); PG8_WAIT_L(0); PG8_BAR; PG8_MMA(0, 0, At, B0); PG8_MMA(0, 1, At, B1); PG8_BAR; PG8_SCHED;
            PG8_LDA(At, 1, 1); PG8_STAGE(PG8_SB(1, 0), b3, voffB); PG8_STAGE(PG8_SB(1, 1), b3 + hstepB, voffB); PG8_STAGE(PG8_SA(1, 0), a3, voffA);
            PG8_WAIT_V(8); PG8_WAIT_L(0); PG8_BAR; PG8_MMA(1, 0, At, B0); PG8_MMA(1, 1, At, B1); PG8_BAR; PG8_SCHED;
            } else {
            PG8_LDB(B0, 0, 0); PG8_SCHED; PG8_LDA(At, 0, 0); PG8_STAGE(PG8_SA(1, 1), a1 + hstepA, voffA);
            PG8_WAIT_L(8); PG8_BAR; PG8_WAIT_L(0); PG8_MMA(0, 0, At, B0); PG8_BAR; PG8_SCHED;
            PG8_LDB(B1, 0, 1); PG8_STAGE(PG8_SB(0, 0), b2, voffB);
            PG8_BAR; PG8_WAIT_L(0); PG8_MMA(0, 1, At, B1); PG8_BAR;
            PG8_LDA(At, 0, 1); PG8_STAGE(PG8_SA(0, 0), a2, voffA);
            PG8_BAR; PG8_WAIT_L(0); PG8_MMA(1, 0, At, B0); PG8_BAR; PG8_SCHED;
            PG8_STAGE(PG8_SB(0, 1), b2 + hstepB, voffB);
            PG8_WAIT_V(6); PG8_BAR; PG8_MMA(1, 1, At, B1); PG8_BAR;
            PG8_LDB(B0, 1, 0); PG8_SCHED; PG8_LDA(At, 1, 0); PG8_STAGE(PG8_SA(0, 1), a2 + hstepA, voffA);
            PG8_WAIT_L(8); PG8_BAR; PG8_WAIT_L(0); PG8_MMA(0, 0, At, B0); PG8_BAR; PG8_SCHED;
            PG8_LDB(B1, 1, 1); PG8_STAGE(PG8_SB(1, 0), b3, voffB);
            PG8_BAR; PG8_WAIT_L(0); PG8_MMA(0, 1, At, B1); PG8_BAR;
            PG8_LDA(At, 1, 1); PG8_STAGE(PG8_SA(1, 0), a3, voffA);
            PG8_BAR; PG8_WAIT_L(0); PG8_MMA(1, 0, At, B0); PG8_BAR; PG8_SCHED;
            PG8_STAGE(PG8_SB(1, 1), b3 + hstepB, voffB);
            PG8_WAIT_V(6); PG8_BAR; PG8_MMA(1, 1, At, B1); PG8_BAR;
            }
        }
        if constexpr (ALIGN_EPI) { if (wr == 0) PG8_BAR; }
        if constexpr (!Epi::AFTER_DRAIN) { E(acc, cur, wr, wc, fr, fq); S.done(cur); }
        if (!has_next) break;
#pragma unroll
        for (int a = 0; a < 2; ++a)
#pragma unroll
            for (int b = 0; b < 2; ++b)
#pragma unroll
                for (int m = 0; m < 4; ++m)
#pragma unroll
                    for (int n = 0; n < 2; ++n) acc[a][b][m][n] = (f32x4){0.f, 0.f, 0.f, 0.f};
        cur = nxt; cA = nA; cB = nB; ++ui;
        if constexpr (ALIGN_EPI) { if (wr == 1) PG8_BAR; }
    }
    PG8_WAIT_V(0);
    if constexpr (!ALIGN_EPI) { if (wr == 0) PG8_BAR; }
    PG8_BAR;
    if constexpr (Epi::AFTER_DRAIN) { E.fused(acc, cur, wr, wc, fr, fq, lds, wid, lane); S.done(cur); }
#undef PG8_SA
#undef PG8_SB
#undef PG8_STAGE
#undef PG8_LDA
#undef PG8_LDB
#undef PG8_MMA
#undef PG8_WAIT_V
#undef PG8_WAIT_L
#undef PG8_BAR
#undef PG8_SCHED
}
}


__device__ __forceinline__ void row_rms(const bf16_t* A, int lda, int K, int m0, float* rs) {
  const int tid = otid(), row = tid >> 1, half = tid & 1;
  const bf16_t* p = A + (size_t)(m0 + row) * lda + half * (K >> 1);
  float s = 0.f;
  for (int i = 0; i < (K >> 4); ++i) { const u32x4 w = *(const u32x4*)(p + i * 8);
#pragma unroll
    for (int k = 0; k < 4; ++k) { const float a = bflo(w[k]), b = bfhi(w[k]); s += a * a + b * b; } }
  s += __shfl_xor(s, 1);
  if (half == 0) rs[row] = rsqrtf(s / (float)K + LN_EPS);
  __syncthreads();
}

constexpr int A_KS = 104, A_VS = 72;
constexpr int A_KBUF = 64 * A_KS, A_VBUF = 64 * A_VS;
constexpr float A_THR = 8.f;
__device__ void attn_unit(const bf16_t* __restrict__ Q, const bf16_t* __restrict__ Kn, const bf16_t* __restrict__ Vt, const bf16_t* __restrict__ KR,
                          bf16_t* __restrict__ Y, int S, int b, int h, int qb, char* smem) {
  const int tid = otid(), lane = tid & 63, wid = tid >> 6, r32 = lane & 31, hi = lane >> 5;
  bf16_t* Ks = (bf16_t*)smem; bf16_t* Vs = Ks + 2 * A_KBUF; float* wsf = (float*)(Vs + 2 * A_VBUF) + wid * 64;
  const size_t rowbase = (size_t)b * S;
  const int q0 = qb * 256 + wid * 32;
  bf16x8 qr[6];
  { const bf16_t* qp = Q + (rowbase + q0 + r32) * 768 + h * 96 + hi * 8;
#pragma unroll
    for (int d0 = 0; d0 < 6; ++d0) qr[d0] = *(const bf16x8*)(qp + d0 * 16); }
  const bf16_t* kn_src = Kn + (rowbase + (tid >> 3)) * 512 + h * 64 + (tid & 7) * 8;
  const bf16_t* kr_src = KR + (rowbase + (tid >> 2)) * 32 + (tid & 3) * 8;
  const bf16_t* v_src = Vt + ((size_t)(b * 8 + h) * 64 + (tid >> 3)) * S + (tid & 7) * 8;
  const int kn_dst = (tid >> 3) * A_KS + (tid & 7) * 8, kr_dst = (tid >> 2) * A_KS + 64 + (tid & 3) * 8, v_dst = (tid >> 3) * A_VS + (tid & 7) * 8;
  const bool has_kr = tid < 256;
  u32x4 sk, sr, sv;
#define A_LOAD(k0) do { sk = *(const u32x4*)(kn_src + (size_t)(k0) * 512); if (has_kr) sr = *(const u32x4*)(kr_src + (size_t)(k0) * 32); sv = *(const u32x4*)(v_src + (k0)); } while (0)
#define A_STORE(bf) do { *(u32x4*)(Ks + (bf) * A_KBUF + kn_dst) = sk; if (has_kr) *(u32x4*)(Ks + (bf) * A_KBUF + kr_dst) = sr; *(u32x4*)(Vs + (bf) * A_VBUF + v_dst) = sv; } while (0)
  float m_ref = 0.f, l_reg = 0.f; f32x16 o[2], negm; o[0] = f32x16{}; o[1] = f32x16{}; negm = f32x16{};
  const int NT = S >> 6;
  A_LOAD(0); A_STORE(0); __syncthreads();
  for (int j = 0; j < NT; ++j) {
    const int buf = j & 1;
    if (j + 1 < NT) A_LOAD((j + 1) * 64);
#ifndef A_SKEW
#define A_SKEW 1
#endif
    if (A_SKEW > 0 && wid >= 4) __builtin_amdgcn_s_sleep(A_SKEW);
    f32x16 p0, p1;
    bf16x8 vf[8];
    { const bf16_t* kb = Ks + buf * A_KBUF + r32 * A_KS + hi * 8;
      bf16x8 kf[12];
#pragma unroll
      for (int d0 = 0; d0 < 6; ++d0) { kf[2 * d0] = *(const bf16x8*)(kb + d0 * 16); kf[2 * d0 + 1] = *(const bf16x8*)(kb + 32 * A_KS + d0 * 16); }
      __builtin_amdgcn_sched_barrier(0);
      p0 = MFMA32(kf[0], qr[0], negm); p1 = MFMA32(kf[1], qr[0], negm);
#pragma unroll
      for (int d0 = 1; d0 < 6; ++d0) { p0 = MFMA32(kf[2 * d0], qr[d0], p0); p1 = MFMA32(kf[2 * d0 + 1], qr[d0], p1); }
      __builtin_amdgcn_sched_barrier(0);
      const bf16_t* vb = Vs + buf * A_VBUF + r32 * A_VS + hi * 8;
#pragma unroll
      for (int d0 = 0; d0 < 2; ++d0)
#pragma unroll
        for (int ks = 0; ks < 4; ++ks) vf[d0 * 4 + ks] = *(const bf16x8*)(vb + d0 * 32 * A_VS + ks * 16);
      __builtin_amdgcn_sched_barrier(0);
    }
#define MX3(a, b, c) __builtin_fmaxf(__builtin_fmaxf((a), (b)), (c))
    float pmax;
    { float a = MX3(p0[0], p0[1], p0[2]), b2 = MX3(p0[3], p0[4], p0[5]);
      a = MX3(a, p0[6], p0[7]); b2 = MX3(b2, p0[8], p0[9]); a = MX3(a, p0[10], p0[11]); b2 = MX3(b2, p0[12], p0[13]); a = MX3(a, p0[14], p0[15]);
      b2 = MX3(b2, p1[0], p1[1]); a = MX3(a, p1[2], p1[3]); b2 = MX3(b2, p1[4], p1[5]); a = MX3(a, p1[6], p1[7]); b2 = MX3(b2, p1[8], p1[9]);
      a = MX3(a, p1[10], p1[11]); b2 = MX3(b2, p1[12], p1[13]); a = MX3(a, p1[14], p1[15]); pmax = __builtin_fmaxf(a, b2); }
#undef MX3
    { auto rr = __builtin_amdgcn_permlane32_swap(__float_as_uint(pmax), __float_as_uint(pmax), false, false);
      pmax = fmaxf(__uint_as_float(rr[0]), __uint_as_float(rr[1])); }
    if (j == 0 || __any(pmax > A_THR)) {
      const float delta = (j == 0) ? pmax : fmaxf(pmax, 0.f);
#pragma unroll
      for (int r = 0; r < 16; ++r) { p0[r] -= delta; p1[r] -= delta; }
      m_ref += delta;
#pragma unroll
      for (int r = 0; r < 16; ++r) negm[r] = -m_ref;
      if (j > 0) {
        const float al = __builtin_amdgcn_exp2f(-delta); l_reg *= al;
        if (hi == 0) wsf[r32] = al;
        asm volatile("s_waitcnt lgkmcnt(0)" ::: "memory");
#pragma unroll
        for (int r = 0; r < 16; ++r) { const float f = wsf[crow(r, hi)]; o[0][r] *= f; o[1][r] *= f; }
        asm volatile("s_waitcnt lgkmcnt(0)" ::: "memory");
      }
    }
    float ps = 0.f, ps2 = 0.f;
#pragma unroll
    for (int r = 0; r < 16; ++r) { p0[r] = __builtin_amdgcn_exp2f(p0[r]); ps += p0[r]; }
#pragma unroll
    for (int r = 0; r < 16; ++r) { p1[r] = __builtin_amdgcn_exp2f(p1[r]); ps2 += p1[r]; }
    ps += ps2;
    { auto rr = __builtin_amdgcn_permlane32_swap(__float_as_uint(ps), __float_as_uint(ps), false, false);
      ps = __uint_as_float(rr[0]) + __uint_as_float(rr[1]); }
    l_reg += ps;
    bf16x8 pa0, pa1, pa2, pa3;
    PK4(p0, 0, pa0); PK4(p0, 8, pa1); PK4(p1, 0, pa2); PK4(p1, 8, pa3);
    __builtin_amdgcn_sched_barrier(0);
    o[0] = MFMA32(pa0, vf[0], o[0]); o[1] = MFMA32(pa0, vf[4], o[1]);
    o[0] = MFMA32(pa1, vf[1], o[0]); o[1] = MFMA32(pa1, vf[5], o[1]);
    o[0] = MFMA32(pa2, vf[2], o[0]); o[1] = MFMA32(pa2, vf[6], o[1]);
    o[0] = MFMA32(pa3, vf[3], o[0]); o[1] = MFMA32(pa3, vf[7], o[1]);
    __builtin_amdgcn_sched_barrier(0);
    if (j + 1 < NT) A_STORE(buf ^ 1);
    __syncthreads();
  }
#undef A_LOAD
#undef A_STORE
  if (hi == 0) wsf[32 + r32] = l_reg;
  asm volatile("s_waitcnt lgkmcnt(0)" ::: "memory");
  bf16_t* yp = Y + (rowbase + q0) * 1024 + h * 64 + r32;
#pragma unroll
  for (int r = 0; r < 16; ++r) {
    const int orow = crow(r, hi); const float rl = __builtin_amdgcn_rcpf(wsf[32 + orow]);
    __builtin_nontemporal_store(f2bf(o[0][r] * rl), yp + (size_t)orow * 1024); __builtin_nontemporal_store(f2bf(o[1][r] * rl), yp + (size_t)orow * 1024 + 32);
  }
  __syncthreads();
}

__device__ void phase_pool_rope(const bf16_t* __restrict__ proj, bf16_t* __restrict__ Y, bf16_t* __restrict__ KR, const f32x2* __restrict__ rope, int S) {
  const int smask = S - 1;
  const int gtid = blockIdx.x * NTHR + otid(), gstr = gridDim.x * NTHR;
  for (int idx = gtid; idx < (MT / 8) * 32; idx += gstr) {
    const int tb = idx >> 5, c = idx & 31, g = c >> 3, half = 1 << g, t0 = tb * 8, pos0 = t0 & smask;
    const bf16_t* base = proj + (size_t)(t0 - pos0) * NPROJ + C_POOL + c * 8;
    float sum[8];
#pragma unroll
    for (int k = 0; k < 8; ++k) sum[k] = 0.f;
    { int lo = pos0 - half; if (lo < 0) lo = 0; int hi = pos0 + half; if (hi > S) hi = S;
      for (int t = lo; t < hi; ++t) { const u32x4 v = *(const u32x4*)(base + (size_t)t * NPROJ);
#pragma unroll
        for (int k = 0; k < 4; ++k) { sum[2 * k] += bflo(v[k]); sum[2 * k + 1] += bfhi(v[k]); } } }
#pragma unroll
    for (int q = 0; q < 8; ++q) {
      const int pos = pos0 + q; int lo = pos - half; if (lo < 0) lo = 0; int hi = pos + half; if (hi > S) hi = S;
      const float rc = 1.f / (float)(hi - lo);
      const u32x4 xv = *(const u32x4*)(base + (size_t)pos * NPROJ);
      u32x4 o;
#pragma unroll
      for (int k = 0; k < 4; ++k) o[k] = pk2(sum[2 * k] * rc - bflo(xv[k]), sum[2 * k + 1] * rc - bfhi(xv[k]));
      *(u32x4*)(Y + (size_t)(t0 + q) * 1024 + 512 + c * 8) = o;
      if (q < 7) {
        if (pos + half < S) { const u32x4 v = *(const u32x4*)(base + (size_t)(pos + half) * NPROJ);
#pragma unroll
          for (int k = 0; k < 4; ++k) { sum[2 * k] += bflo(v[k]); sum[2 * k + 1] += bfhi(v[k]); } }
        if (pos - half >= 0) { const u32x4 v = *(const u32x4*)(base + (size_t)(pos - half) * NPROJ);
#pragma unroll
          for (int k = 0; k < 4; ++k) { sum[2 * k] -= bflo(v[k]); sum[2 * k + 1] -= bfhi(v[k]); } }
      }
    }
  }
  for (int idx = gtid; idx < MT * 2; idx += gstr) {
    const int m = idx >> 1, hf = idx & 1, pos = m & smask;
    const bf16_t* pp = proj + (size_t)m * NPROJ + C_KR + hf * 8;
    const u32x4 a = *(const u32x4*)pp, b2 = *(const u32x4*)(pp + 16);
    u32x4 o1, o2;
#pragma unroll
    for (int k = 0; k < 4; ++k) {
      const f32x2 c0 = rope[pos * 16 + hf * 8 + 2 * k], c1 = rope[pos * 16 + hf * 8 + 2 * k + 1];
      const float x1a = bflo(a[k]), x1b = bfhi(a[k]), x2a = bflo(b2[k]), x2b = bfhi(b2[k]);
      o1[k] = pk2(x1a * c0[0] - x2a * c0[1], x1b * c1[0] - x2b * c1[1]);
      o2[k] = pk2(x2a * c0[0] + x1a * c0[1], x2b * c1[0] + x1b * c1[1]);
    }
    *(u32x4*)(KR + (size_t)m * 32 + hf * 8) = o1; *(u32x4*)(KR + (size_t)m * 32 + 16 + hf * 8) = o2;
  }
}

__device__ __forceinline__ float logsigmoidf(float f) { return fminf(f, 0.f) - log1pf(__expf(-fabsf(f))); }
constexpr int ML_T = 136;
constexpr int ML_R = 72;

__device__ void mlstm_pass1(int cgi, int hh, const bf16_t* __restrict__ proj, const float* __restrict__ gates, const float* __restrict__ gbias,
                            float* __restrict__ stU, float* __restrict__ stN, float* __restrict__ stS, char* smem) {
  const int tid = otid(), lane = tid & 63, wid = tid >> 6, r32 = lane & 31, hi = lane >> 5;
  bf16_t* Vt = (bf16_t*)smem; bf16_t* Kw = Vt + 64 * ML_T;
  float* sc = (float*)(Kw + 2 * 64 * ML_T); float* lfs = sc; float* als = sc + 256; float* wss = sc + 512; float* red = sc + 768;
  const int item = cgi * 4 + hh; const size_t m0 = (size_t)cgi * 128;
  float ipre = 0.f;
  if (tid < 256) { const int dir = tid >> 7, s = tid & 127; const float* gp = gates + (m0 + s) * 16;
    ipre = gp[(2 * dir) * 4 + hh] + gbias[(2 * dir) * 4 + hh];
    const float f = gp[(2 * dir + 1) * 4 + hh] + gbias[(2 * dir + 1) * 4 + hh];
    lfs[tid] = logsigmoidf(f); }
  __syncthreads();
  if (tid < 256) { const int dir = tid >> 7, s = tid & 127; float b = 0.f;
#pragma unroll
    for (int t4 = 0; t4 < 32; ++t4) { const f32x4 v = *(const f32x4*)(lfs + dir * 128 + 4 * t4);
#pragma unroll
      for (int k = 0; k < 4; ++k) { const int t = 4 * t4 + k; const bool in = dir ? (t >= s) : (t <= s); b += in ? v[k] : 0.f; } }
    als[tid] = ipre - b;
    if (dir == 0 && s == 127) red[0] = b;
    if (dir == 1 && s == 0) red[1] = b; }
  __syncthreads();
  if (tid < 256) { const int dir = tid >> 7, s = tid & 127; float mx = als[dir * 128];
#pragma unroll
    for (int t4 = 0; t4 < 32; ++t4) { const f32x4 v = *(const f32x4*)(als + dir * 128 + 4 * t4); mx = fmaxf(fmaxf(mx, fmaxf(v[0], v[1])), fmaxf(v[2], v[3])); }
    wss[tid] = __expf(als[tid] - mx);
    if (s == 0) { stS[(size_t)(item * 2 + dir) * 4 + 0] = red[dir]; stS[(size_t)(item * 2 + dir) * 4 + 1] = mx; } }
  __syncthreads();
#pragma unroll
  for (int it = 0; it < 2; ++it) { const int idx = tid + NTHR * it, s = idx & 127, c = idx >> 7;
    const bf16_t* rp = proj + (m0 + s) * NPROJ + hh * 64 + c * 8;
    const u32x4 kc = *(const u32x4*)(rp + C_KM), vc = *(const u32x4*)(rp + C_VM);
    const float w0 = wss[s] * 0.125f, w1 = wss[128 + s] * 0.125f;
#pragma unroll
    for (int k = 0; k < 4; ++k) {
      const float ka = bflo(kc[k]), kb = bfhi(kc[k]);
      Kw[(8 * c + 2 * k) * ML_T + s] = f2bf(ka * w0); Kw[(8 * c + 2 * k + 1) * ML_T + s] = f2bf(kb * w0);
      Kw[64 * ML_T + (8 * c + 2 * k) * ML_T + s] = f2bf(ka * w1); Kw[64 * ML_T + (8 * c + 2 * k + 1) * ML_T + s] = f2bf(kb * w1);
      Vt[(8 * c + 2 * k) * ML_T + s] = (bf16_t)(vc[k] & 0xffffu); Vt[(8 * c + 2 * k + 1) * ML_T + s] = (bf16_t)(vc[k] >> 16);
    } }
  __syncthreads();
  { const int dir = wid >> 2, kb = (wid >> 1) & 1, vb = wid & 1;
    f32x16 acc = f32x16{};
    const bf16_t* ap = Kw + dir * 64 * ML_T + (kb * 32 + r32) * ML_T + hi * 8; const bf16_t* bp = Vt + (vb * 32 + r32) * ML_T + hi * 8;
#pragma unroll
    for (int ks = 0; ks < 8; ++ks) acc = MFMA32(*(const bf16x8*)(ap + ks * 16), *(const bf16x8*)(bp + ks * 16), acc);
    float* up = stU + (size_t)(item * 2 + dir) * 4096 + vb * 32 + r32;
#pragma unroll
    for (int r = 0; r < 16; ++r) up[(kb * 32 + crow(r, hi)) * 64] = acc[r]; }
  if (tid < 128) { const int dir = tid >> 6, kd = tid & 63; const bf16_t* kp = Kw + dir * 64 * ML_T + kd * ML_T; float s = 0.f;
#pragma unroll
    for (int t8 = 0; t8 < 16; ++t8) { const u32x4 v = *(const u32x4*)(kp + t8 * 8);
#pragma unroll
      for (int k = 0; k < 4; ++k) s += bflo(v[k]) + bfhi(v[k]); }
    stN[(size_t)(item * 2 + dir) * 64 + kd] = s; }
  __syncthreads();
}

template <int EPT, int GS>
__device__ void mlstm_pass2(int ch, int part, int NC, float* __restrict__ stU, float* __restrict__ stN, float* __restrict__ stS) {
  const int tid = otid(); const int b = ch >> 3, hh = (ch >> 1) & 3, dir = ch & 1;
  const int e0 = part * (NTHR * EPT) + tid;
  const bool own_n = (part == 0) && (tid < 64);
  float sv[EPT], nv = 0.f, m = 0.f;
#pragma unroll
  for (int i = 0; i < EPT; ++i) sv[i] = 0.f;
  for (int st0 = 0; st0 < NC; st0 += GS) {
    float uu[GS][EPT], un[GS], bs[GS], ml[GS];
#pragma unroll
    for (int q = 0; q < GS; ++q) {
      const int step = st0 + q, c = dir ? (NC - 1 - step) : step;
      const size_t base = (size_t)(((b * NC + c) * 4 + hh) * 2 + dir);
      bs[q] = stS[base * 4 + 0]; ml[q] = stS[base * 4 + 1];
#pragma unroll
      for (int i = 0; i < EPT; ++i) uu[q][i] = stU[base * 4096 + e0 + NTHR * i];
      un[q] = own_n ? stN[base * 64 + tid] : 0.f;
    }
#pragma unroll
    for (int q = 0; q < GS; ++q) {
      const int step = st0 + q, c = dir ? (NC - 1 - step) : step;
      const size_t base = (size_t)(((b * NC + c) * 4 + hh) * 2 + dir);
      const float mnew = bs[q] + fmaxf(m, ml[q]);
      const float decay = __expf(m + bs[q] - mnew), uf = __expf(ml[q] + bs[q] - mnew);
#pragma unroll
      for (int i = 0; i < EPT; ++i) { stU[base * 4096 + e0 + NTHR * i] = sv[i]; sv[i] = decay * sv[i] + uf * uu[q][i]; }
      if (own_n) { stN[base * 64 + tid] = nv; nv = decay * nv + uf * un[q]; }
      if (part == 0 && tid == 0) stS[base * 4 + 2] = m;
      m = mnew;
    }
  }
}

__device__ void mlstm_pass3(int cgi, int hh, const bf16_t* __restrict__ proj, const float* __restrict__ gates, const float* __restrict__ gbias,
                            const float* __restrict__ norm_g, const float* __restrict__ stU, const float* __restrict__ stN, const float* __restrict__ stS,
                            bf16_t* __restrict__ Y, char* smem) {
  const int tid = otid(), lane = tid & 63, wid = tid >> 6, r32 = lane & 31, hi = lane >> 5;
  bf16_t* Kr = (bf16_t*)smem; bf16_t* Qr = Kr + 128 * ML_R; bf16_t* Vt = Qr + 128 * ML_R; bf16_t* Qf = Vt + 64 * ML_T;
  bf16_t* St = Qf + 2 * 128 * ML_R;
  float* H = (float*)(St + 2 * 64 * ML_R);
  float* sc = H + 128 * 64; float* lfs = sc; float* als = sc + 256; float* bbs = sc + 512; float* Mls = sc + 768; float* ffs = sc + 1024; float* dqs = sc + 1280;
  float* nss = sc + 1536;   float* invs = sc + 1664;
  const int item = cgi * 4 + hh; const size_t m0 = (size_t)cgi * 128;
  float ipre = 0.f;
  if (tid < 256) { const int dir = tid >> 7, s = tid & 127; const float* gp = gates + (m0 + s) * 16;
    ipre = gp[(2 * dir) * 4 + hh] + gbias[(2 * dir) * 4 + hh];
    const float f = gp[(2 * dir + 1) * 4 + hh] + gbias[(2 * dir + 1) * 4 + hh];
    lfs[tid] = logsigmoidf(f); }
  __syncthreads();
  if (tid < 256) { const int dir = tid >> 7, s = tid & 127; float b = 0.f;
#pragma unroll
    for (int t4 = 0; t4 < 32; ++t4) { const f32x4 v = *(const f32x4*)(lfs + dir * 128 + 4 * t4);
#pragma unroll
      for (int k = 0; k < 4; ++k) { const int t = 4 * t4 + k; const bool in = dir ? (t >= s) : (t <= s); b += in ? v[k] : 0.f; } }
    als[tid] = ipre - b; bbs[tid] = b; }
  else if (tid < 384) { const int dir = (tid - 256) >> 6, kd = tid & 63; nss[dir * 64 + kd] = stN[(size_t)(item * 2 + dir) * 64 + kd]; }
  __syncthreads();
  if (tid < 256) { const int dir = tid >> 7, s = tid & 127; const float mst = stS[(size_t)(item * 2 + dir) * 4 + 2]; float mx = mst;
#pragma unroll
    for (int t4 = 0; t4 < 32; ++t4) { const f32x4 v = *(const f32x4*)(als + dir * 128 + 4 * t4);
#pragma unroll
      for (int k = 0; k < 4; ++k) { const int t = 4 * t4 + k; const bool in = dir ? (t >= s) : (t <= s); mx = fmaxf(mx, in ? v[k] : -3.0e38f); } }
    Mls[tid] = mx; ffs[tid] = __expf(mst - mx); }
  __syncthreads();
#pragma unroll
  for (int it = 0; it < 2; ++it) {
    { const int idx = tid + NTHR * it, s = idx >> 3, c = idx & 7;
      const bf16_t* rp = proj + (m0 + s) * NPROJ + hh * 64 + c * 8;
      const u32x4 kc = *(const u32x4*)(rp + C_KM), qc = *(const u32x4*)(rp + C_QM);
      *(u32x4*)(Kr + s * ML_R + c * 8) = kc; *(u32x4*)(Qr + s * ML_R + c * 8) = qc;
      const float f0 = ffs[s], f1 = ffs[128 + s]; u32x4 q0, q1;
#pragma unroll
      for (int k = 0; k < 4; ++k) { const float a = bflo(qc[k]), b2 = bfhi(qc[k]); q0[k] = pk2(a * f0, b2 * f0); q1[k] = pk2(a * f1, b2 * f1); }
      *(u32x4*)(Qf + s * ML_R + c * 8) = q0; *(u32x4*)(Qf + 128 * ML_R + s * ML_R + c * 8) = q1; }
    { const int idx = tid + NTHR * it, s = idx & 127, c = idx >> 7;
      const u32x4 vc = *(const u32x4*)(proj + (m0 + s) * NPROJ + C_VM + hh * 64 + c * 8);
#pragma unroll
      for (int k = 0; k < 4; ++k) { Vt[(8 * c + 2 * k) * ML_T + s] = (bf16_t)(vc[k] & 0xffffu); Vt[(8 * c + 2 * k + 1) * ML_T + s] = (bf16_t)(vc[k] >> 16); } }
  }
#pragma unroll
  for (int dir = 0; dir < 2; ++dir) { const float* sp = stU + (size_t)(item * 2 + dir) * 4096;
#pragma unroll
    for (int it = 0; it < 8; ++it) { const int idx = tid + NTHR * it, d = idx >> 6, e = idx & 63; St[dir * 64 * ML_R + e * ML_R + d] = f2bf(sp[idx]); } }
  __syncthreads();
  if (tid < 256) { const int dir = tid >> 7, j = tid & 127; const bf16_t* qp = Qr + j * ML_R; float s = 0.f;
#pragma unroll
    for (int d8 = 0; d8 < 8; ++d8) { const u32x4 qv = *(const u32x4*)(qp + d8 * 8); const f32x4 n0 = *(const f32x4*)(nss + dir * 64 + d8 * 8), n1 = *(const f32x4*)(nss + dir * 64 + d8 * 8 + 4);
      s += bflo(qv[0]) * n0[0] + bfhi(qv[0]) * n0[1] + bflo(qv[1]) * n0[2] + bfhi(qv[1]) * n0[3] + bflo(qv[2]) * n1[0] + bfhi(qv[2]) * n1[1] + bflo(qv[3]) * n1[2] + bfhi(qv[3]) * n1[3]; }
    dqs[tid] = s * ffs[tid]; }
  __syncthreads();
  f32x16 o[2]; o[0] = f32x16{}; o[1] = f32x16{};
  const int dir = wid >> 2, jb = wid & 3;
  {
    const int jrow = 32 * jb + r32; const float Mj = Mls[dir * 128 + jrow]; float den = 0.f;
    const int st_lo = dir ? jb : 0, st_hi = dir ? 3 : jb;
    for (int st = st_lo; st <= st_hi; ++st) {
      f32x16 sc2 = f32x16{};
      const bf16_t* ap = Kr + (32 * st + r32) * ML_R + hi * 8; const bf16_t* bp = Qr + jrow * ML_R + hi * 8;
#pragma unroll
      for (int kk = 0; kk < 4; ++kk) sc2 = MFMA32(*(const bf16x8*)(ap + kk * 16), *(const bf16x8*)(bp + kk * 16), sc2);
      float pv[16];
#pragma unroll
      for (int r = 0; r < 16; ++r) { const int s = 32 * st + crow(r, hi); const bool valid = dir ? (s >= jrow) : (s <= jrow);
        const float x = fminf(als[dir * 128 + s] - Mj, 0.f); const float w = valid ? 0.125f * __expf(x) : 0.f;
        pv[r] = sc2[r] * w; den += pv[r]; }
      bf16x8 pa0, pa1; PK4(pv, 0, pa0); PK4(pv, 8, pa1);
#pragma unroll
      for (int d0 = 0; d0 < 2; ++d0) { const bf16_t* vp = Vt + (32 * d0 + r32) * ML_T + 32 * st + hi * 8;
        o[d0] = MFMA32(pa0, *(const bf16x8*)(vp), o[d0]); o[d0] = MFMA32(pa1, *(const bf16x8*)(vp + 16), o[d0]); }
    }
    { const bf16_t* ap = Qf + dir * 128 * ML_R + jrow * ML_R + hi * 8;
#pragma unroll
      for (int kk = 0; kk < 4; ++kk) { const bf16x8 a = *(const bf16x8*)(ap + kk * 16);
#pragma unroll
        for (int d0 = 0; d0 < 2; ++d0) o[d0] = MFMA32(a, *(const bf16x8*)(St + dir * 64 * ML_R + (32 * d0 + r32) * ML_R + kk * 16 + hi * 8), o[d0]); } }
    den += __shfl_xor(den, 32);
    den += dqs[dir * 128 + jrow];
    const float flo = __expf(-(bbs[dir * 128 + jrow] + Mj));
    const float inv = __builtin_amdgcn_rcpf(fmaxf(fabsf(den), flo));
    if (hi == 0) invs[wid * 32 + r32] = inv;
    asm volatile("s_waitcnt lgkmcnt(0)" ::: "memory");
  }
  if (dir == 0) {
#pragma unroll
    for (int r = 0; r < 16; ++r) { const int jr = crow(r, hi); const float iv = invs[wid * 32 + jr];
      H[(32 * jb + jr) * 64 + r32] = o[0][r] * iv; H[(32 * jb + jr) * 64 + 32 + r32] = o[1][r] * iv; }
  }
  __syncthreads();
  if (dir == 1) {
#pragma unroll
    for (int r = 0; r < 16; ++r) { const int jr = crow(r, hi); const float iv = invs[wid * 32 + jr];
      H[(32 * jb + jr) * 64 + r32] += o[0][r] * iv; H[(32 * jb + jr) * 64 + 32 + r32] += o[1][r] * iv; }
  }
  __syncthreads();
  { const int j = tid >> 2, qd = tid & 3; float hv[16]; float s = 0.f;
#pragma unroll
    for (int e = 0; e < 16; ++e) { hv[e] = H[j * 64 + qd * 16 + e]; s += hv[e]; }
    s += __shfl_xor(s, 1); s += __shfl_xor(s, 2);
    const float mu = s * (1.f / 64.f); float q = 0.f;
#pragma unroll
    for (int e = 0; e < 16; ++e) { const float d = hv[e] - mu; q += d * d; }
    q += __shfl_xor(q, 1); q += __shfl_xor(q, 2);
    const float rstd = rsqrtf(q * (1.f / 64.f) + LN_EPS);
    const bf16_t* op = proj + (m0 + j) * NPROJ + C_OM + hh * 64 + qd * 16;
    const u32x4 oa = *(const u32x4*)op, ob = *(const u32x4*)(op + 8);
    const float* ng = norm_g + hh * 64 + qd * 16;
    float y[16];
#pragma unroll
    for (int k = 0; k < 4; ++k) {
      const float g0 = bflo(oa[k]), g1 = bfhi(oa[k]), g2 = bflo(ob[k]), g3 = bfhi(ob[k]);
      y[2 * k] = (hv[2 * k] - mu) * rstd * ng[2 * k] * __builtin_amdgcn_rcpf(1.f + __builtin_amdgcn_exp2f(-1.4426950408889634f * g0));
      y[2 * k + 1] = (hv[2 * k + 1] - mu) * rstd * ng[2 * k + 1] * __builtin_amdgcn_rcpf(1.f + __builtin_amdgcn_exp2f(-1.4426950408889634f * g1));
      y[8 + 2 * k] = (hv[8 + 2 * k] - mu) * rstd * ng[8 + 2 * k] * __builtin_amdgcn_rcpf(1.f + __builtin_amdgcn_exp2f(-1.4426950408889634f * g2));
      y[8 + 2 * k + 1] = (hv[8 + 2 * k + 1] - mu) * rstd * ng[8 + 2 * k + 1] * __builtin_amdgcn_rcpf(1.f + __builtin_amdgcn_exp2f(-1.4426950408889634f * g3));
    }
    u32x4 w0 = {pk2(y[0], y[1]), pk2(y[2], y[3]), pk2(y[4], y[5]), pk2(y[6], y[7])}, w1 = {pk2(y[8], y[9]), pk2(y[10], y[11]), pk2(y[12], y[13]), pk2(y[14], y[15])};
    bf16_t* yp = Y + (m0 + j) * 1024 + 768 + hh * 64 + qd * 16;
    *(u32x4*)yp = w0; *(u32x4*)(yp + 8) = w1; }
  __syncthreads();
}

__device__ __forceinline__ bool tile_order(int i, int G, int c, int nM, int nN, int& pm, int& pn) {
  const int nwg = nM * nN; const long L = (long)i * G + c; if (L >= nwg) return false;
  int wgid = (int)L; { const int q = nwg / 8, r = nwg % 8, xcd = wgid % 8, off = wgid / 8; wgid = (xcd < r ? xcd * (q + 1) : r * (q + 1) + (xcd - r) * q) + off; }
  const int nig = 8 * nN, gid = wgid / nig, fm = gid * 8, gsz = (nM - fm) < 8 ? (nM - fm) : 8;
  pm = fm + ((wgid % nig) % gsz); pn = (wgid % nig) / gsz; return true;
}

#define XB_TMO      128
#define XB_XCNT(j)  (256  + 64 * (j))
#define XB_XSUB(j)  (1280 + 64 * (j))
#define XB_XGEN(j)  (2304 + 64 * (j))
#define XB_TOP      3328
#define XB_TOPGEN   3392
#define XCD_BAR_WORDS 3456
#define XB_SPIN_CAP (1u << 18)
#define LAS __attribute__((address_space(3)))

__device__ __forceinline__ unsigned xb_ld(unsigned* p)              { return __hip_atomic_load(p, __ATOMIC_RELAXED, __HIP_MEMORY_SCOPE_AGENT); }
__device__ __forceinline__ unsigned xb_add(unsigned* p, unsigned v) { return __hip_atomic_fetch_add(p, v, __ATOMIC_RELAXED, __HIP_MEMORY_SCOPE_AGENT); }
__device__ __forceinline__ unsigned xb_xcc_id() { return (unsigned)__builtin_amdgcn_s_getreg((3 << 11) | 20) & 0xFu; }
#define XB_SPIN(cond, bar) do { unsigned _sp = 0; while (cond) { __builtin_amdgcn_s_sleep(1); \
    if ((++_sp & 255u) == 0u) { if (xb_ld(&(bar)[XB_TMO])) break; if (_sp > XB_SPIN_CAP) { atomicAdd(&(bar)[XB_TMO], 1u); break; } } } } while (0)

struct XcdBarrier {
    unsigned* bar; unsigned x;
    volatile LAS unsigned* st;
};

__device__ __forceinline__ XcdBarrier xcd_barrier_post(unsigned* bar, volatile LAS unsigned* st) {
    XcdBarrier b; b.bar = bar; b.x = xb_xcc_id(); b.st = st;
    if (threadIdx.x == 0) (void)xb_add(&bar[XB_XCNT(b.x)], 1u);
    return b;
}
__device__ __forceinline__ void xcd_barrier_complete(unsigned* bar, unsigned x, unsigned& nloc, unsigned& nx) {
    const unsigned G = gridDim.x * gridDim.y * gridDim.z;
    unsigned sum, cnt, mine, sp = 0u;
    for (;;) {
        sum = 0u; cnt = 0u; mine = 0u;
#pragma unroll
        for (unsigned j = 0; j < 16; ++j) { const unsigned c = xb_ld(&bar[XB_XCNT(j)]); sum += c; cnt += (c > 0u) ? 1u : 0u; mine = (j == x) ? c : mine; }
        if (sum == G) break;
        __builtin_amdgcn_s_sleep(1);
        if ((++sp & 255u) == 0u) { if (xb_ld(&bar[XB_TMO])) break; if (sp > XB_SPIN_CAP) { atomicAdd(&bar[XB_TMO], 1u); break; } }
    }
    nloc = mine > 0u ? mine : 1u; nx = cnt > 0u ? cnt : 1u;
}

__device__ __forceinline__ void xcd_barrier(const XcdBarrier& b) {
    asm volatile("s_waitcnt vmcnt(0)" ::: "memory");
    __syncthreads();
    if (threadIdx.x == 0) {
        unsigned* bar = b.bar;
        __builtin_amdgcn_s_waitcnt(0);
        unsigned nloc = b.st[0], nx = b.st[1];
        if (nloc == 0u) { xcd_barrier_complete(bar, b.x, nloc, nx); b.st[0] = nloc; b.st[1] = nx; }
        const unsigned old = xb_add(&bar[XB_XSUB(b.x)], 1u);
        const unsigned gen = old / nloc;
        if (old + 1u == (gen + 1u) * nloc) {
            __builtin_amdgcn_fence(__ATOMIC_RELEASE, "agent");
            asm volatile("s_waitcnt vmcnt(0)" ::: "memory");
            const unsigned og = xb_add(&bar[XB_TOP], 1u);
            const unsigned tg = og / nx;
            if (og + 1u == (tg + 1u) * nx) xb_add(&bar[XB_TOPGEN], 1u);
            else XB_SPIN(xb_ld(&bar[XB_TOPGEN]) == tg, bar);
            __builtin_amdgcn_fence(__ATOMIC_ACQUIRE, "agent");
            xb_add(&bar[XB_XGEN(b.x)], 1u);
            asm volatile("s_waitcnt vmcnt(0)" ::: "memory");
        } else {
            XB_SPIN(xb_ld(&bar[XB_XGEN(b.x)]) == gen, bar);
            __builtin_amdgcn_fence(__ATOMIC_ACQUIRE, "agent");
            asm volatile("s_waitcnt vmcnt(0)" ::: "memory");
        }
    }
    __syncthreads();
}

constexpr int PH_PER_TRUNK = 1 + 8 * DEPTH, N_PHASES = 1 + 2 * PH_PER_TRUNK;

__device__ void run_phase(const Params& p, int ph, char* smem) {
  if (ph == 0) { if (blockIdx.x == 0) { const int t0 = otid();
      ((unsigned*)(p.ws + OFF_CNT))[t0] = 0u; ((unsigned*)(p.ws + OFF_CNT))[t0 + NTHR] = 0u;
      float* idv = (float*)(p.ws + OFF_ID); idv[t0] = 1.f; idv[t0 + NTHR] = 1.f; idv[1024 + t0] = 0.f; idv[1024 + t0 + NTHR] = 0.f; }
    phase_prep(p, smem); return; }
  const int tr = (ph - 1) / PH_PER_TRUNK, q = (ph - 1) % PH_PER_TRUNK;
  const int S = tr ? 2048 : 16384, slog = tr ? 11 : 14, nseq = tr ? 16 : 2;
  float* x32 = p.out + (size_t)tr * MT * 1024;
  unsigned char* ws = p.ws;
  bf16_t* XB = (bf16_t*)(ws + OFF_XB); bf16_t* Y = (bf16_t*)(ws + OFF_Y); bf16_t* PROJ = (bf16_t*)(ws + OFF_PROJ);
  bf16_t* Qb = (bf16_t*)(ws + OFF_Q); bf16_t* KN = (bf16_t*)(ws + OFF_KN); bf16_t* VT = (bf16_t*)(ws + OFF_VT); bf16_t* KR = (bf16_t*)(ws + OFF_KR);
  float* GATES = (float*)(ws + OFF_GATES); float* STU = (float*)(ws + OFF_STU); float* STN = (float*)(ws + OFF_STN); float* STS = (float*)(ws + OFF_STS);
  bf16_t* HID = (bf16_t*)(ws + OFF_HID); const f32x2* ROPE = (const f32x2*)(ws + OFF_ROPE);
  f32x2* STAT = (f32x2*)(ws + OFF_STAT); const float* IDV = (const float*)(ws + OFF_ID);
  if (q == 0) { phase_ln(p.in[tr], x32, XB, p.in[2], p.in[3], MT, STAT, true); return; }
  const int l = (q - 1) / 8, sub = (q - 1) % 8;
  const unsigned char* wl = ws + OFF_W + (size_t)l * W_LAYER;
  const int G = gridDim.x, B = blockIdx.x;
#ifdef ONLY_SUB
  switch (ONLY_SUB) {
#else
  switch (sub) {
#endif
    case 0: {
      pg8::Gemm g{XB, (const bf16_t*)(wl + W_IN), MT, NPROJ, 1024, 1024}; pg8::StaticOrder So; So.init(MT, NPROJ, G, B);
      pg8::EpiInProj2 E{PROJ, GATES};
      pg8::gemm_phase<pg8::EpiInProj2, pg8::StaticOrder, true, true>((PG8_LAS unsigned char*)smem, g, So, E);
    } break;
    case 1: {
      float* rs = (float*)(smem + G_SMEM_BYTES);
      for (int rep1 = 0; rep1 < REP_P1; ++rep1) {
      for (int i = 0, pm, pn; tile_order(i, G, B, 128, 3, pm, pn); ++i) {
        row_rms(PROJ + C_CQ, NPROJ, 256, pm * 256, rs); EpiQUp E{Qb, rs, ROPE, S - 1, smem};
        gemm_tile(PROJ + C_CQ, NPROJ, (const bf16_t*)(wl + W_UQ), 256, pm * 256, pn * 256, smem, E);
        __syncthreads();
      }
      for (int i = 0, pm, pn; tile_order(i, G, B, 128, 4, pm, pn); ++i) {
        row_rms(PROJ + C_CKV, NPROJ, 128, pm * 256, rs); EpiKVUp E{KN, VT, rs, S, slog, S - 1, smem};
        gemm_tile(PROJ + C_CKV, NPROJ, (const bf16_t*)(wl + W_UKV), 128, pm * 256, pn * 256, smem, E);
        __syncthreads();
      }
      phase_pool_rope(PROJ, Y, KR, ROPE, S);
      for (int t = B; t < 256 * 4; t += G) mlstm_pass1(t >> 2, t & 3, PROJ, GATES, p.in[11] + l * 16, STU, STN, STS, smem);
      }
    } break;
    case 2: {
      unsigned* cnt = (unsigned*)(ws + OFF_CNT) + (tr * DEPTH + l) * 64;
      if (B < 128) {
        if (tr == 0) mlstm_pass2<1, 32>(B >> 3, B & 7, S >> 7, STU, STN, STS); else mlstm_pass2<8, 4>(B, 0, S >> 7, STU, STN, STS);
        __builtin_amdgcn_fence(__ATOMIC_RELEASE, "agent");
        asm volatile("s_waitcnt vmcnt(0)" ::: "memory");
        __syncthreads();
        if (threadIdx.x == 0) __hip_atomic_fetch_add(cnt, 1u, __ATOMIC_RELEASE, __HIP_MEMORY_SCOPE_AGENT);
      }
      const int nqb = S >> 8;
      for (int t0 = B; t0 < 1024; t0 += G) { const int t = (G == 256) ? (t0 & ~255) + (B & 7) * 32 + (B >> 3) : t0; const int qb = t % nqb, bh = t / nqb; attn_unit(Qb, KN, VT, KR, Y, S, bh >> 3, bh & 7, qb, smem); }
      if (threadIdx.x == 0) { while (__hip_atomic_load(cnt, __ATOMIC_ACQUIRE, __HIP_MEMORY_SCOPE_AGENT) < 128u) __builtin_amdgcn_s_sleep(2); }
      __syncthreads();
      __builtin_amdgcn_fence(__ATOMIC_ACQUIRE, "agent");
      asm volatile("s_waitcnt vmcnt(0)" ::: "memory");
      for (int t = B; t < 256 * 4; t += G) mlstm_pass3(t >> 2, t & 3, PROJ, GATES, p.in[11] + l * 16, p.in[12] + l * 256, STU, STN, STS, Y, smem);
    } break;
    case 3: {
      pg8::Gemm g{Y, (const bf16_t*)(wl + W_OUT), MT, 1024, 1024, 1024}; pg8::StaticOrder So; So.init(MT, 1024, G, B);
      pg8::EpiResid2 E{x32, STAT, l ? p.in[19] + (l - 1) * 1024 : IDV, l ? p.in[20] + (l - 1) * 1024 : IDV + 1024};
      pg8::gemm_phase<pg8::EpiResid2, pg8::StaticOrder, true, true>((PG8_LAS unsigned char*)smem, g, So, E);
    } break;
    case 4: phase_ln(x32, nullptr, XB, p.in[14] + l * 1024, p.in[15] + l * 1024, MT, STAT, false); break;
    case 5: {
      pg8::Gemm g{XB, (const bf16_t*)(wl + W_GU), MT, NGU, 1024, 1024}; pg8::StaticOrder So; So.init(MT, NGU, G, B);
      pg8::EpiGU2 E{HID};
      pg8::gemm_phase<pg8::EpiGU2, pg8::StaticOrder, true, true>((PG8_LAS unsigned char*)smem, g, So, E);
    } break;
    case 6: {
      pg8::Gemm g{HID, (const bf16_t*)(wl + W_DN), MT, 1024, DFF, DFF}; pg8::StaticOrder So; So.init(MT, 1024, G, B);
      pg8::EpiResid2 E{x32, STAT, p.in[14] + l * 1024, p.in[15] + l * 1024};
      pg8::gemm_phase<pg8::EpiResid2, pg8::StaticOrder, true, true>((PG8_LAS unsigned char*)smem, g, So, E);
    } break;
    case 7: phase_ln(x32, (l == DEPTH - 1) ? x32 : nullptr, XB, p.in[19] + l * 1024, p.in[20] + l * 1024, MT, STAT, false); break;
  }
}

__global__ void __launch_bounds__(NTHR) fwd_kernel(Params p) {
  extern __shared__ __attribute__((aligned(16))) char smem[];
  cg::grid_group grid = cg::this_grid();
  volatile LAS unsigned* st = (volatile LAS unsigned*)((LAS unsigned char*)smem + (LDS_BYTES - 16));
  if (threadIdx.x < 2) st[threadIdx.x] = 0u;
  __syncthreads();
  XcdBarrier xb = xcd_barrier_post((unsigned*)(p.ws + OFF_XBAR), st);
  for (int ph = p.ph_lo; ph < p.ph_hi; ++ph) {
    run_phase(p, ph, smem);
    if (ph + 1 < p.ph_hi) {
      if (ph == p.ph_lo) grid.sync();
      else xcd_barrier(xb);
    }
  }
}

extern "C" void kernel_launch(void* const* d_in, const int* in_sizes, int n_in, void* d_out, int out_size, void* d_ws, size_t ws_size, hipStream_t stream) {
  static int grid_blocks = 0;
  if (!grid_blocks) {
    int dev = 0, cus = 0, per_cu = 0;
    hipGetDevice(&dev);
    hipDeviceGetAttribute(&cus, hipDeviceAttributeMultiprocessorCount, dev);
    hipFuncSetAttribute((const void*)fwd_kernel, hipFuncAttributeMaxDynamicSharedMemorySize, LDS_BYTES);
    hipOccupancyMaxActiveBlocksPerMultiprocessor(&per_cu, (const void*)fwd_kernel, NTHR, LDS_BYTES);
    if (per_cu < 1) per_cu = 1;
    grid_blocks = cus * per_cu;
    if (ws_size < OFF_END) fprintf(stderr, "kernel_launch: workspace too small (%zu < %zu)\n", ws_size, (size_t)OFF_END);
  }
  Params p{};
  for (int i = 0; i < 21; ++i) p.in[i] = (const float*)d_in[i];
  p.out = (float*)d_out; p.ws = (unsigned char*)d_ws;
#if ONE_LAUNCH
  p.ph_lo = 0; p.ph_hi = N_PHASES;
  (void)hipMemsetAsync((char*)d_ws + OFF_XBAR, 0, XCD_BAR_WORDS * 4, stream);
  void* args[] = {&p};
  hipError_t e = hipLaunchCooperativeKernel((const void*)fwd_kernel, dim3(grid_blocks), dim3(NTHR), args, LDS_BYTES, stream);
  if (e != hipSuccess) fprintf(stderr, "cooperative launch failed: %s (grid %d)\n", hipGetErrorString(e), grid_blocks);
#else
  for (int ph = 0; ph < N_PHASES; ++ph) { p.ph_lo = ph; p.ph_hi = ph + 1; hipLaunchKernelGGL(fwd_kernel, dim3(grid_blocks), dim3(NTHR), LDS_BYTES, stream, p); }
#endif
}
```
